# Optimizing an MI355X kernel written in HIP

```python
import math
import jax, jax.numpy as jnp
from jax import lax
import numpy as np

D_MODEL = 1024
BATCH = 32
SEQ = 256
DEPTH = 4
DEC_BATCH = 2
DEC_SEQ = 4096
PAST_LEN = 256

GRID_W = 64
N_MIXERS = 4
Q_BLOCK = 128
ROPE_THETA = 10000.0
NORM_EPS = 1e-6
A_HEADS = 16
A_KV_HEADS = 4
A_HEAD_DIM = 64
A_GROUP = A_HEADS // A_KV_HEADS
B_HEADS = 8
B_HEAD_DIM = 64
B_SUBLN_EPS = 1e-5
C_HEADS = 4
C_KEY_DIM = 256
C_VAL_DIM = 512
C_CHUNK = 128
D_BANDS = 16
D_EMB = 1 + 2 * D_BANDS
D_FILTER_HIDDEN = 64
D_ORDER = 2
D_DIRS = 2
D_FAST_DECAY_PCT = 0.3
D_SLOW_DECAY_PCT = 1.5
D_DECAY_TARGET = 1e-2
D_MOD_SHIFT = 0.05
FFN_DIM = 2816
N_A = (DEPTH + 3) // 4
N_B = (DEPTH + 2) // 4
N_C = (DEPTH + 1) // 4
N_D = DEPTH // 4

kernel_name = 'hybrid_diffusion_prefix_trunk_step'


def rms_norm(x, g, eps=NORM_EPS):
    xf = x.astype(jnp.float32)
    y = xf * lax.rsqrt(jnp.mean(xf * xf, axis=-1, keepdims=True) + eps)
    return (y * g.astype(jnp.float32)).astype(x.dtype)


def grid_positions(n_tok):
    rows = n_tok // GRID_W
    t = jnp.arange(rows * GRID_W)
    return (t // GRID_W).astype(jnp.float32), (t % GRID_W).astype(jnp.float32)


def rope_1d(x, pos):
    half = x.shape[-1] // 2
    inv_freq = ROPE_THETA ** (-jnp.arange(half, dtype=jnp.float32) / half)
    ang = pos[:, None] * inv_freq[None, :]
    cos = jnp.cos(ang)[None, :, None, :]
    sin = jnp.sin(ang)[None, :, None, :]
    x1, x2 = x[..., :half], x[..., half:]
    return jnp.concatenate([x1 * cos - x2 * sin, x1 * sin + x2 * cos], axis=-1)


def rope_2d(x, pos):
    row, col = pos
    xf = x.astype(jnp.float32)
    a = x.shape[-1] // 2
    return jnp.concatenate([rope_1d(xf[..., :a], row), rope_1d(xf[..., a:], col)], axis=-1).astype(x.dtype)


def over_query_blocks(fn, q):
    B, L = q.shape[:2]
    nb = L // Q_BLOCK
    qb = jnp.moveaxis(q.reshape((B, nb, Q_BLOCK) + q.shape[2:]), 1, 0)
    ob = lax.map(fn, qb)
    return jnp.moveaxis(ob, 0, 1).reshape((B, L) + ob.shape[3:])


def dwconv3(x, w, b):
    xp = jnp.pad(x, ((0, 0), (1, 1), (0, 0)))
    return xp[:, :-2] * w[0] + xp[:, 1:-1] * w[1] + xp[:, 2:] * w[2] + b


def attn_mixer(h, w_qkv, q_g, k_g, w_o, pos, ctx_kv):
    B, L, _ = h.shape
    qd, kd = A_HEADS * A_HEAD_DIM, A_KV_HEADS * A_HEAD_DIM
    qkv = h @ w_qkv
    q = rms_norm(qkv[..., :qd].reshape(B, L, A_HEADS, A_HEAD_DIM), q_g)
    k = rms_norm(qkv[..., qd:qd + kd].reshape(B, L, A_KV_HEADS, A_HEAD_DIM), k_g)
    v = qkv[..., qd + kd:].reshape(B, L, A_KV_HEADS, A_HEAD_DIM)
    if pos is not None:
        q = rope_2d(q, pos)
        k = rope_2d(k, pos)
    if ctx_kv is None:
        k_all, v_all = k, v
    else:
        k_all = jnp.concatenate([ctx_kv[0].astype(k.dtype), k], axis=1)
        v_all = jnp.concatenate([ctx_kv[1].astype(v.dtype), v], axis=1)
    scale = A_HEAD_DIM ** -0.5

    def block(qb):
        s = jnp.einsum('bqkgd,bskd->bkgqs', qb, k_all).astype(jnp.float32) * scale
        p = jax.nn.softmax(s, axis=-1).astype(v_all.dtype)
        return jnp.einsum('bkgqs,bskd->bqkgd', p, v_all)

    o = over_query_blocks(block, q.reshape(B, L, A_KV_HEADS, A_GROUP, A_HEAD_DIM))
    return o.reshape(B, L, qd) @ w_o, k, v


def diff_mixer(h, w_qkv, lam, subln_g, w_o, layer_idx, pos, ctx_kv):
    B, L, _ = h.shape
    d = B_HEAD_DIM
    w = B_HEADS * 2 * d
    qkv = h @ w_qkv
    q = qkv[..., :w].reshape(B, L, B_HEADS, 2 * d)
    k = qkv[..., w:2 * w].reshape(B, L, B_HEADS, 2 * d)
    v = qkv[..., 2 * w:].reshape(B, L, B_HEADS, 2 * d)
    if pos is not None:
        q = rope_2d(q.reshape(B, L, 2 * B_HEADS, d), pos).reshape(B, L, B_HEADS, 2 * d)
        k = rope_2d(k.reshape(B, L, 2 * B_HEADS, d), pos).reshape(B, L, B_HEADS, 2 * d)
    lam_init = 0.8 - 0.6 * math.exp(-0.3 * layer_idx)
    lf = lam.astype(jnp.float32)
    lam_full = jnp.exp(jnp.sum(lf[0] * lf[1])) - jnp.exp(jnp.sum(lf[2] * lf[3])) + lam_init
    if ctx_kv is None:
        k_all, v_all = k, v
    else:
        k_all = jnp.concatenate([ctx_kv[0].astype(k.dtype), k], axis=1)
        v_all = jnp.concatenate([ctx_kv[1].astype(v.dtype), v], axis=1)
    k1, k2 = k_all[..., :d], k_all[..., d:]
    scale = d ** -0.5

    def block(qb):
        s1 = jnp.einsum('bqhd,bshd->bhqs', qb[..., :d], k1).astype(jnp.float32) * scale
        s2 = jnp.einsum('bqhd,bshd->bhqs', qb[..., d:], k2).astype(jnp.float32) * scale
        a = jax.nn.softmax(s1, axis=-1) - lam_full * jax.nn.softmax(s2, axis=-1)
        return jnp.einsum('bhqs,bshe->bqhe', a.astype(v_all.dtype), v_all)

    o = over_query_blocks(block, q)
    o = rms_norm(o, subln_g, B_SUBLN_EPS) * (1.0 - lam_init)
    return o.reshape(B, L, w) @ w_o, k, v


def retention_scan(q, k, v, log_g, s0):
    B, L, H, _ = q.shape
    nc = L // C_CHUNK
    idx = jnp.arange(C_CHUNK, dtype=jnp.float32)
    rel = idx[:, None] - idx[None, :]
    causal = rel >= 0
    intra = jnp.where(causal[None], jnp.exp(jnp.where(causal, rel, 0.0)[None] * log_g[:, None, None]), 0.0)
    q_dec = jnp.exp((idx + 1.0)[:, None] * log_g[None, :])
    k_dec = jnp.exp((C_CHUNK - 1.0 - idx)[:, None] * log_g[None, :])
    chunk_dec = jnp.exp(C_CHUNK * log_g)

    def to_chunks(t):
        return jnp.moveaxis(t.reshape(B, nc, C_CHUNK, H, t.shape[-1]), 1, 0)

    def step(s, qkv_c):
        qc, kc, vc = qkv_c
        sc = jnp.einsum('bnhd,bmhd->bhnm', qc, kc) * intra[None]
        o = jnp.einsum('bhnm,bmhe->bnhe', sc, vc) + jnp.einsum('bnhd,bhde->bnhe', qc, s) * q_dec[None, :, :, None]
        s = s * chunk_dec[None, :, None, None] + jnp.einsum('bmhd,bmhe->bhde', kc * k_dec[None, :, :, None], vc)
        return s, o

    s_fin, o = lax.scan(step, s0, (to_chunks(q), to_chunks(k), to_chunks(v)))
    return jnp.moveaxis(o, 0, 1).reshape(B, L, H, v.shape[-1]), s_fin


def ret_mixer(h, w_in, log_decay, gn_g, w_o, s0):
    B, L, _ = h.shape
    qk, vd = C_HEADS * C_KEY_DIM, C_HEADS * C_VAL_DIM
    proj = h @ w_in
    q = proj[..., :qk].reshape(B, L, C_HEADS, C_KEY_DIM).astype(jnp.float32)
    k = proj[..., qk:2 * qk].reshape(B, L, C_HEADS, C_KEY_DIM).astype(jnp.float32) * (C_KEY_DIM ** -0.5)
    v = proj[..., 2 * qk:2 * qk + vd].reshape(B, L, C_HEADS, C_VAL_DIM).astype(jnp.float32)
    g = proj[..., 2 * qk + vd:]
    log_g = -jnp.abs(log_decay.astype(jnp.float32))
    if s0 is None:
        s0 = jnp.zeros((B, 2, C_HEADS, C_KEY_DIM, C_VAL_DIM), jnp.float32)
    else:
        s0 = s0.astype(jnp.float32)
    o_f, s_f = retention_scan(q, k, v, log_g[0], s0[:, 0])
    o_b, s_b = retention_scan(q[:, ::-1], k[:, ::-1], v[:, ::-1], log_g[1], s0[:, 1])
    o = rms_norm(o_f + o_b[:, ::-1], gn_g.reshape(C_HEADS, C_VAL_DIM)).astype(h.dtype)
    out = (jax.nn.silu(g) * o.reshape(B, L, vd)) @ w_o
    return out, jnp.stack([s_f, s_b], axis=1).astype(h.dtype)


def hyena_filters(L, w1, b1, w2, b2, w3, freq):
    t = jnp.arange(L, dtype=jnp.float32)
    t_norm = t / max(L - 1, 1)
    bands = jnp.linspace(1e-4, D_BANDS - 1, D_BANDS, dtype=jnp.float32)
    ang = 2.0 * math.pi * t[:, None] * bands[None, :] / L
    z = jnp.concatenate([t_norm[:, None], jnp.cos(ang), -jnp.sin(ang)], axis=-1)
    a = jnp.sin(freq[0] * (z @ w1 + b1))
    a = jnp.sin(freq[1] * (a @ w2 + b2))
    filt = (a @ w3).astype(jnp.float32).reshape(L, D_DIRS, D_ORDER, D_MODEL)
    max_decay = math.log(D_DECAY_TARGET) / D_FAST_DECAY_PCT
    min_decay = math.log(D_DECAY_TARGET) / D_SLOW_DECAY_PCT
    deltas = jnp.abs(jnp.linspace(min_decay, max_decay, D_MODEL, dtype=jnp.float32))
    window = jnp.exp(-t_norm[:, None] * deltas[None, :]) + D_MOD_SHIFT
    filt = filt * window[:, None, None, :]
    return filt / (jnp.sum(jnp.abs(filt), axis=0, keepdims=True) + 1e-6)


def fft_conv(u, h):
    L = u.shape[1]
    uf = jnp.fft.rfft(u, n=2 * L, axis=1)
    hf = jnp.fft.rfft(h, n=2 * L, axis=0)
    return jnp.fft.irfft(uf * hf[None], n=2 * L, axis=1)[:, :L]


def hyena_mixer(h, w_in, sc_w, sc_b, f_w1, f_b1, f_w2, f_b2, f_w3, f_freq, f_skip, w_o):
    B, L, _ = h.shape
    z = dwconv3(h @ w_in, sc_w, sc_b).astype(jnp.float32)
    x1, x2, v = jnp.split(z, 3, axis=-1)
    filt = hyena_filters(L, f_w1, f_b1, f_w2, f_b2, f_w3, f_freq)
    skip = f_skip.astype(jnp.float32)
    y = v
    for n, gate in enumerate((x1, x2)):
        fwd = fft_conv(y, filt[:, 0, n])
        bwd = fft_conv(y[:, ::-1], filt[:, 1, n])[:, ::-1]
        y = gate * (fwd + bwd + skip[n] * y)
    return y.astype(h.dtype) @ w_o


def conv_ffn(h, w_up, cw, cb, w_down):
    a, b = jnp.split(dwconv3(h @ w_up, cw, cb), 2, axis=-1)
    return (jax.nn.silu(a) * b) @ w_down


def trunk(x, cond, latent, cache, W):
    L = x.shape[1]
    pos = grid_positions(L) if latent else None
    new = {'attn_k': [], 'attn_v': [], 'diff_k': [], 'diff_v': [], 'ret_s': []}
    for l in range(DEPTH):
        m, j = l % N_MIXERS, l // N_MIXERS
        mod = (jax.nn.silu(cond) @ W['w_mod'][l] + W['b_mod'][l])[:, None, :]
        sh1, sc1, g1, sh2, sc2, g2 = jnp.split(mod, 6, axis=-1)
        h = rms_norm(x, W['norm1_g'][l]) * (1.0 + sc1) + sh1
        if m == 0:
            ctx = (cache['attn_k'][:, j], cache['attn_v'][:, j]) if latent else None
            o, k, v = attn_mixer(h, W['attn_w_qkv'][j], W['attn_q_g'][j], W['attn_k_g'][j], W['attn_w_o'][j], pos, ctx)
            if not latent:
                new['attn_k'].append(k)
                new['attn_v'].append(v)
        elif m == 1:
            ctx = (cache['diff_k'][:, j], cache['diff_v'][:, j]) if latent else None
            o, k, v = diff_mixer(h, W['diff_w_qkv'][j], W['diff_lambda'][j], W['diff_subln_g'][j], W['diff_w_o'][j], l, pos, ctx)
            if not latent:
                new['diff_k'].append(k)
                new['diff_v'].append(v)
        elif m == 2:
            s0 = cache['ret_s'][:, j] if latent else None
            o, s = ret_mixer(h, W['ret_w_in'][j], W['ret_log_decay'][j], W['ret_gn_g'][j], W['ret_w_o'][j], s0)
            if not latent:
                new['ret_s'].append(s)
        else:
            o = hyena_mixer(h, W['hyena_w_in'][j], W['hyena_sc_w'][j], W['hyena_sc_b'][j], W['hyena_f_w1'][j], W['hyena_f_b1'][j], W['hyena_f_w2'][j], W['hyena_f_b2'][j], W['hyena_f_w3'][j], W['hyena_f_freq'][j], W['hyena_f_skip'][j], W['hyena_w_o'][j])
        x = x + g1 * o
        h = rms_norm(x, W['norm2_g'][l]) * (1.0 + sc2) + sh2
        x = x + g2 * conv_ffn(h, W['ffn_w_up'][l], W['ffn_conv_w'][l], W['ffn_conv_b'][l], W['ffn_w_down'][l])
    return rms_norm(x, W['final_g']), new


def setup_inputs(seed: int = 0) -> dict:
    key = jax.random.key(seed)
    ks = iter(jax.random.split(key, 64))
    f32 = jnp.float32
    D = D_MODEL

    def nrm(shape, scale):
        return jax.random.normal(next(ks), shape, f32) * scale

    def gain(shape):
        return 1.0 + nrm(shape, 0.02)

    base_decay = jnp.log(1.0 - 2.0 ** (-5.0 - jnp.arange(C_HEADS, dtype=f32)))
    inp = {}
    inp['x_prompt'] = nrm((BATCH, SEQ, D), 1.0)
    inp['x_sample'] = nrm((DEC_BATCH, DEC_SEQ, D), 1.0)
    inp['cache_attn_k'] = nrm((DEC_BATCH, N_A, PAST_LEN, A_KV_HEADS, A_HEAD_DIM), 1.0)
    inp['cache_attn_v'] = nrm((DEC_BATCH, N_A, PAST_LEN, A_KV_HEADS, A_HEAD_DIM), 1.0)
    inp['cache_diff_k'] = nrm((DEC_BATCH, N_B, PAST_LEN, B_HEADS, 2 * B_HEAD_DIM), 1.0)
    inp['cache_diff_v'] = nrm((DEC_BATCH, N_B, PAST_LEN, B_HEADS, 2 * B_HEAD_DIM), 1.0)
    inp['state_ret'] = nrm((DEC_BATCH, N_C, 2, C_HEADS, C_KEY_DIM, C_VAL_DIM), 1.0)
    inp['c'] = nrm((DEC_BATCH, D), 1.0)
    inp['c_ctx'] = nrm((D,), 1.0)
    inp['w_mod'] = nrm((DEPTH, D, 6 * D), D ** -0.5)
    inp['b_mod'] = nrm((DEPTH, 6 * D), 0.01)
    inp['norm1_g'] = gain((DEPTH, D))
    inp['norm2_g'] = gain((DEPTH, D))
    inp['final_g'] = gain((D,))
    inp['attn_w_qkv'] = nrm((N_A, D, (A_HEADS + 2 * A_KV_HEADS) * A_HEAD_DIM), D ** -0.5)
    inp['attn_q_g'] = gain((N_A, A_HEAD_DIM))
    inp['attn_k_g'] = gain((N_A, A_HEAD_DIM))
    inp['attn_w_o'] = nrm((N_A, A_HEADS * A_HEAD_DIM, D), (A_HEADS * A_HEAD_DIM) ** -0.5)
    inp['diff_w_qkv'] = nrm((N_B, D, 3 * B_HEADS * 2 * B_HEAD_DIM), D ** -0.5)
    inp['diff_lambda'] = nrm((N_B, 4, B_HEAD_DIM), 0.1)
    inp['diff_subln_g'] = gain((N_B, 2 * B_HEAD_DIM))
    inp['diff_w_o'] = nrm((N_B, B_HEADS * 2 * B_HEAD_DIM, D), (B_HEADS * 2 * B_HEAD_DIM) ** -0.5)
    inp['ret_w_in'] = nrm((N_C, D, 2 * C_HEADS * C_KEY_DIM + 2 * C_HEADS * C_VAL_DIM), D ** -0.5)
    inp['ret_log_decay'] = base_decay[None, None, :] * jnp.exp(nrm((N_C, 2, C_HEADS), 0.1))
    inp['ret_gn_g'] = gain((N_C, C_HEADS * C_VAL_DIM))
    inp['ret_w_o'] = nrm((N_C, C_HEADS * C_VAL_DIM, D), (C_HEADS * C_VAL_DIM) ** -0.5)
    inp['hyena_w_in'] = nrm((N_D, D, 3 * D), D ** -0.5)
    inp['hyena_sc_w'] = nrm((N_D, 3, 3 * D), 3 ** -0.5)
    inp['hyena_sc_b'] = nrm((N_D, 3 * D), 0.01)
    inp['hyena_f_w1'] = nrm((N_D, D_EMB, D_FILTER_HIDDEN), D_EMB ** -0.5)
    inp['hyena_f_b1'] = nrm((N_D, D_FILTER_HIDDEN), 0.01)
    inp['hyena_f_w2'] = nrm((N_D, D_FILTER_HIDDEN, D_FILTER_HIDDEN), D_FILTER_HIDDEN ** -0.5)
    inp['hyena_f_b2'] = nrm((N_D, D_FILTER_HIDDEN), 0.01)
    inp['hyena_f_w3'] = nrm((N_D, D_FILTER_HIDDEN, D_DIRS * D_ORDER * D), D_FILTER_HIDDEN ** -0.5)
    inp['hyena_f_freq'] = gain((N_D, 2, D_FILTER_HIDDEN))
    inp['hyena_f_skip'] = nrm((N_D, D_ORDER, D), 0.5)
    inp['hyena_w_o'] = nrm((N_D, D, D), D ** -0.5)
    inp['ffn_w_up'] = nrm((DEPTH, D, 2 * FFN_DIM), D ** -0.5)
    inp['ffn_conv_w'] = nrm((DEPTH, 3, 2 * FFN_DIM), 3 ** -0.5)
    inp['ffn_conv_b'] = nrm((DEPTH, 2 * FFN_DIM), 0.01)
    inp['ffn_w_down'] = nrm((DEPTH, FFN_DIM, D), FFN_DIM ** -0.5)
    return inp


def reference(x_prompt, x_sample, cache_attn_k, cache_attn_v, cache_diff_k, cache_diff_v, state_ret, c, c_ctx, w_mod, b_mod, norm1_g, norm2_g, final_g, attn_w_qkv, attn_q_g, attn_k_g, attn_w_o, diff_w_qkv, diff_lambda, diff_subln_g, diff_w_o, ret_w_in, ret_log_decay, ret_gn_g, ret_w_o, hyena_w_in, hyena_sc_w, hyena_sc_b, hyena_f_w1, hyena_f_b1, hyena_f_w2, hyena_f_b2, hyena_f_w3, hyena_f_freq, hyena_f_skip, hyena_w_o, ffn_w_up, ffn_conv_w, ffn_conv_b, ffn_w_down):
    W = {
        'w_mod': w_mod, 'b_mod': b_mod, 'norm1_g': norm1_g, 'norm2_g': norm2_g, 'final_g': final_g,
        'attn_w_qkv': attn_w_qkv, 'attn_q_g': attn_q_g, 'attn_k_g': attn_k_g, 'attn_w_o': attn_w_o,
        'diff_w_qkv': diff_w_qkv, 'diff_lambda': diff_lambda, 'diff_subln_g': diff_subln_g, 'diff_w_o': diff_w_o,
        'ret_w_in': ret_w_in, 'ret_log_decay': ret_log_decay, 'ret_gn_g': ret_gn_g, 'ret_w_o': ret_w_o,
        'hyena_w_in': hyena_w_in, 'hyena_sc_w': hyena_sc_w, 'hyena_sc_b': hyena_sc_b,
        'hyena_f_w1': hyena_f_w1, 'hyena_f_b1': hyena_f_b1, 'hyena_f_w2': hyena_f_w2, 'hyena_f_b2': hyena_f_b2,
        'hyena_f_w3': hyena_f_w3, 'hyena_f_freq': hyena_f_freq, 'hyena_f_skip': hyena_f_skip, 'hyena_w_o': hyena_w_o,
        'ffn_w_up': ffn_w_up, 'ffn_conv_w': ffn_conv_w, 'ffn_conv_b': ffn_conv_b, 'ffn_w_down': ffn_w_down,
    }
    y_prompt, st = trunk(x_prompt, c_ctx[None, :], False, None, W)
    cache = {'attn_k': cache_attn_k, 'attn_v': cache_attn_v, 'diff_k': cache_diff_k, 'diff_v': cache_diff_v, 'ret_s': state_ret}
    y_sample, _ = trunk(x_sample, c, True, cache, W)
    new_attn_k = jnp.stack(st['attn_k'], axis=1)
    new_attn_v = jnp.stack(st['attn_v'], axis=1)
    new_diff_k = jnp.stack(st['diff_k'], axis=1)
    new_diff_v = jnp.stack(st['diff_v'], axis=1)
    new_state_ret = jnp.stack(st['ret_s'], axis=1)
    return (y_prompt, y_sample, new_attn_k, new_attn_v, new_diff_k, new_diff_v, new_state_ret)
```

```cpp
#include <hip/hip_runtime.h>
#include <hip/hip_cooperative_groups.h>
#include <cstdio>
namespace cg = cooperative_groups;

#ifndef MULTI_LAUNCH
#define MULTI_LAUNCH 0
#endif

#define LAS __attribute__((address_space(3)))
typedef unsigned short bf16_t;
typedef short bf16x8 __attribute__((ext_vector_type(8)));
typedef float f32x4 __attribute__((ext_vector_type(4)));
typedef float f32x16 __attribute__((ext_vector_type(16)));
typedef unsigned u32x4 __attribute__((ext_vector_type(4)));
typedef unsigned u32x2 __attribute__((ext_vector_type(2)));

constexpr int NT = 16384;
constexpr int NTP = 8192;
constexpr int DM = 1024;
constexpr int FF = 2816;
constexpr int LDS_BYTES = 155648;
constexpr size_t MiB = 1048576;
constexpr size_t WS_MOD = 0;
constexpr size_t WS_IDENT = 512 * 1024;
constexpr size_t WS_SLOT = 2 * 1048576;
constexpr size_t WS_SLOT_BYTES = 64 * 4 * 256 * 8;
constexpr size_t WS_PSLOT = WS_SLOT + WS_SLOT_BYTES;
constexpr size_t WS_PSLOT_BYTES = 512 * 2 * 128 * 8;
constexpr size_t WS_DQMAX = WS_PSLOT + WS_PSLOT_BYTES + 16;
constexpr size_t WS_CKMAX = WS_PSLOT + WS_PSLOT_BYTES;
constexpr size_t WS_BAR = 1024 * 1024;
constexpr size_t WS_WMIX = 4 * MiB;
constexpr size_t WS_WFFN = 22 * MiB;
constexpr size_t WS_H = 40 * MiB;
constexpr size_t WS_U = 72 * MiB;
constexpr size_t WS_X = 264 * MiB;
constexpr size_t WS_IDENTW = 364 * MiB;
constexpr size_t WS_NEED = 368 * MiB;
constexpr size_t XR_OFF = 32 * 1048576;
constexpr size_t OUT_NAK = 16777216, OUT_NAV = 18874368, OUT_NDK = 20971520, OUT_NDV = 29360128, OUT_NSR = 37748736;

struct Params { const float* in[41]; float* out; unsigned char* ws; };
typedef const __attribute__((address_space(4))) Params* KParamsPtr;
constexpr int LDS_RETPARAM = 148 * 1024;

enum { I_XP = 0, I_XS, I_CAK, I_CAV, I_CDK, I_CDV, I_SRET, I_C, I_CCTX, I_WMOD, I_BMOD, I_N1G, I_N2G, I_FG, I_AQKV, I_AQG, I_AKG, I_AWO,
       I_DQKV, I_DLAM, I_DSUB, I_DWO, I_RWIN, I_RLD, I_RGN, I_RWO, I_HWIN, I_HSCW, I_HSCB, I_HW1, I_HB1, I_HW2, I_HB2, I_HW3, I_HFREQ, I_HSKIP, I_HWO,
       I_FUP, I_FCW, I_FCB, I_FDOWN };

__device__ __forceinline__ int otid() { int t = (int)threadIdx.x; asm volatile("" : "+v"(t)); return t; }
typedef float f32x2v __attribute__((ext_vector_type(2)));
typedef __bf16 bf16x2v __attribute__((ext_vector_type(2)));
__device__ __forceinline__ unsigned cvt_pk_bf16(float lo, float hi) { const f32x2v v = {lo, hi}; const bf16x2v b = __builtin_convertvector(v, bf16x2v); return __builtin_bit_cast(unsigned, b); }
__device__ __forceinline__ bf16_t f2bf(float f) { return (bf16_t)(cvt_pk_bf16(f, 0.f) & 0xffffu); }
__device__ __forceinline__ float bf2f(bf16_t b) { return __uint_as_float(((unsigned)b) << 16); }
__device__ __forceinline__ float bflo(unsigned w) { return __uint_as_float(w << 16); }
__device__ __forceinline__ float bfhi(unsigned w) { return __uint_as_float(w & 0xffff0000u); }
__device__ __forceinline__ float shfl_xor_f(float v, int m) { return __int_as_float(__builtin_amdgcn_ds_bpermute((((int)(otid() & 63)) ^ m) << 2, __float_as_int(v))); }
__device__ __forceinline__ float wave_sum(float v) {
#pragma unroll
    for (int o = 32; o >= 1; o >>= 1) v += shfl_xor_f(v, o);
    return v;
}
__device__ __forceinline__ float fast_exp2(float x) { return __builtin_amdgcn_exp2f(x); }
__device__ __forceinline__ float siluf(float x) { return x * __builtin_amdgcn_rcpf(1.0f + __expf(-x)); }
__device__ __forceinline__ float sin_rr(float x) { float r = x * 0.15915494309189535f; r -= rintf(r); return __builtin_amdgcn_sinf(r); }
__device__ __forceinline__ float cos_rr(float x) { float r = x * 0.15915494309189535f; r -= rintf(r); return __builtin_amdgcn_cosf(r); }
__device__ __forceinline__ float sin_rev(float r) { r -= rintf(r); return __builtin_amdgcn_sinf(r); }
__device__ __forceinline__ float cos_rev(float r) { r -= rintf(r); return __builtin_amdgcn_cosf(r); }

__device__ __forceinline__ void xcd_barrier(unsigned* bar, volatile LAS unsigned* st);
namespace pg8 {
constexpr int BM = 256, BK = 64, HALF = 128, HTB = HALF * BK * 2, STAGE_BYTES = 8 * HTB, NXCD = 8, WGM = 8;
__device__ __forceinline__ int lds_byte(int r, int c) { const int st = (r >> 4) * 2 + (c >> 5), rr = r & 15, cc = c & 31, ob = rr * 64 + cc * 2; return st * 1024 + (ob ^ (((ob >> 9) & 1) << 5)); }
__device__ __forceinline__ void stage_rc(int b, int& R, int& C) { const int st = b / 1024, sb = b % 1024, swz = sb ^ (((sb >> 9) & 1) << 5); R = (st >> 1) * 16 + swz / 64; C = (st & 1) * 32 + (swz % 64) / 2; }
__device__ __forceinline__ int perm32(int rho) { const int n = rho >> 4, i = rho & 15; return 8 * (i >> 2) + 4 * n + (i & 3); }
struct Unit { int pm, pn; };
struct Gemm { const bf16_t* A; const bf16_t* Bt; int M, N, K; };
struct StaticOrder {
    int nM, nN, nwg, G, c;
    __device__ void init(int M, int N, int G_, int c_) { nM = M / BM; nN = N / BM; nwg = nM * nN; G = G_; c = c_; }
    __device__ bool next(int i, Unit& u) const {
        const long L = (long)i * G + c; if (L >= nwg) return false;
        int wgid = (int)L; { const int q = nwg / NXCD, r = nwg % NXCD, xcd = wgid % NXCD, off = wgid / NXCD; wgid = (xcd < r ? xcd * (q + 1) : r * (q + 1) + (xcd - r) * q) + off; }
        const int nig = WGM * nN, gid = wgid / nig, fm = gid * WGM, gsz = (nM - fm) < WGM ? (nM - fm) : WGM;
        u.pm = fm + ((wgid % nig) % gsz); u.pn = (wgid % nig) / gsz; return true;
    }
    __device__ __forceinline__ void a_ready(const Unit&) const {}
    __device__ __forceinline__ void done(const Unit&) const {}
};
struct EpiBf16 {
    static constexpr bool PERM = true, AFTER_DRAIN = false;
    bf16_t* O; int ldc;
    __device__ __forceinline__ void operator()(const f32x4 (&acc)[2][2][4][2], const Unit& u, int wr, int wc, int fr, int fq) const {
        const int row0 = u.pm * BM + wr * 64 + fr; const int col0 = u.pn * BM + wc * 32 + 8 * fq;
#pragma unroll
        for (int ai = 0; ai < 2; ++ai)
#pragma unroll
            for (int m = 0; m < 4; ++m) { bf16_t* rowp = O + (size_t)(row0 + ai * HALF + m * 16) * ldc + col0;
#pragma unroll
                for (int bj = 0; bj < 2; ++bj) { f32x4 v0 = acc[ai][bj][m][0], v1 = acc[ai][bj][m][1];
                    u32x4 w; w.x = cvt_pk_bf16(v0[0], v0[1]); w.y = cvt_pk_bf16(v0[2], v0[3]); w.z = cvt_pk_bf16(v1[0], v1[1]); w.w = cvt_pk_bf16(v1[2], v1[3]);
                    *(u32x4*)(rowp + bj * HALF) = w; } }
    }
};
struct EpiRes {
    static constexpr bool PERM = false, AFTER_DRAIN = true;
    bf16_t* X; const float* mod; int goff;
    bf16_t* An; const float* gnext; int scoff, shoff; unsigned long long* slots; unsigned tag; int fin; float* Y; unsigned* bar;
    __device__ __forceinline__ void fused(f32x4 (&acc)[2][2][4][2], const Unit& u, int wr, int wc, int fr, int fq, LAS unsigned char* lds) const {
        const int row0 = u.pm * BM + wr * 64 + fr, col0 = u.pn * BM + wc * 32 + 4 * fq;
        const int cond = u.pm < 32 ? 0 : (u.pm < 48 ? 1 : 2);
        const float* gp = mod + cond * 24576 + goff + col0;
        f32x4 gv[2][2];
#pragma unroll
        for (int bj = 0; bj < 2; ++bj)
#pragma unroll
            for (int n = 0; n < 2; ++n) gv[bj][n] = *(const f32x4*)(gp + bj * HALF + n * 16);
        float ss[2][4];
#pragma unroll
        for (int ai = 0; ai < 2; ++ai)
#pragma unroll
            for (int m = 0; m < 4; ++m) { bf16_t* rowp = X + (size_t)(row0 + ai * HALF + m * 16) * DM + col0; float t = 0.f;
#pragma unroll
                for (int bj = 0; bj < 2; ++bj)
#pragma unroll
                    for (int n = 0; n < 2; ++n) { u32x2* p = (u32x2*)(rowp + bj * HALF + n * 16); const u32x2 w = *p; f32x4 v = (f32x4){bflo(w.x), bfhi(w.x), bflo(w.y), bfhi(w.y)}; v += gv[bj][n] * acc[ai][bj][m][n];
                        if (!fin) *p = (u32x2){cvt_pk_bf16(v[0], v[1]), cvt_pk_bf16(v[2], v[3])}; acc[ai][bj][m][n] = v; t += v[0] * v[0] + v[1] * v[1] + v[2] * v[2] + v[3] * v[3]; }
                ss[ai][m] = t; }
        if (An == nullptr && !fin) return;
        LAS float* xl = (LAS float*)lds;
#pragma unroll
        for (int ai = 0; ai < 2; ++ai)
#pragma unroll
            for (int m = 0; m < 4; ++m) { float t = ss[ai][m]; t += shfl_xor_f(t, 16); t += shfl_xor_f(t, 32); if (fq == 0) xl[(ai * HALF + wr * 64 + m * 16 + fr) * 4 + wc] = t; }
        __syncthreads();
        const int tid = otid();
        if (tid < 256) {
            const f32x4 q = *(const LAS f32x4*)(xl + tid * 4); const float mine = q[0] + q[1] + q[2] + q[3];
            unsigned long long* sp = slots + ((size_t)u.pm * 4) * 256 + tid;
            (void)__hip_atomic_exchange(sp + (size_t)u.pn * 256, ((unsigned long long)tag << 32) | (unsigned long long)__float_as_uint(mine), __ATOMIC_RELAXED, __HIP_MEMORY_SCOPE_AGENT);
            float tot = mine;
#pragma unroll
            for (int k = 1; k < 4; ++k) { unsigned long long* o = sp + (size_t)((u.pn + k) & 3) * 256; unsigned long long v; unsigned spin = 0;
                for (;;) { v = __hip_atomic_load(o, __ATOMIC_RELAXED, __HIP_MEMORY_SCOPE_AGENT); if ((unsigned)(v >> 32) == tag) break; __builtin_amdgcn_s_sleep(1); if (++spin > (1u << 22)) break; }
                tot += __uint_as_float((unsigned)v); }
            xl[1024 + tid] = rsqrtf(tot * (1.0f / 1024.0f) + 1e-6f);
        }
        __syncthreads();
        if (fin) {
            xcd_barrier(bar, (volatile LAS unsigned*)(lds + LDS_BYTES - 16));
#pragma unroll
            for (int ai = 0; ai < 2; ++ai)
#pragma unroll
                for (int m = 0; m < 4; ++m) { const int rl = ai * HALF + wr * 64 + m * 16 + fr; const float rs = xl[1024 + rl]; float* rowp = Y + (size_t)(u.pm * BM + rl) * DM + col0;
#pragma unroll
                    for (int bj = 0; bj < 2; ++bj)
#pragma unroll
                        for (int n = 0; n < 2; ++n) { const f32x4 g4 = *(const f32x4*)(gnext + col0 + bj * HALF + n * 16); *(f32x4*)(rowp + bj * HALF + n * 16) = acc[ai][bj][m][n] * rs * g4; } }
            return;
        }
        f32x4 Gn[2][2], Sh[2][2];
#pragma unroll
        for (int bj = 0; bj < 2; ++bj)
#pragma unroll
            for (int n = 0; n < 2; ++n) { const int c = col0 + bj * HALF + n * 16; const f32x4 g4 = *(const f32x4*)(gnext + c), s4 = *(const f32x4*)(mod + cond * 24576 + scoff + c);
                Gn[bj][n] = g4 * (s4 + 1.0f); Sh[bj][n] = *(const f32x4*)(mod + cond * 24576 + shoff + c); }
#pragma unroll
        for (int ai = 0; ai < 2; ++ai)
#pragma unroll
            for (int m = 0; m < 4; ++m) { const int rl = ai * HALF + wr * 64 + m * 16 + fr; const int row = u.pm * BM + rl; const float rs = xl[1024 + rl];
                bf16_t* op = An + (size_t)row * DM + col0;
#pragma unroll
                for (int bj = 0; bj < 2; ++bj)
#pragma unroll
                    for (int n = 0; n < 2; ++n) { const f32x4 h = acc[ai][bj][m][n] * rs * Gn[bj][n] + Sh[bj][n];
                        *(u32x2*)(op + bj * HALF + n * 16) = (u32x2){cvt_pk_bf16(h[0], h[1]), cvt_pk_bf16(h[2], h[3])}; } }
    }
};

template <class Epi, class Sched>
__device__ __forceinline__ void gemm_phase(LAS unsigned char* lds, const Gemm g, const Sched& S, const Epi& E) {
    const int tid = otid(), wid = __builtin_amdgcn_readfirstlane(tid >> 6), lane = tid & 63, wr = wid >> 2, wc = wid & 3, fr = lane & 15, fq = lane >> 4;
    const int K = g.K, nt = K / BK;
    unsigned voffA[2], voffB[2];
#pragma unroll
    for (int i = 0; i < 2; ++i) { int R, C; stage_rc(tid * 16 + i * 8192, R, C); const int Rb = Epi::PERM ? ((R & ~31) + perm32(R & 31)) : R;
        voffA[i] = (unsigned)(R * K + C) * 2u; voffB[i] = (unsigned)(Rb * K + C) * 2u; }
    const size_t kstep = (size_t)(BK * 2);
    const size_t hstep = (size_t)HALF * K * 2;
    const size_t tstep = 2 * hstep;
    const unsigned ldsw = (unsigned)wid * 1024u;
    const int aoff = lds_byte(wr * 64 + fr, fq * 8), boff = lds_byte(wc * 32 + fr, fq * 8);
#define PG8_SA(b, h) (((b) * 2 + (h)) * HTB)
#define PG8_SB(b, h) ((4 + (b) * 2 + (h)) * HTB)
#define PG8_STAGE(bufoff, gbase, voff) do { _Pragma("unroll") for (int _i = 0; _i < 2; ++_i) \
        __builtin_amdgcn_global_load_lds((const unsigned*)((const char*)(gbase) + (voff)[_i]), (LAS unsigned*)(lds + (bufoff) + ldsw + _i * 8192), 16, 0, 0); } while (0)
#define PG8_LDA(dst, b, h) do { _Pragma("unroll") for (int m = 0; m < 4; ++m) _Pragma("unroll") for (int k = 0; k < 2; ++k) dst[m][k] = *(const LAS bf16x8*)(lds + PG8_SA(b, h) + aoff + m * 2048 + k * 1024); } while (0)
#define PG8_LDB(dst, b, h) do { _Pragma("unroll") for (int n = 0; n < 2; ++n) _Pragma("unroll") for (int k = 0; k < 2; ++k) dst[n][k] = *(const LAS bf16x8*)(lds + PG8_SB(b, h) + boff + n * 2048 + k * 1024); } while (0)
#define PG8_MMA(ai, bj, At, Bt) do { __builtin_amdgcn_s_setprio(1); _Pragma("unroll") for (int m = 0; m < 4; ++m) _Pragma("unroll") for (int n = 0; n < 2; ++n) _Pragma("unroll") for (int k = 0; k < 2; ++k) \
        acc[ai][bj][m][n] = __builtin_amdgcn_mfma_f32_16x16x32_bf16(Bt[n][k], At[m][k], acc[ai][bj][m][n], 0, 0, 0); __builtin_amdgcn_s_setprio(0); } while (0)
#define PG8_WAIT_V(n) asm volatile("s_waitcnt vmcnt(" #n ")" ::: "memory")
#define PG8_WAIT_L(n) asm volatile("s_waitcnt lgkmcnt(" #n ")" ::: "memory")
#define PG8_BAR __builtin_amdgcn_s_barrier()
#define PG8_SCHED __builtin_amdgcn_sched_barrier(0)
    Unit cur, nxt; int ui = 0;
    if (!S.next(0, cur)) return;
    f32x4 acc[2][2][4][2];
#pragma unroll
    for (int a = 0; a < 2; ++a)
#pragma unroll
        for (int b = 0; b < 2; ++b)
#pragma unroll
            for (int m = 0; m < 4; ++m)
#pragma unroll
                for (int n = 0; n < 2; ++n) acc[a][b][m][n] = (f32x4){0.f, 0.f, 0.f, 0.f};
    bf16x8 At[4][2], B0[2][2], B1[2][2];
    const char* cA = (const char*)g.A + (size_t)cur.pm * tstep; const char* cB = (const char*)g.Bt + (size_t)cur.pn * tstep;
    S.a_ready(cur);
    PG8_STAGE(PG8_SB(0, 0), cB, voffB); PG8_STAGE(PG8_SA(0, 0), cA, voffA); PG8_STAGE(PG8_SB(0, 1), cB + hstep, voffB); PG8_STAGE(PG8_SA(0, 1), cA + hstep, voffA);
    if (wr == 1) PG8_BAR;
    PG8_WAIT_V(4); PG8_BAR;
    PG8_STAGE(PG8_SB(1, 0), cB + kstep, voffB); PG8_STAGE(PG8_SA(1, 0), cA + kstep, voffA); PG8_STAGE(PG8_SB(1, 1), cB + hstep + kstep, voffB);
    PG8_WAIT_V(6); PG8_BAR;
    for (;;) {
        const bool has_next = S.next(ui + 1, nxt);
        const char* nA = has_next ? (const char*)g.A + (size_t)nxt.pm * tstep : cA; const char* nB = has_next ? (const char*)g.Bt + (size_t)nxt.pn * tstep : cB;
        for (int t = 0; t < nt; t += 2) {
            const bool last = (t == nt - 2);
            const char* a1 = cA + (size_t)(t + 1) * kstep;
            const char* a2 = last ? nA : cA + (size_t)(t + 2) * kstep; const char* b2 = last ? nB : cB + (size_t)(t + 2) * kstep;
            const char* a3 = a2 + kstep; const char* b3 = b2 + kstep;
            if (last && has_next) S.a_ready(nxt);
            PG8_LDB(B0, 0, 0); PG8_SCHED; PG8_LDA(At, 0, 0); PG8_STAGE(PG8_SA(1, 1), a1 + hstep, voffA);
            PG8_WAIT_L(8); PG8_BAR; PG8_WAIT_L(0); PG8_MMA(0, 0, At, B0); PG8_BAR; PG8_SCHED;
            PG8_LDB(B1, 0, 1); PG8_STAGE(PG8_SB(0, 0), b2, voffB);
            PG8_BAR; PG8_WAIT_L(0); PG8_MMA(0, 1, At, B1); PG8_BAR;
            PG8_LDA(At, 0, 1); PG8_STAGE(PG8_SA(0, 0), a2, voffA);
            PG8_BAR; PG8_WAIT_L(0); PG8_MMA(1, 0, At, B0); PG8_BAR; PG8_SCHED;
            PG8_STAGE(PG8_SB(0, 1), b2 + hstep, voffB);
            PG8_WAIT_V(6); PG8_BAR; PG8_MMA(1, 1, At, B1); PG8_BAR;
            PG8_LDB(B0, 1, 0); PG8_SCHED; PG8_LDA(At, 1, 0); PG8_STAGE(PG8_SA(0, 1), a2 + hstep, voffA);
            PG8_WAIT_L(8); PG8_BAR; PG8_WAIT_L(0); PG8_MMA(0, 0, At, B0); PG8_BAR; PG8_SCHED;
            PG8_LDB(B1, 1, 1); PG8_STAGE(PG8_SB(1, 0), b3, voffB);
            PG8_BAR; PG8_WAIT_L(0); PG8_MMA(0, 1, At, B1); PG8_BAR;
            PG8_LDA(At, 1, 1); PG8_STAGE(PG8_SA(1, 0), a3, voffA);
            PG8_BAR; PG8_WAIT_L(0); PG8_MMA(1, 0, At, B0); PG8_BAR; PG8_SCHED;
            PG8_STAGE(PG8_SB(1, 1), b3 + hstep, voffB);
            PG8_WAIT_V(6); PG8_BAR; PG8_MMA(1, 1, At, B1); PG8_BAR;
        }
        if constexpr (!Epi::AFTER_DRAIN) { E(acc, cur, wr, wc, fr, fq); S.done(cur); }
        if (!has_next) break;
#pragma unroll
        for (int a = 0; a < 2; ++a)
#pragma unroll
            for (int b = 0; b < 2; ++b)
#pragma unroll
                for (int m = 0; m < 4; ++m)
#pragma unroll
                    for (int n = 0; n < 2; ++n) acc[a][b][m][n] = (f32x4){0.f, 0.f, 0.f, 0.f};
        cur = nxt; cA = nA; cB = nB; ++ui;
    }
    PG8_WAIT_V(0);
    if (wr == 0) PG8_BAR;
    PG8_BAR;
    if constexpr (Epi::AFTER_DRAIN) { E.fused(acc, cur, wr, wc, fr, fq, lds); S.done(cur); }
#undef PG8_SA
#undef PG8_SB
#undef PG8_STAGE
#undef PG8_LDA
#undef PG8_LDB
#undef PG8_MMA
#undef PG8_WAIT_V
#undef PG8_WAIT_L
#undef PG8_BAR
#undef PG8_SCHED
}
}

template <bool P16 = false>
__device__ __forceinline__ void wconv_tile(const float* __restrict__ src, int N, bf16_t* __restrict__ dst, int ldd, int kt, int ntile, LAS float* tl) {
    const int tid = otid();
#pragma unroll
    for (int i = 0; i < 2; ++i) { const int k = (tid >> 4) + 32 * i, n4 = (tid & 15) * 4;
        const f32x4 v = *(const f32x4*)(src + (size_t)(kt * 64 + k) * N + ntile * 64 + n4);
        tl[k * 65 + n4] = v[0]; tl[k * 65 + n4 + 1] = v[1]; tl[k * 65 + n4 + 2] = v[2]; tl[k * 65 + n4 + 3] = v[3]; }
    __syncthreads();
    { const int n = tid >> 3, k8 = (tid & 7) * 8; u32x4 w;
      w.x = cvt_pk_bf16(tl[(k8 + 0) * 65 + n], tl[(k8 + 1) * 65 + n]); w.y = cvt_pk_bf16(tl[(k8 + 2) * 65 + n], tl[(k8 + 3) * 65 + n]);
      w.z = cvt_pk_bf16(tl[(k8 + 4) * 65 + n], tl[(k8 + 5) * 65 + n]); w.w = cvt_pk_bf16(tl[(k8 + 6) * 65 + n], tl[(k8 + 7) * 65 + n]);
      if (P16) { const int odd = (tid & 1); bf16_t* d = dst + (size_t)(ntile * 64 + n) * ldd + kt * 64;
          *(u32x2*)(d + (odd ? k8 - 4 : k8)) = (u32x2){w.x, w.y}; *(u32x2*)(d + (odd ? k8 + 4 : k8 + 8)) = (u32x2){w.z, w.w}; }
      else *(u32x4*)(dst + (size_t)(ntile * 64 + n) * ldd + kt * 64 + k8) = w; }
    __syncthreads();
}
__device__ void wconv(const float* src, int K, int N, bf16_t* dst, LAS unsigned char* lds, int& rot) {
    const int nk = K / 64, nn = N / 64, tot = nk * nn;
    int start = (int)blockIdx.x - rot; while (start < 0) start += gridDim.x;
    for (int it = start; it < tot; it += gridDim.x) wconv_tile(src, N, dst, K, it / nn, it % nn, (LAS float*)lds);
    rot = (rot + tot) % (int)gridDim.x;
}
template <int NQ, bool P16 = false>
__device__ __forceinline__ void vt_tile(const bf16_t* __restrict__ src, int ld, bf16_t* __restrict__ dst, size_t ldd, LAS bf16_t* tl) {
    const int tid = otid();
    { const int r = tid >> 3, c8 = (tid & 7) * 8; u32x4 v[NQ];
#pragma unroll
      for (int q = 0; q < NQ; ++q) v[q] = *(const u32x4*)(src + (size_t)r * ld + q * 64 + c8);
#pragma unroll
      for (int q = 0; q < NQ; ++q) *(LAS u32x4*)(tl + q * 4608 + r * 72 + c8) = v[q]; }
    __syncthreads();
    { const int c = tid >> 3, t8 = (tid & 7) * 8;
#pragma unroll
      for (int q = 0; q < NQ; ++q) { unsigned w[4];
#pragma unroll
          for (int j = 0; j < 4; ++j) w[j] = (unsigned)tl[q * 4608 + (t8 + 2 * j) * 72 + c] | ((unsigned)tl[q * 4608 + (t8 + 2 * j + 1) * 72 + c] << 16);
          if (P16) { const int odd = (tid & 1); bf16_t* d = dst + (size_t)(q * 64 + c) * ldd;
              *(u32x2*)(d + (odd ? t8 - 4 : t8)) = (u32x2){w[0], w[1]}; *(u32x2*)(d + (odd ? t8 + 4 : t8 + 8)) = (u32x2){w[2], w[3]}; }
          else *(u32x4*)(dst + (size_t)(q * 64 + c) * ldd + t8) = (u32x4){w[0], w[1], w[2], w[3]}; } }
    __syncthreads();
}
template <bool P16 = false>
__device__ void vt_all(const bf16_t* U, int ld, int vc0, int C, bf16_t* VtP, bf16_t* VtS, int LK, int koff, LAS unsigned char* lds) {
    const int nct = C / 256, tot = (NT / 64) * nct;
    for (int it = blockIdx.x; it < tot; it += gridDim.x) {
        const int tt = it / nct, ct = it % nct, t0 = tt * 64;
        const bf16_t* src = U + (size_t)t0 * ld + vc0 + ct * 256;
        if (t0 < NTP) { const int b = t0 >> 8, tp = t0 & 255; vt_tile<4, P16>(src, ld, VtP + ((size_t)b * C + ct * 256) * 256 + tp, 256, (LAS bf16_t*)lds); }
        else { const int ts = t0 - NTP, b = ts >> 12, tp = ts & 4095; vt_tile<4, P16>(src, ld, VtS + ((size_t)b * C + ct * 256) * LK + koff + tp, (size_t)LK, (LAS bf16_t*)lds); }
    }
}
__device__ void norm_mod(const bf16_t* __restrict__ X, const float* __restrict__ g, const float* __restrict__ mod, int scoff, int shoff, bf16_t* __restrict__ H) {
    const int lane = otid() & 63, gw = blockIdx.x * 8 + (otid() >> 6), nw = gridDim.x * 8;
    for (int r = gw; r < NT; r += nw) {
        const int cond = r < NTP ? 0 : (r < NTP + 4096 ? 1 : 2);
        const bf16_t* xr = X + (size_t)r * DM; const float* mp = mod + cond * 24576;
        f32x4 v[4]; float ss = 0.f;
#pragma unroll
        for (int i = 0; i < 4; ++i) { const u32x2 w = *(const u32x2*)(xr + i * 256 + lane * 4); v[i] = (f32x4){bflo(w.x), bfhi(w.x), bflo(w.y), bfhi(w.y)}; ss += v[i][0] * v[i][0] + v[i][1] * v[i][1] + v[i][2] * v[i][2] + v[i][3] * v[i][3]; }
        ss = wave_sum(ss); const float rs = rsqrtf(ss * (1.0f / DM) + 1e-6f);
#pragma unroll
        for (int i = 0; i < 4; ++i) { const int c = i * 256 + lane * 4; const f32x4 gg = *(const f32x4*)(g + c), sc = *(const f32x4*)(mp + scoff + c), sh = *(const f32x4*)(mp + shoff + c);
            float o[4];
#pragma unroll
            for (int j = 0; j < 4; ++j) o[j] = v[i][j] * rs * gg[j] * (1.0f + sc[j]) + sh[j];
            *(u32x2*)(H + (size_t)r * DM + c) = (u32x2){cvt_pk_bf16(o[0], o[1]), cvt_pk_bf16(o[2], o[3])}; }
    }
}
__device__ void final_norm(float* __restrict__ X, const float* __restrict__ g) {
    const int lane = otid() & 63, gw = blockIdx.x * 8 + (otid() >> 6), nw = gridDim.x * 8;
    for (int r = gw; r < NT; r += nw) {
        float* xr = X + (size_t)r * DM; f32x4 v[4]; float ss = 0.f;
#pragma unroll
        for (int i = 0; i < 4; ++i) { v[i] = *(const f32x4*)(xr + i * 256 + lane * 4); ss += v[i][0] * v[i][0] + v[i][1] * v[i][1] + v[i][2] * v[i][2] + v[i][3] * v[i][3]; }
        ss = wave_sum(ss); const float rs = rsqrtf(ss * (1.0f / DM) + 1e-6f);
#pragma unroll
        for (int i = 0; i < 4; ++i) { const int c = i * 256 + lane * 4; const f32x4 gg = *(const f32x4*)(g + c); f32x4 o;
#pragma unroll
            for (int j = 0; j < 4; ++j) o[j] = v[i][j] * rs * gg[j];
            *(f32x4*)(xr + c) = o; }
    }
}
__device__ void prep_misc(const Params& p, LAS unsigned char* lds) {
    const int tid = otid(); const size_t gt = (size_t)blockIdx.x * 512 + tid, ng = (size_t)gridDim.x * 512;
    { const f32x4* a = (const f32x4*)p.in[I_XP]; const f32x4* b = (const f32x4*)p.in[I_XS]; u32x2* o = (u32x2*)((unsigned char*)p.out + XR_OFF); const size_t n4 = (size_t)NTP * DM / 4;
      for (size_t i = gt; i < n4; i += ng) { const f32x4 va = a[i], vb = b[i]; o[i] = (u32x2){cvt_pk_bf16(va[0], va[1]), cvt_pk_bf16(va[2], va[3])}; o[n4 + i] = (u32x2){cvt_pk_bf16(vb[0], vb[1]), cvt_pk_bf16(vb[2], vb[3])}; } }
    { bf16_t* id = (bf16_t*)(p.ws + WS_IDENT); for (size_t i = gt; i < 65536; i += ng) id[i] = ((i >> 8) == (i & 255)) ? (bf16_t)0x3F80 : (bf16_t)0; }
    { bf16_t* idw = (bf16_t*)(p.ws + WS_IDENTW); for (size_t i = gt; i < 65536; i += ng) idw[(i >> 8) * 6144 + (i & 255)] = ((i >> 8) == (i & 255)) ? (bf16_t)0x3F80 : (bf16_t)0; }
    LAS float* sc = (LAS float*)lds;
    LAS float* red = sc + 3072;
    for (int i = tid; i < 3072; i += 512) { const int c = i >> 10, k = i & 1023; const float v = c == 0 ? p.in[I_CCTX][k] : p.in[I_C][(c - 1) * 1024 + k]; sc[i] = siluf(v); }
    __syncthreads();
    float* mod = (float*)(p.ws + WS_MOD);
    for (int it = blockIdx.x; it < 4 * 96; it += gridDim.x) {
        const int l = it / 96, n0 = (it % 96) * 64, col = tid & 63, kq = tid >> 6;
        const float* w = p.in[I_WMOD] + (size_t)l * 1024 * 6144 + n0 + col;
        float a0 = 0.f, a1 = 0.f, a2 = 0.f;
#pragma unroll 8
        for (int k = kq * 128; k < kq * 128 + 128; ++k) { const float wv = w[(size_t)k * 6144]; a0 += sc[k] * wv; a1 += sc[1024 + k] * wv; a2 += sc[2048 + k] * wv; }
        red[(kq * 3 + 0) * 64 + col] = a0; red[(kq * 3 + 1) * 64 + col] = a1; red[(kq * 3 + 2) * 64 + col] = a2;
        __syncthreads();
        if (tid < 192) { const int c = tid >> 6; float s = p.in[I_BMOD][l * 6144 + n0 + col];
#pragma unroll
            for (int q = 0; q < 8; ++q) s += red[(q * 3 + c) * 64 + col];
            mod[c * 24576 + l * 6144 + n0 + col] = s; }
        __syncthreads();
    }
}

struct RopeCS { float cs[8], sn[8]; };
__device__ __forceinline__ void rope_cs8(int lane, int tp, RopeCS& r) {
    const int k = lane & 7; const float pos = (float)((k < 4) ? (tp >> 6) : (tp & 63));
#pragma unroll
    for (int j = 0; j < 8; ++j) { const float ang = pos * fast_exp2(-(float)(8 * (k & 1) + j) * (13.287712379549449f / 16.0f)); r.cs[j] = cos_rr(ang); r.sn[j] = sin_rr(ang); }
}
__device__ __forceinline__ void rope8(float* x, int lane, const RopeCS& r) {
    const bool second = (lane & 2) != 0;
#pragma unroll
    for (int j = 0; j < 8; ++j) { const float pr = shfl_xor_f(x[j], 2); x[j] = second ? (pr * r.sn[j] + x[j] * r.cs[j]) : (x[j] * r.cs[j] - pr * r.sn[j]); }
}
__device__ __forceinline__ void unpack8(const u32x4 w, float* x) {
#pragma unroll
    for (int j = 0; j < 4; ++j) { x[2 * j] = bflo(w[j]); x[2 * j + 1] = bfhi(w[j]); }
}
__device__ __forceinline__ u32x4 pack8(const float* x) { return (u32x4){cvt_pk_bf16(x[0], x[1]), cvt_pk_bf16(x[2], x[3]), cvt_pk_bf16(x[4], x[5]), cvt_pk_bf16(x[6], x[7])}; }
__device__ __forceinline__ void rms8(float* x, const float* gn) {
    float ss = 0.f;
#pragma unroll
    for (int j = 0; j < 8; ++j) ss += x[j] * x[j];
    ss += shfl_xor_f(ss, 1); ss += shfl_xor_f(ss, 2); ss += shfl_xor_f(ss, 4);
    const float rs = rsqrtf(ss * (1.0f / 64.0f) + 1e-6f);
#pragma unroll
    for (int j = 0; j < 8; ++j) x[j] = x[j] * rs * gn[j];
}
__device__ void post_attn(const Params& p, bf16_t* U, bf16_t* KS, bf16_t* VtS) {
    const int lane = otid() & 63, gw = blockIdx.x * 8 + (otid() >> 6), nw = gridDim.x * 8;
    float qg[8], kg[8];
#pragma unroll
    for (int j = 0; j < 8; ++j) { qg[j] = p.in[I_AQG][(lane & 7) * 8 + j]; kg[j] = p.in[I_AKG][(lane & 7) * 8 + j]; }
    float* nak = p.out + OUT_NAK; float* nav = p.out + OUT_NAV;
    for (int t = gw; t < NT + 512; t += nw) {
        if (t < NT) {
            const bool smp = t >= NTP; const int ts = t - NTP; const int b = smp ? (ts >> 12) : (t >> 8), tp = smp ? (ts & 4095) : (t & 255);
            bf16_t* ur = U + (size_t)t * 1536 + lane * 8;
            const u32x4 w0 = *(const u32x4*)ur, w1 = *(const u32x4*)(ur + 512), w2 = *(const u32x4*)(ur + 1024);
            RopeCS rc; if (smp) rope_cs8(lane, tp, rc);
            float x[8];
            unpack8(w0, x); rms8(x, qg); if (smp) rope8(x, lane, rc); *(u32x4*)ur = pack8(x);
            unpack8(w1, x); rms8(x, qg); if (smp) rope8(x, lane, rc); *(u32x4*)(ur + 512) = pack8(x);
            unpack8(w2, x);
            float y[8];
#pragma unroll
            for (int j = 0; j < 8; ++j) y[j] = x[j];
            rms8(y, kg); if (smp) rope8(y, lane, rc);
            if (lane < 32) {
                if (!smp) { *(u32x4*)(ur + 1024) = pack8(y); float* o = nak + (size_t)t * 256 + lane * 8; *(f32x4*)o = (f32x4){y[0], y[1], y[2], y[3]}; *(f32x4*)(o + 4) = (f32x4){y[4], y[5], y[6], y[7]}; }
                else *(u32x4*)(KS + ((size_t)b * 4352 + 256 + tp) * 256 + lane * 8) = pack8(y);
            } else if (!smp) { float* o = nav + (size_t)t * 256 + (lane - 32) * 8; *(f32x4*)o = (f32x4){x[0], x[1], x[2], x[3]}; *(f32x4*)(o + 4) = (f32x4){x[4], x[5], x[6], x[7]}; }
        } else {
            const int ci = t - NT, b = ci >> 8, m = ci & 255;
            for (int kh = 0; kh < 4; ++kh) {
                const bf16_t kb16 = f2bf(p.in[I_CAK][((size_t)(b * 256 + m) * 4 + kh) * 64 + lane]);
                KS[((size_t)b * 4352 + m) * 256 + kh * 64 + lane] = kb16;
                const float kn = wave_sum(bf2f(kb16) * bf2f(kb16));
                if (lane == 0) atomicMax((unsigned*)(p.ws + WS_CKMAX), __float_as_uint(kn));
                VtS[((size_t)(b * 4 + kh) * 64 + lane) * 4352 + m] = f2bf(p.in[I_CAV][((size_t)(b * 256 + m) * 4 + kh) * 64 + lane]);
            }
        }
    }
}
__device__ __forceinline__ float subhead_maxsq(const float* x) {
    float ss = 0.f;
#pragma unroll
    for (int j = 0; j < 8; ++j) ss += x[j] * x[j];
    ss += shfl_xor_f(ss, 1); ss += shfl_xor_f(ss, 2); ss += shfl_xor_f(ss, 4);
    ss = fmaxf(ss, shfl_xor_f(ss, 8)); ss = fmaxf(ss, shfl_xor_f(ss, 16)); ss = fmaxf(ss, shfl_xor_f(ss, 32));
    return ss;
}
__device__ void post_diff(const Params& p, bf16_t* U, bf16_t* KS, bf16_t* VtS, LAS unsigned char* lds) {
    const int lane = otid() & 63, gw = blockIdx.x * 8 + (otid() >> 6), nw = gridDim.x * 8;
    float* ndk = p.out + OUT_NDK; float* ndv = p.out + OUT_NDV;
    float qrun = 0.f, krun = 0.f;
    for (int t = gw; t < NT + 512; t += nw) {
        if (t < NT) {
            const bool smp = t >= NTP; const int ts = t - NTP; const int b = smp ? (ts >> 12) : (t >> 8), tp = smp ? (ts & 4095) : (t & 255);
            bf16_t* ur = U + (size_t)t * 3072 + lane * 8;
            float qm = 0.f, km = 0.f;
            if (!smp) {
                u32x4 w[4], wq[2];
#pragma unroll
                for (int c = 0; c < 4; ++c) w[c] = *(const u32x4*)(ur + 1024 + c * 512);
                wq[0] = *(const u32x4*)ur; wq[1] = *(const u32x4*)(ur + 512);
#pragma unroll
                for (int c = 0; c < 4; ++c) { float x[8]; unpack8(w[c], x); float* o = (c < 2 ? ndk : ndv) + (size_t)t * 1024 + (c & 1) * 512 + lane * 8;
                    if (c < 2) km = fmaxf(km, subhead_maxsq(x));
                    *(f32x4*)o = (f32x4){x[0], x[1], x[2], x[3]}; *(f32x4*)(o + 4) = (f32x4){x[4], x[5], x[6], x[7]}; }
#pragma unroll
                for (int c = 0; c < 2; ++c) { float x[8]; unpack8(wq[c], x); qm = fmaxf(qm, subhead_maxsq(x)); }
            } else {
                u32x4 w[4];
#pragma unroll
                for (int c = 0; c < 4; ++c) w[c] = *(const u32x4*)(ur + c * 512);
                RopeCS rc; rope_cs8(lane, tp, rc);
#pragma unroll
                for (int c = 0; c < 4; ++c) { float x[8]; unpack8(w[c], x); const float m2 = subhead_maxsq(x); if (c < 2) qm = fmaxf(qm, m2); else km = fmaxf(km, m2); rope8(x, lane, rc);
                    if (c < 2) *(u32x4*)(ur + c * 512) = pack8(x); else *(u32x4*)(KS + ((size_t)b * 4352 + 256 + tp) * 1024 + (c - 2) * 512 + lane * 8) = pack8(x); }
            }
            qrun = fmaxf(qrun, qm); krun = fmaxf(krun, km);
        } else {
            const int ci = t - NT, b = ci >> 8, m = ci & 255;
            for (int j = 0; j < 16; ++j) { const int c = j * 64 + lane;
                const bf16_t kb16 = f2bf(p.in[I_CDK][(size_t)(b * 256 + m) * 1024 + c]); const float kn = wave_sum(bf2f(kb16) * bf2f(kb16));
                krun = fmaxf(krun, kn);
                KS[((size_t)b * 4352 + m) * 1024 + c] = kb16;
                VtS[((size_t)b * 1024 + c) * 4352 + m] = f2bf(p.in[I_CDV][(size_t)(b * 256 + m) * 1024 + c]); }
        }
    }
    { LAS float* red = (LAS float*)lds; const int wid = otid() >> 6;
      if (lane == 0) { red[wid] = qrun; red[8 + wid] = krun; }
      __syncthreads();
      if (otid() == 0) { float a = 0.f, b2 = 0.f;
          for (int i = 0; i < 8; ++i) { a = fmaxf(a, red[i]); b2 = fmaxf(b2, red[8 + i]); }
          atomicMax((unsigned*)(p.ws + WS_DQMAX), __float_as_uint(a)); atomicMax((unsigned*)(p.ws + WS_DQMAX) + 1, __float_as_uint(b2)); }
      __syncthreads(); }
}

struct FlashArgs {
    const bf16_t* q; int ldq;
    const bf16_t* k; int ldk;
    const bf16_t* vt; int ldvt;
    const bf16_t* ident;
    int nreal, ntiles, kcol;
    bf16_t* out; int ldo;
    float* outf;
    float qscale; float fixm;
    float lgf, lgb; int n0, L, dir, half;
    float lam, onem; const float* subg;
};

template <int DK, int DV, int MODE, bool FXC = false>
__device__ __forceinline__ void flash_item(LAS unsigned char* lds, const FlashArgs& a) {
    constexpr int KW = (MODE == 1) ? 2 * DK : DK, KLD = KW + 8, VLD = 72, KB = 64 * KLD * 2, VB = DV * VLD * 2, STG = KB + VB;
    constexpr int NKC = KW / 64, NVC = DV / 64, NS = DK / 16, ND = DV / 32;
    static_assert(2 * STG <= LDS_BYTES, "lds");
    const int tid = otid(), lane = tid & 63, lr = lane & 31, g = lane >> 5;
    bf16x8 qf[NS];
#pragma unroll
    for (int s = 0; s < NS; ++s) {
        u32x4 w = *(const u32x4*)(a.q + (size_t)lr * a.ldq + s * 16 + g * 8);
        if (MODE <= 1) {
#pragma unroll
            for (int j = 0; j < 4; ++j) w[j] = cvt_pk_bf16(bflo(w[j]) * a.qscale, bfhi(w[j]) * a.qscale);
        }
        qf[s] = __builtin_bit_cast(bf16x8, w);
    }
    f32x16 O[ND];
#pragma unroll
    for (int d = 0; d < ND; ++d)
#pragma unroll
        for (int r = 0; r < 16; ++r) O[d][r] = 0.f;
    float m_run = -1e30f, l_run = 0.f;
    if constexpr (MODE >= 2) {
        static_assert(DK == 256 && DV == 128, "ret path shapes");
        constexpr int KB2 = 64 * 512, VB2 = 256 * 128, STG2 = KB2 + VB2;
        static_assert(2 * STG2 + 16384 <= LDS_BYTES - 16, "ret lds");
        const int wid_u = __builtin_amdgcn_readfirstlane(tid >> 6);
        const int nt = a.ntiles;
        unsigned koff[4], voff[4];
#pragma unroll
        for (int i = 0; i < 4; ++i) { const int blk = wid_u * 4 + i;
            { const int row = 2 * blk + (lane >> 5), pos = lane & 31, c = pos ^ (row & 31); koff[i] = (unsigned)(row * a.ldk + c * 8) * 2u; }
            { const int row = 8 * blk + (lane >> 3), pos = lane & 7, c = pos ^ ((row >> 1) & 7); voff[i] = (unsigned)(row * a.ldvt + c * 8) * 2u; } }
        auto dma = [&](int t, int buf) {
            const char* kbase = (t * 64 >= a.nreal) ? (const char*)a.ident + (size_t)((t * 64 - a.nreal) & 255) * a.ldk * 2 : (const char*)a.k + (size_t)t * 64 * a.ldk * 2;
            const char* vbase = (const char*)a.vt + (size_t)t * 128;
            LAS unsigned char* base = lds + buf * STG2;
#pragma unroll
            for (int i = 0; i < 4; ++i) __builtin_amdgcn_global_load_lds((const unsigned*)(kbase + koff[i]), (LAS unsigned*)(base + (wid_u * 4 + i) * 1024), 16, 0, 0);
#pragma unroll
            for (int i = 0; i < 4; ++i) __builtin_amdgcn_global_load_lds((const unsigned*)(vbase + voff[i]), (LAS unsigned*)(base + KB2 + (wid_u * 4 + i) * 1024), 16, 0, 0);
        };
        auto unif = [](float v) { return __int_as_float(__builtin_amdgcn_readfirstlane(__float_as_int(v))); };
        const float f1 = unif(fast_exp2(-a.lgf)), f2 = unif(f1 * f1), f3 = unif(f2 * f1), f8 = unif(fast_exp2(-8.0f * a.lgf));
        const float b1 = unif(fast_exp2(a.lgb)), b2 = unif(b1 * b1), b3 = unif(b2 * b1), b8 = unif(fast_exp2(8.0f * a.lgb));
        LAS unsigned char* pbuf = lds + 2 * STG2;
        auto compute2 = [&](int t) {
            const LAS unsigned char* kb = lds + (t & 1) * STG2; const LAS unsigned char* vb = kb + KB2;
            const int n = a.n0 + lr, m0 = t * 64, half = a.half;
            const unsigned ka0 = (unsigned)(size_t)(kb + (half * 32 + lr) * 512) + (unsigned)((g ^ lr) << 4);
            auto kfrag = [&](int s_) { return *(const LAS bf16x8*)(size_t)(ka0 ^ (unsigned)(s_ << 5)); };
            f32x16 S;
#pragma unroll
            for (int r = 0; r < 16; ++r) S[r] = 0.f;
            bf16x8 ka[2], kc[2];
            ka[0] = kfrag(0); ka[1] = kfrag(1);
#pragma unroll
            for (int grp = 0; grp < 8; ++grp) {
                if (grp < 7) { if (grp & 1) { ka[0] = kfrag(2 * grp + 2); ka[1] = kfrag(2 * grp + 3); } else { kc[0] = kfrag(2 * grp + 2); kc[1] = kfrag(2 * grp + 3); } }
                __builtin_amdgcn_sched_barrier(0);
                if (grp & 1) { S = __builtin_amdgcn_mfma_f32_32x32x16_bf16(kc[0], qf[2 * grp], S, 0, 0, 0); S = __builtin_amdgcn_mfma_f32_32x32x16_bf16(kc[1], qf[2 * grp + 1], S, 0, 0, 0); }
                else { S = __builtin_amdgcn_mfma_f32_32x32x16_bf16(ka[0], qf[2 * grp], S, 0, 0, 0); S = __builtin_amdgcn_mfma_f32_32x32x16_bf16(ka[1], qf[2 * grp + 1], S, 0, 0, 0); }
                __builtin_amdgcn_sched_barrier(0);
            }
            const int mb = m0 + half * 32;
            if (MODE == 2) {
                if (m0 < a.nreal) {
                    if (mb + 31 < a.n0) {
                        float c4 = 0.0625f * fast_exp2((float)(n - mb - 4 * g) * a.lgf);
#pragma unroll
                        for (int q4 = 0; q4 < 4; ++q4) { S[4 * q4] *= c4; S[4 * q4 + 1] *= c4 * f1; S[4 * q4 + 2] *= c4 * f2; S[4 * q4 + 3] *= c4 * f3; c4 *= f8; }
                    } else if (mb > a.n0 + 31) {
                        float c4 = 0.0625f * fast_exp2((float)(mb + 4 * g - n) * a.lgb);
#pragma unroll
                        for (int q4 = 0; q4 < 4; ++q4) { S[4 * q4] *= c4; S[4 * q4 + 1] *= c4 * b1; S[4 * q4 + 2] *= c4 * b2; S[4 * q4 + 3] *= c4 * b3; c4 *= b8; }
                    } else {
#pragma unroll
                        for (int r = 0; r < 16; ++r) { const int m = mb + 8 * (r >> 2) + 4 * g + (r & 3); const int df = n - m;
                            const float e = df > 0 ? (float)df * a.lgf : (float)(-df) * a.lgb; float f = fast_exp2(e) * 0.0625f; if (df == 0) f = 0.125f; S[r] *= f; }
                    }
                } else {
                    const float f = ((m0 - a.nreal) < 256) ? fast_exp2((float)(n + 1) * a.lgf) : fast_exp2((float)(a.L - n) * a.lgb);
#pragma unroll
                    for (int r = 0; r < 16; ++r) S[r] *= f;
                }
            } else {
#pragma unroll
                for (int r = 0; r < 16; ++r) { const int m = mb + 8 * (r >> 2) + 4 * g + (r & 3);
                    const float e = a.dir == 0 ? (float)(a.L - 1 - m) * a.lgf : (float)m * a.lgb; S[r] *= fast_exp2(e) * 0.0625f; }
            }
            u32x4 pw0, pw1;
            pw0.x = cvt_pk_bf16(S[0], S[1]); pw0.y = cvt_pk_bf16(S[2], S[3]); pw0.z = cvt_pk_bf16(S[4], S[5]); pw0.w = cvt_pk_bf16(S[6], S[7]);
            pw1.x = cvt_pk_bf16(S[8], S[9]); pw1.y = cvt_pk_bf16(S[10], S[11]); pw1.z = cvt_pk_bf16(S[12], S[13]); pw1.w = cvt_pk_bf16(S[14], S[15]);
            { LAS unsigned char* pb = pbuf + wid_u * 2048 + lane * 16; *(LAS u32x4*)pb = pw0; *(LAS u32x4*)(pb + 1024) = pw1; }
            u32x4 vf[ND];
            auto vload = [&](int kk) {
#pragma unroll
                for (int d = 0; d < ND; ++d) { const unsigned va0 = ((unsigned)(size_t)(vb + (half * 128 + lr) * 128) + (unsigned)((g ^ ((lr >> 1) & 7)) << 4)) ^ (unsigned)(kk << 5);
                    vf[d] = *(const LAS u32x4*)(size_t)(va0 + d * 4096); }
            };
            auto pv = [&](const u32x4 pw) { const bf16x8 pf = __builtin_bit_cast(bf16x8, pw);
#pragma unroll
                for (int d = 0; d < ND; ++d) O[d] = __builtin_amdgcn_mfma_f32_32x32x16_bf16(__builtin_bit_cast(bf16x8, vf[d]), pf, O[d], 0, 0, 0); };
            vload(2 * half); pv(pw0);
            vload(2 * half + 1); pv(pw1);
            asm volatile("s_waitcnt lgkmcnt(0)" ::: "memory"); __builtin_amdgcn_s_barrier(); asm volatile("" ::: "memory");
            const LAS unsigned char* pp = pbuf + (wid_u ^ 4) * 2048 + lane * 16;
            { const u32x4 q0 = *(const LAS u32x4*)pp; vload(2 * (1 - half)); pv(q0); }
            { const u32x4 q1 = *(const LAS u32x4*)(pp + 1024); vload(2 * (1 - half) + 1); pv(q1); }
        };
        dma(0, 0);
        asm volatile("s_waitcnt vmcnt(0)" ::: "memory"); __syncthreads();
        for (int t = 0; t < nt; ++t) {
            if (t + 1 < nt) dma(t + 1, (t + 1) & 1);
            compute2(t);
            asm volatile("s_waitcnt vmcnt(0)" ::: "memory"); __syncthreads();
        }
    } else {
    constexpr bool PF2 = (MODE == 0);
    u32x4 kreg[NKC], vreg[NVC], kreg2[PF2 ? NKC : 1], vreg2[PF2 ? NVC : 1];
    auto gload = [&](int t, u32x4* kr, u32x4* vr) {
        const bf16_t* kp; int ldk;
        if (MODE >= 2 && t * 64 >= a.nreal) { kp = a.ident + (size_t)((t * 64 - a.nreal) & 255) * 256; ldk = 256; } else { kp = a.k + (size_t)t * 64 * a.ldk; ldk = a.ldk; }
#pragma unroll
        for (int i = 0; i < NKC; ++i) { const int c = tid + i * 512, row = c / (KW / 8), cc = c % (KW / 8); kr[i] = *(const u32x4*)(kp + (size_t)row * ldk + cc * 8); }
#pragma unroll
        for (int i = 0; i < NVC; ++i) { const int c = tid + i * 512, d = c >> 3, cc = c & 7; vr[i] = *(const u32x4*)(a.vt + (size_t)d * a.ldvt + t * 64 + cc * 8); }
    };
    auto sstore = [&](int buf, const u32x4* kr, const u32x4* vr) {
        LAS unsigned char* base = lds + buf * STG;
#pragma unroll
        for (int i = 0; i < NKC; ++i) { const int c = tid + i * 512, row = c / (KW / 8), cc = c % (KW / 8); *(LAS u32x4*)(base + (row * KLD + cc * 8) * 2) = kr[i]; }
#pragma unroll
        for (int i = 0; i < NVC; ++i) { const int c = tid + i * 512, d = c >> 3, cc = c & 7; *(LAS u32x4*)(base + KB + (d * VLD + cc * 8) * 2) = vr[i]; }
    };
    gload(0, kreg, vreg); sstore(0, kreg, vreg); __syncthreads();
    const int nt = a.ntiles;
    auto compute = [&](int t) {
        LAS unsigned char* kb = lds + (t & 1) * STG; LAS unsigned char* vb = kb + KB;
        f32x16 S[2];
        if constexpr (MODE <= 1) {
            bf16x8 kf[2][NS];
#pragma unroll
            for (int ks = 0; ks < 2; ++ks)
#pragma unroll
                for (int s = 0; s < NS; ++s) kf[ks][s] = *(const LAS bf16x8*)(kb + ((ks * 32 + lr) * KLD + a.kcol + s * 16 + g * 8) * 2);
            u32x4 vf[2][ND];
            auto vload = [&](int kk, u32x4* dst) {
#pragma unroll
                for (int d = 0; d < ND; ++d) { const LAS unsigned char* vp = vb + ((d * 32 + lr) * VLD + kk * 16 + 4 * g) * 2;
                    const u32x2 v0 = *(const LAS u32x2*)vp, v1 = *(const LAS u32x2*)(vp + 16); dst[d] = (u32x4){v0.x, v0.y, v1.x, v1.y}; }
            };
            vload(0, vf[0]);
            __builtin_amdgcn_sched_barrier(0);
            const bool fx = (MODE == 0) ? (a.fixm >= 0.f) : FXC;
#pragma unroll
            for (int r = 0; r < 16; ++r) { S[0][r] = fx ? -a.fixm : 0.f; S[1][r] = fx ? -a.fixm : 0.f; }
#pragma unroll
            for (int s = 0; s < NS; ++s) { S[0] = __builtin_amdgcn_mfma_f32_32x32x16_bf16(kf[0][s], qf[s], S[0], 0, 0, 0); S[1] = __builtin_amdgcn_mfma_f32_32x32x16_bf16(kf[1][s], qf[s], S[1], 0, 0, 0); }
            if (fx) {
                float ls = 0.f;
#pragma unroll
                for (int ks = 0; ks < 2; ++ks)
#pragma unroll
                    for (int r = 0; r < 16; ++r) { const float pv = fast_exp2(S[ks][r]); S[ks][r] = pv; ls += pv; }
                l_run += ls;
            } else {
                float mx = S[0][0];
#pragma unroll
                for (int ks = 0; ks < 2; ++ks)
#pragma unroll
                    for (int r = 0; r < 16; ++r) mx = fmaxf(mx, S[ks][r]);
                mx = fmaxf(mx, shfl_xor_f(mx, 32));
                const float mn = fmaxf(m_run, mx), alpha = fast_exp2(m_run - mn); m_run = mn;
                float ls = 0.f;
#pragma unroll
                for (int ks = 0; ks < 2; ++ks)
#pragma unroll
                    for (int r = 0; r < 16; ++r) { const float pv = fast_exp2(S[ks][r] - mn); S[ks][r] = pv; ls += pv; }
                l_run = l_run * alpha + ls;
#pragma unroll
                for (int d = 0; d < ND; ++d)
#pragma unroll
                    for (int r = 0; r < 16; ++r) O[d][r] *= alpha;
            }
#pragma unroll
            for (int kk = 0; kk < 4; ++kk) {
                if (kk < 3) vload(kk + 1, vf[(kk + 1) & 1]);
                __builtin_amdgcn_sched_barrier(0);
                const int ks = kk >> 1, rb = (kk & 1) * 8;
                u32x4 pw; pw.x = cvt_pk_bf16(S[ks][rb + 0], S[ks][rb + 1]); pw.y = cvt_pk_bf16(S[ks][rb + 2], S[ks][rb + 3]); pw.z = cvt_pk_bf16(S[ks][rb + 4], S[ks][rb + 5]); pw.w = cvt_pk_bf16(S[ks][rb + 6], S[ks][rb + 7]);
                const bf16x8 pf = __builtin_bit_cast(bf16x8, pw);
#pragma unroll
                for (int d = 0; d < ND; ++d) O[d] = __builtin_amdgcn_mfma_f32_32x32x16_bf16(__builtin_bit_cast(bf16x8, vf[kk & 1][d]), pf, O[d], 0, 0, 0);
            }
            return;
        }
#pragma unroll
        for (int ks = 0; ks < 2; ++ks) {
            if (MODE >= 2 && ks == 1) __builtin_amdgcn_sched_barrier(0);
#pragma unroll
            for (int r = 0; r < 16; ++r) S[ks][r] = 0.f;
#pragma unroll
            for (int s = 0; s < NS; ++s) {
                const bf16x8 af = *(const LAS bf16x8*)(kb + ((ks * 32 + lr) * KLD + a.kcol + s * 16 + g * 8) * 2);
                S[ks] = __builtin_amdgcn_mfma_f32_32x32x16_bf16(af, qf[s], S[ks], 0, 0, 0);
            }
            if (MODE == 2) {
                const int n = a.n0 + lr;
                if (t * 64 < a.nreal) {
#pragma unroll
                    for (int r = 0; r < 16; ++r) { const int m = t * 64 + ks * 32 + 8 * (r >> 2) + 4 * g + (r & 3); const int df = n - m;
                        const float e = df > 0 ? (float)df * a.lgf : (float)(-df) * a.lgb; float f = fast_exp2(e) * 0.0625f; if (df == 0) f = 0.125f; S[ks][r] *= f; }
                } else {
                    const float f = ((t * 64 - a.nreal) < 256) ? fast_exp2((float)(n + 1) * a.lgf) : fast_exp2((float)(a.L - n) * a.lgb);
#pragma unroll
                    for (int r = 0; r < 16; ++r) S[ks][r] *= f;
                }
            } else if (MODE == 3) {
#pragma unroll
                for (int r = 0; r < 16; ++r) { const int m = t * 64 + ks * 32 + 8 * (r >> 2) + 4 * g + (r & 3);
                    const float e = a.dir == 0 ? (float)(a.L - 1 - m) * a.lgf : (float)m * a.lgb; S[ks][r] *= fast_exp2(e) * 0.0625f; }
            }
            if (MODE >= 2) {
#pragma unroll
                for (int k2 = 0; k2 < 2; ++k2) {
                    const int kk = ks * 2 + k2, rb = k2 * 8;
                    u32x4 pw; pw.x = cvt_pk_bf16(S[ks][rb + 0], S[ks][rb + 1]); pw.y = cvt_pk_bf16(S[ks][rb + 2], S[ks][rb + 3]); pw.z = cvt_pk_bf16(S[ks][rb + 4], S[ks][rb + 5]); pw.w = cvt_pk_bf16(S[ks][rb + 6], S[ks][rb + 7]);
                    const bf16x8 pf = __builtin_bit_cast(bf16x8, pw);
#pragma unroll
                    for (int d = 0; d < ND; ++d) {
                        const LAS unsigned char* vp = vb + ((d * 32 + lr) * VLD + kk * 16 + 4 * g) * 2;
                        const u32x2 v0 = *(const LAS u32x2*)vp, v1 = *(const LAS u32x2*)(vp + 16);
                        const bf16x8 vf = __builtin_bit_cast(bf16x8, (u32x4){v0.x, v0.y, v1.x, v1.y});
                        O[d] = __builtin_amdgcn_mfma_f32_32x32x16_bf16(vf, pf, O[d], 0, 0, 0);
                    }
                }
            }
        }
        if (MODE <= 1) {
            float mx = S[0][0];
#pragma unroll
            for (int ks = 0; ks < 2; ++ks)
#pragma unroll
                for (int r = 0; r < 16; ++r) mx = fmaxf(mx, S[ks][r]);
            mx = fmaxf(mx, shfl_xor_f(mx, 32));
            const float mn = fmaxf(m_run, mx), alpha = fast_exp2(m_run - mn); m_run = mn;
            float ls = 0.f;
#pragma unroll
            for (int ks = 0; ks < 2; ++ks)
#pragma unroll
                for (int r = 0; r < 16; ++r) { const float pv = fast_exp2(S[ks][r] - mn); S[ks][r] = pv; ls += pv; }
            l_run = l_run * alpha + ls;
#pragma unroll
            for (int d = 0; d < ND; ++d)
#pragma unroll
                for (int r = 0; r < 16; ++r) O[d][r] *= alpha;
#pragma unroll
            for (int kk = 0; kk < 4; ++kk) {
                const int ks = kk >> 1, rb = (kk & 1) * 8;
                u32x4 pw; pw.x = cvt_pk_bf16(S[ks][rb + 0], S[ks][rb + 1]); pw.y = cvt_pk_bf16(S[ks][rb + 2], S[ks][rb + 3]); pw.z = cvt_pk_bf16(S[ks][rb + 4], S[ks][rb + 5]); pw.w = cvt_pk_bf16(S[ks][rb + 6], S[ks][rb + 7]);
                const bf16x8 pf = __builtin_bit_cast(bf16x8, pw);
#pragma unroll
                for (int d = 0; d < ND; ++d) {
                    const LAS unsigned char* vp = vb + ((d * 32 + lr) * VLD + kk * 16 + 4 * g) * 2;
                    const u32x2 v0 = *(const LAS u32x2*)vp, v1 = *(const LAS u32x2*)(vp + 16);
                    const bf16x8 vf = __builtin_bit_cast(bf16x8, (u32x4){v0.x, v0.y, v1.x, v1.y});
                    O[d] = __builtin_amdgcn_mfma_f32_32x32x16_bf16(vf, pf, O[d], 0, 0, 0);
                }
            }
        }
    };
    if (PF2) {
        if (nt > 1) gload(1, kreg, vreg);
        for (int t = 0; t < nt; t += 2) {
            if (t + 2 < nt) gload(t + 2, kreg2, vreg2);
            compute(t);
            if (t + 1 < nt) sstore(1, kreg, vreg);
            __syncthreads();
            if (t + 1 >= nt) break;
            if (t + 3 < nt) gload(t + 3, kreg, vreg);
            compute(t + 1);
            if (t + 2 < nt) sstore(0, kreg2, vreg2);
            __syncthreads();
        }
    } else {
        for (int t = 0; t < nt; ++t) {
            if (t + 1 < nt) gload(t + 1, kreg, vreg);
            compute(t);
            if (t + 1 < nt) sstore((t + 1) & 1, kreg, vreg);
            __syncthreads();
        }
    }
    }
    if (MODE == 0) {
        const float inv = 1.0f / (l_run + shfl_xor_f(l_run, 32));
        bf16_t* op = a.out + (size_t)lr * a.ldo;
#pragma unroll
        for (int d = 0; d < ND; ++d)
#pragma unroll
            for (int q4 = 0; q4 < 4; ++q4)
                *(u32x2*)(op + d * 32 + 8 * q4 + 4 * g) = (u32x2){cvt_pk_bf16(O[d][4 * q4] * inv, O[d][4 * q4 + 1] * inv), cvt_pk_bf16(O[d][4 * q4 + 2] * inv, O[d][4 * q4 + 3] * inv)};
    } else if (MODE == 1) {
        const int wid = tid >> 6;
        const float inv = 1.0f / (l_run + shfl_xor_f(l_run, 32));
        LAS float* ex = (LAS float*)lds;
        if (wid >= 4) {
#pragma unroll
            for (int d = 0; d < ND; ++d)
#pragma unroll
                for (int r = 0; r < 16; ++r) ex[(((wid - 4) * ND + d) * 16 + r) * 64 + lane] = O[d][r] * inv;
        }
        __syncthreads();
        if (wid < 4) {
            float ss = 0.f;
#pragma unroll
            for (int d = 0; d < ND; ++d)
#pragma unroll
                for (int r = 0; r < 16; ++r) { const float o = O[d][r] * inv - a.lam * ex[((wid * ND + d) * 16 + r) * 64 + lane]; O[d][r] = o; ss += o * o; }
            ss += shfl_xor_f(ss, 32);
            const float rs = rsqrtf(ss * (1.0f / DV) + 1e-5f) * a.onem;
            bf16_t* op = a.out + (size_t)lr * a.ldo;
#pragma unroll
            for (int d = 0; d < ND; ++d)
#pragma unroll
                for (int q4 = 0; q4 < 4; ++q4) { const int dd = d * 32 + 8 * q4 + 4 * g; const f32x4 sg = *(const f32x4*)(a.subg + dd);
                    *(u32x2*)(op + dd) = (u32x2){cvt_pk_bf16(O[d][4 * q4] * rs * sg[0], O[d][4 * q4 + 1] * rs * sg[1]), cvt_pk_bf16(O[d][4 * q4 + 2] * rs * sg[2], O[d][4 * q4 + 3] * rs * sg[3])}; }
        }
        __syncthreads();
    } else if (MODE == 2) {
        const int wid_e = __builtin_amdgcn_readfirstlane(tid >> 6);
        const LAS int* pp = (const LAS int*)(lds + LDS_RETPARAM) + wid_e * 8;
        const int e_row = pp[0], e_col = pp[1], e_pair = pp[2], e_dvh = pp[3];
        KParamsPtr kpe = (KParamsPtr)__builtin_amdgcn_kernarg_segment_ptr();
        unsigned char* wsb = kpe->ws;
        unsigned long long* pslot = (unsigned long long*)(wsb + WS_PSLOT) + (size_t)e_pair * 256;
        float ss = 0.f;
#pragma unroll
        for (int d = 0; d < ND; ++d)
#pragma unroll
            for (int r = 0; r < 16; ++r) ss += O[d][r] * O[d][r];
        ss += shfl_xor_f(ss, 32);
        LAS float* xl = (LAS float*)lds;
        if (g == 0) xl[wid_e * 32 + lr] = ss;
        __syncthreads();
        if (wid_e < 4 && g == 0) {
            const float mine = xl[wid_e * 32 + lr] + xl[(wid_e + 4) * 32 + lr];
            const int row = wid_e * 32 + lr;
            (void)__hip_atomic_exchange(pslot + (size_t)e_dvh * 128 + row, (0x5EEDull << 32) | (unsigned long long)__float_as_uint(mine), __ATOMIC_RELAXED, __HIP_MEMORY_SCOPE_AGENT);
            unsigned long long* o = pslot + (size_t)(e_dvh ^ 1) * 128 + row; unsigned long long v; unsigned spin = 0;
            for (;;) { v = __hip_atomic_load(o, __ATOMIC_RELAXED, __HIP_MEMORY_SCOPE_AGENT); if ((unsigned)(v >> 32) == 0x5EEDu) break; __builtin_amdgcn_s_sleep(1); if (++spin > (1u << 22)) break; }
            xl[256 + row] = rsqrtf((mine + __uint_as_float((unsigned)v)) * (1.0f / 512.0f) + 1e-6f);
        }
        __syncthreads();
        const float rs = xl[256 + (wid_e & 3) * 32 + lr];
        bf16_t* op = (bf16_t*)(wsb + WS_X + 36 * MiB) + (size_t)(e_row + lr) * 2048 + e_col; const bf16_t* gp = (const bf16_t*)(wsb + WS_U) + (size_t)(e_row + lr) * 6144 + 4096 + e_col; const float* gnp = kpe->in[I_RGN] + e_col;
#pragma unroll
        for (int d = 0; d < ND; ++d)
#pragma unroll
            for (int q4 = 0; q4 < 4; ++q4) { const int dd = d * 32 + 8 * q4 + 4 * g; const u32x2 gw = *(const u32x2*)(gp + dd); const f32x4 g4 = *(const f32x4*)(gnp + dd);
                const float o0 = siluf(bflo(gw.x)) * (O[d][4 * q4] * rs * g4[0]), o1 = siluf(bfhi(gw.x)) * (O[d][4 * q4 + 1] * rs * g4[1]);
                const float o2 = siluf(bflo(gw.y)) * (O[d][4 * q4 + 2] * rs * g4[2]), o3 = siluf(bfhi(gw.y)) * (O[d][4 * q4 + 3] * rs * g4[3]);
                *(u32x2*)(op + dd) = (u32x2){cvt_pk_bf16(o0, o1), cvt_pk_bf16(o2, o3)}; }
        __syncthreads();
    } else {
        float* op = a.outf + (size_t)lr * 512;
#pragma unroll
        for (int d = 0; d < ND; ++d)
#pragma unroll
            for (int q4 = 0; q4 < 4; ++q4) *(f32x4*)(op + d * 32 + 8 * q4 + 4 * g) = (f32x4){O[d][4 * q4], O[d][4 * q4 + 1], O[d][4 * q4 + 2], O[d][4 * q4 + 3]};
    }
}

__device__ __forceinline__ int xcd_item(int it) { return (gridDim.x == 256 && it < 512) ? ((it & 256) | ((it & 7) << 5) | ((it & 255) >> 3)) : it; }
__device__ void attn_phase(const Params& p, LAS unsigned char* lds) {
    bf16_t* U = (bf16_t*)(p.ws + WS_U); bf16_t* H = (bf16_t*)(p.ws + WS_H);
    bf16_t* KS = (bf16_t*)(p.ws + WS_X); bf16_t* VtS = KS + (size_t)2 * 4352 * 256; bf16_t* VtP = VtS + (size_t)2 * 256 * 4352;
    const int wid = otid() >> 6, sub = wid >> 2, w4 = wid & 3;
    float gq = 0.f, gk = 0.f;
    for (int i = 0; i < 64; ++i) { gq = fmaxf(gq, fabsf(p.in[I_AQG][i])); gk = fmaxf(gk, fabsf(p.in[I_AKG][i])); }
    const float ckn = sqrtf(__uint_as_float(*(const unsigned*)(p.ws + WS_CKMAX)));
    const float sbound = 8.0f * gq * fmaxf(8.0f * gk, ckn) * (0.125f * 1.4426950408889634f) * 1.03f + 0.25f;
    const float fixm = sbound <= 80.0f ? sbound : -1.0f;
    for (int it = blockIdx.x; it < 1024; it += gridDim.x) {
        FlashArgs a; a.ident = nullptr; a.kcol = 0; a.qscale = 0.125f * 1.4426950408889634f; a.ldo = DM; a.outf = nullptr; a.ldq = 1536; a.fixm = fixm;
        if (it < 512) { const int ix = xcd_item(it); const int b = ix >> 8, pr = (ix >> 5) & 7, qb = ix & 31; const int head = pr * 2 + sub, kh = pr >> 1;
            const size_t tok = (size_t)NTP + b * 4096 + qb * 128 + w4 * 32;
            a.q = U + tok * 1536 + head * 64; a.k = KS + (size_t)b * 4352 * 256 + kh * 64; a.ldk = 256; a.vt = VtS + (size_t)(b * 4 + kh) * 64 * 4352; a.ldvt = 4352;
            a.nreal = 4352; a.ntiles = 68; a.out = H + tok * DM + head * 64;
        } else { const int i2 = it - 512, b = i2 >> 4, pr = (i2 >> 1) & 7, qb = i2 & 1; const int head = pr * 2 + sub, kh = pr >> 1;
            const size_t tok = (size_t)b * 256 + qb * 128 + w4 * 32;
            a.q = U + tok * 1536 + head * 64; a.k = U + (size_t)b * 256 * 1536 + 1024 + kh * 64; a.ldk = 1536; a.vt = VtP + (size_t)(b * 4 + kh) * 64 * 256; a.ldvt = 256;
            a.nreal = 256; a.ntiles = 4; a.out = H + tok * DM + head * 64;
        }
        flash_item<64, 64, 0>(lds, a);
    }
}
template <bool FXC>
__device__ __forceinline__ void diff_phase_t(const Params& p, LAS unsigned char* lds, const float dfix) {
    bf16_t* U = (bf16_t*)(p.ws + WS_U); bf16_t* H = (bf16_t*)(p.ws + WS_H);
    bf16_t* KS = (bf16_t*)(p.ws + WS_X); bf16_t* VtS = KS + (size_t)2 * 4352 * 1024; bf16_t* VtP = VtS + (size_t)2 * 1024 * 4352;
    const int wid = otid() >> 6, sub = wid >> 2, w4 = wid & 3;
    const float* lam = p.in[I_DLAM]; float s1 = 0.f, s2 = 0.f;
    for (int i = 0; i < 64; ++i) { s1 += lam[i] * lam[64 + i]; s2 += lam[128 + i] * lam[192 + i]; }
    const float lam_init = 0.8f - 0.6f * expf(-0.3f * 1.0f); const float lam_full = expf(s1) - expf(s2) + lam_init;
    for (int it = blockIdx.x; it < 1024; it += gridDim.x) {
        FlashArgs a; a.ident = nullptr; a.kcol = sub * 64; a.qscale = 0.125f * 1.4426950408889634f; a.ldo = DM; a.outf = nullptr; a.ldq = 3072; a.fixm = dfix;
        a.lam = lam_full; a.onem = 1.0f - lam_init; a.subg = p.in[I_DSUB];
        if (it < 512) { const int ix = xcd_item(it); const int b = ix >> 8, h = (ix >> 5) & 7, qb = ix & 31; const size_t tok = (size_t)NTP + b * 4096 + qb * 128 + w4 * 32;
            a.q = U + tok * 3072 + h * 128 + sub * 64; a.k = KS + (size_t)b * 4352 * 1024 + h * 128; a.ldk = 1024; a.vt = VtS + ((size_t)b * 1024 + h * 128) * 4352; a.ldvt = 4352;
            a.nreal = 4352; a.ntiles = 68; a.out = H + tok * DM + h * 128;
        } else { const int i2 = it - 512, b = i2 >> 4, h = (i2 >> 1) & 7, qb = i2 & 1; const size_t tok = (size_t)b * 256 + qb * 128 + w4 * 32;
            a.q = U + tok * 3072 + h * 128 + sub * 64; a.k = U + (size_t)b * 256 * 3072 + 1024 + h * 128; a.ldk = 3072; a.vt = VtP + ((size_t)b * 1024 + h * 128) * 256; a.ldvt = 256;
            a.nreal = 256; a.ntiles = 4; a.out = H + tok * DM + h * 128;
        }
        flash_item<64, 128, 1, FXC>(lds, a);
    }
}
__device__ void diff_phase(const Params& p, LAS unsigned char* lds) {
    const float dqn = sqrtf(__uint_as_float(*(const unsigned*)(p.ws + WS_DQMAX))), dkn = sqrtf(__uint_as_float(*((const unsigned*)(p.ws + WS_DQMAX) + 1)));
    const float dbound = dqn * dkn * (0.125f * 1.4426950408889634f) * 1.03f + 0.25f; const float dfix = dbound <= 80.0f ? dbound : -1.0f;
    if (dfix >= 0.f) diff_phase_t<true>(p, lds, dfix); else diff_phase_t<false>(p, lds, dfix);
}
__device__ void ret_phase(const Params& p, LAS unsigned char* lds) {
    bf16_t* U = (bf16_t*)(p.ws + WS_U); bf16_t* VtP = (bf16_t*)(p.ws + WS_H); bf16_t* VtS = (bf16_t*)(p.ws + WS_X); bf16_t* OB = (bf16_t*)(p.ws + WS_X + 36 * MiB);
    const bf16_t* ident = (const bf16_t*)(p.ws + WS_IDENT); const bf16_t* identw = (const bf16_t*)(p.ws + WS_IDENTW);
    const float L2E = 1.4426950408889634f;
    for (int it = blockIdx.x; it < 2048; it += gridDim.x) {
        const int wid = __builtin_amdgcn_readfirstlane(otid() >> 6), rg = wid & 3, half = wid >> 2;
        FlashArgs a; a.ident = identw; a.kcol = 0; a.qscale = 1.f; a.ldo = 2048; a.outf = nullptr; a.dir = 0; a.half = half;
        if (it < 512) { const int ix = xcd_item(it); const int b = ix >> 8, h = (ix >> 6) & 3, dvh = (ix >> 5) & 1, qb = ix & 31; const size_t tok0 = (size_t)NTP + b * 4096;
            a.lgf = -fabsf(p.in[I_RLD][h]) * L2E; a.lgb = -fabsf(p.in[I_RLD][4 + h]) * L2E;
            a.n0 = qb * 128 + rg * 32; a.L = 4096;
            a.q = U + (tok0 + a.n0) * 6144 + h * 256; a.ldq = 6144; a.k = U + tok0 * 6144 + 1024 + h * 256; a.ldk = 6144;
            a.vt = VtS + ((size_t)b * 2048 + h * 512 + dvh * 256) * 4608; a.ldvt = 4608; a.nreal = 4096; a.ntiles = 72;
            a.out = nullptr;
            if ((otid() & 63) == 0) { LAS int* pp = (LAS int*)(lds + LDS_RETPARAM) + wid * 8; pp[0] = (int)(tok0 + a.n0); pp[1] = h * 512 + dvh * 256 + half * 128; pp[2] = (b * 4 + h) * 32 + qb; pp[3] = dvh; }
            flash_item<256, 128, 2>(lds, a);
        } else if (it < 1024) { const int i2 = it - 512, b = i2 >> 4, h = (i2 >> 2) & 3, dvh = (i2 >> 1) & 1, qb = i2 & 1; const size_t tok0 = (size_t)b * 256;
            a.lgf = -fabsf(p.in[I_RLD][h]) * L2E; a.lgb = -fabsf(p.in[I_RLD][4 + h]) * L2E;
            a.n0 = qb * 128 + rg * 32; a.L = 256;
            a.q = U + (tok0 + a.n0) * 6144 + h * 256; a.ldq = 6144; a.k = U + tok0 * 6144 + 1024 + h * 256; a.ldk = 6144;
            a.vt = VtP + ((size_t)b * 2048 + h * 512 + dvh * 256) * 256; a.ldvt = 256; a.nreal = 256; a.ntiles = 4;
            a.out = nullptr;
            if ((otid() & 63) == 0) { LAS int* pp = (LAS int*)(lds + LDS_RETPARAM) + wid * 8; pp[0] = (int)(tok0 + a.n0); pp[1] = h * 512 + dvh * 256 + half * 128; pp[2] = 256 + (b * 4 + h) * 2 + qb; pp[3] = dvh; }
            flash_item<256, 128, 2>(lds, a);
        } else { const int i2 = it - 1024, b = i2 >> 5, dir = (i2 >> 4) & 1, h = (i2 >> 2) & 3, dvh = (i2 >> 1) & 1, ib = i2 & 1; const size_t tok0 = (size_t)b * 256;
            a.lgf = -fabsf(p.in[I_RLD][h]) * L2E; a.lgb = -fabsf(p.in[I_RLD][4 + h]) * L2E;
            a.n0 = ib * 128 + rg * 32; a.L = 256; a.dir = dir;
            a.q = ident + (size_t)(ib * 128 + rg * 32) * 256; a.ldq = 256; a.k = U + tok0 * 6144 + 1024 + h * 256; a.ldk = 6144;
            a.vt = VtP + ((size_t)b * 2048 + h * 512 + dvh * 256) * 256; a.ldvt = 256; a.nreal = 256; a.ntiles = 4;
            a.out = nullptr; a.outf = p.out + OUT_NSR + ((size_t)((b * 2 + dir) * 4 + h) * 256 + ib * 128 + rg * 32) * 512 + dvh * 256 + half * 128;
            flash_item<256, 128, 3>(lds, a);
        }
    }
}
__device__ void ret_prep(const Params& p, LAS unsigned char* lds) {
    bf16_t* U = (bf16_t*)(p.ws + WS_U); bf16_t* VtP = (bf16_t*)(p.ws + WS_H); bf16_t* VtS = (bf16_t*)(p.ws + WS_X);
    vt_all<true>(U, 6144, 2048, 2048, VtP, VtS, 4608, 0, lds);
    for (int it = blockIdx.x; it < 16 * 32; it += gridDim.x) { const int mt = it >> 5, tl = it & 31, kt = tl >> 3, ntile = tl & 7; const int b = mt >> 3, dir = (mt >> 2) & 1, h = mt & 3;
        wconv_tile<true>(p.in[I_SRET] + (size_t)mt * 256 * 512, 512, VtS + ((size_t)b * 2048 + h * 512) * 4608 + 4096 + dir * 256, 4608, kt, ntile, (LAS float*)lds); }
}
__device__ void ret_gate(const Params& p) {
    const bf16_t* U = (const bf16_t*)(p.ws + WS_U); bf16_t* OB = (bf16_t*)(p.ws + WS_X + 36 * MiB); const float* gn = p.in[I_RGN];
    const int lane = otid() & 63, gw = blockIdx.x * 8 + (otid() >> 6), nw = gridDim.x * 8;
    for (int it = gw; it < NT * 4; it += nw) { const int t = it >> 2, h = it & 3;
        bf16_t* op = OB + (size_t)t * 2048 + h * 512 + lane * 8; const u32x4 ow = *(const u32x4*)op; const u32x4 gwv = *(const u32x4*)(U + (size_t)t * 6144 + 4096 + h * 512 + lane * 8);
        float o[8], gg[8];
#pragma unroll
        for (int j = 0; j < 4; ++j) { o[2 * j] = bflo(ow[j]); o[2 * j + 1] = bfhi(ow[j]); gg[2 * j] = bflo(gwv[j]); gg[2 * j + 1] = bfhi(gwv[j]); }
        float ss = 0.f;
#pragma unroll
        for (int j = 0; j < 8; ++j) ss += o[j] * o[j];
        ss = wave_sum(ss); const float rs = rsqrtf(ss * (1.0f / 512.0f) + 1e-6f);
        const f32x4 g0 = *(const f32x4*)(gn + h * 512 + lane * 8), g1 = *(const f32x4*)(gn + h * 512 + lane * 8 + 4);
        float r[8];
#pragma unroll
        for (int j = 0; j < 8; ++j) r[j] = siluf(gg[j]) * (o[j] * rs * (j < 4 ? g0[j] : g1[j - 4]));
        *(u32x4*)op = (u32x4){cvt_pk_bf16(r[0], r[1]), cvt_pk_bf16(r[2], r[3]), cvt_pk_bf16(r[4], r[5]), cvt_pk_bf16(r[6], r[7])};
    }
}

__device__ void ffn_act_phase(const bf16_t* __restrict__ src, bf16_t* __restrict__ dst, const float* __restrict__ w, const float* __restrict__ bias) {
    constexpr int C = FF, LD = 2 * FF; const int nc8 = C / 8; const size_t tot = (size_t)(NT / 16) * nc8;
    for (size_t it = (size_t)blockIdx.x * 512 + otid(); it < tot; it += (size_t)gridDim.x * 512) {
        const int cb = (int)(it % nc8), rb = (int)(it / nc8), r0 = rb * 16, j0 = cb * 8;
        const int Ls = r0 < NTP ? 256 : 4096; const bool hasp = (r0 % Ls) != 0, hasn = ((r0 + 16) % Ls) != 0;
        float w0[2][8], w1[2][8], w2[2][8], bb[2][8];
#pragma unroll
        for (int q = 0; q < 2; ++q)
#pragma unroll
            for (int h4 = 0; h4 < 2; ++h4) { const int c = j0 + 4 * h4 + q * C;
                const f32x4 t0 = *(const f32x4*)(w + c), t1 = *(const f32x4*)(w + LD + c), t2 = *(const f32x4*)(w + 2 * LD + c), tb = *(const f32x4*)(bias + c);
#pragma unroll
                for (int j = 0; j < 4; ++j) { w0[q][4 * h4 + j] = t0[j]; w1[q][4 * h4 + j] = t1[j]; w2[q][4 * h4 + j] = t2[j]; bb[q][4 * h4 + j] = tb[j]; } }
        const bf16_t* sp = src + (size_t)r0 * LD + j0;
        u32x4 raw[2][6];
        const u32x4 z4 = (u32x4){0u, 0u, 0u, 0u};
#pragma unroll
        for (int q = 0; q < 2; ++q) { raw[q][0] = hasp ? *(const u32x4*)(sp - LD + q * C) : z4; raw[q][1] = *(const u32x4*)(sp + q * C); }
#pragma unroll
        for (int grp = 0; grp < 4; ++grp) {
#pragma unroll
            for (int k = 0; k < 4; ++k)
#pragma unroll
                for (int q = 0; q < 2; ++q) { const int rr = grp * 4 + k + 1; raw[q][2 + k] = (rr < 16 || hasn) ? *(const u32x4*)(sp + (size_t)rr * LD + q * C) : z4; }
#pragma unroll
            for (int k = 0; k < 4; ++k) {
                float o[8];
#pragma unroll
                for (int jj = 0; jj < 4; ++jj) {
                    float ca[2], cbv[2];
#pragma unroll
                    for (int h2 = 0; h2 < 2; ++h2) { const int j = 2 * jj + h2;
                        const float pa = h2 ? bfhi(raw[0][k][jj]) : bflo(raw[0][k][jj]), ca_ = h2 ? bfhi(raw[0][k + 1][jj]) : bflo(raw[0][k + 1][jj]), na = h2 ? bfhi(raw[0][k + 2][jj]) : bflo(raw[0][k + 2][jj]);
                        const float pb = h2 ? bfhi(raw[1][k][jj]) : bflo(raw[1][k][jj]), cb_ = h2 ? bfhi(raw[1][k + 1][jj]) : bflo(raw[1][k + 1][jj]), nb = h2 ? bfhi(raw[1][k + 2][jj]) : bflo(raw[1][k + 2][jj]);
                        ca[h2] = w0[0][j] * pa + w1[0][j] * ca_ + w2[0][j] * na + bb[0][j];
                        cbv[h2] = w0[1][j] * pb + w1[1][j] * cb_ + w2[1][j] * nb + bb[1][j];
                        o[j] = siluf(ca[h2]) * cbv[h2]; }
                }
                *(u32x4*)(dst + (size_t)(r0 + grp * 4 + k) * C + j0) = (u32x4){cvt_pk_bf16(o[0], o[1]), cvt_pk_bf16(o[2], o[3]), cvt_pk_bf16(o[4], o[5]), cvt_pk_bf16(o[6], o[7])};
            }
#pragma unroll
            for (int q = 0; q < 2; ++q) { raw[q][0] = raw[q][4]; raw[q][1] = raw[q][5]; }
        }
    }
}

__device__ void hyena_filters(const Params& p, LAS unsigned char* lds) {
    float* FtP = (float*)(p.ws + WS_X); float* FtS = FtP + (size_t)4096 * 256; float* PS = (float*)(p.ws + WS_X + 68 * MiB);
    LAS float* zz = (LAS float*)lds;
    LAS float* a1 = zz + 16 * 33;
    LAS float* a2 = a1 + 16 * 64;
    const int tid = otid();
    const float* w1 = p.in[I_HW1]; const float* b1 = p.in[I_HB1]; const float* w2 = p.in[I_HW2]; const float* b2 = p.in[I_HB2]; const float* w3 = p.in[I_HW3]; const float* fq = p.in[I_HFREQ];
    for (int it = blockIdx.x; it < 272; it += gridDim.x) {
        const int L = it < 16 ? 256 : 4096, t0 = it < 16 ? it * 16 : (it - 16) * 16;
        for (int i = tid; i < 16 * 33; i += 512) { const int r = i / 33, e = i % 33; const float t = (float)(t0 + r); float v;
            if (e == 0) v = t / (float)(L - 1);
            else { const int bi = (e - 1) & 15; const float band = 1e-4f + (float)bi * ((15.0f - 1e-4f) / 15.0f); const float rev = t * band / (float)L; v = e <= 16 ? cos_rev(rev) : -sin_rev(rev); }
            zz[i] = v; }
        __syncthreads();
        for (int i = tid; i < 1024; i += 512) { const int r = i >> 6, j = i & 63; float s = b1[j];
            for (int e = 0; e < 33; ++e) s += zz[r * 33 + e] * w1[e * 64 + j];
            a1[i] = sin_rr(fq[j] * s); }
        __syncthreads();
        for (int i = tid; i < 1024; i += 512) { const int r = i >> 6, j = i & 63; float s = b2[j];
            for (int k = 0; k < 64; ++k) s += a1[r * 64 + k] * w2[k * 64 + j];
            a2[i] = sin_rr(fq[64 + j] * s); }
        __syncthreads();
        const int c0 = tid * 8;
        float acc[16][8];
#pragma unroll
        for (int r = 0; r < 16; ++r)
#pragma unroll
            for (int j = 0; j < 8; ++j) acc[r][j] = 0.f;
        for (int k = 0; k < 64; ++k) { const f32x4 wa = *(const f32x4*)(w3 + (size_t)k * 4096 + c0), wb = *(const f32x4*)(w3 + (size_t)k * 4096 + c0 + 4);
#pragma unroll
            for (int r = 0; r < 16; ++r) { const float av = a2[r * 64 + k];
#pragma unroll
                for (int j = 0; j < 4; ++j) { acc[r][j] += av * wa[j]; acc[r][4 + j] += av * wb[j]; } } }
        float asum[8];
#pragma unroll
        for (int j = 0; j < 8; ++j) asum[j] = 0.f;
        const float mind = -3.0701134573253945f, maxd = -15.350567286626973f;
        float dl[8];
#pragma unroll
        for (int j = 0; j < 8; ++j) { const int c = (c0 + j) & 1023; dl[j] = fabsf(mind + (maxd - mind) * ((float)c / 1023.0f)); }
#pragma unroll
        for (int r = 0; r < 16; ++r) { const float tn = (float)(t0 + r) / (float)(L - 1);
#pragma unroll
            for (int j = 0; j < 8; ++j) { acc[r][j] *= (__expf(-tn * dl[j]) + 0.05f); asum[j] += fabsf(acc[r][j]); } }
        { float* Ft = it < 16 ? FtP : FtS;
#pragma unroll
          for (int j = 0; j < 8; ++j) { float* d = Ft + (size_t)(c0 + j) * L + t0;
#pragma unroll
              for (int r4 = 0; r4 < 4; ++r4) *(f32x4*)(d + r4 * 4) = (f32x4){acc[r4 * 4][j], acc[r4 * 4 + 1][j], acc[r4 * 4 + 2][j], acc[r4 * 4 + 3][j]}; } }
        *(f32x4*)(PS + (size_t)it * 4096 + c0) = (f32x4){asum[0], asum[1], asum[2], asum[3]}; *(f32x4*)(PS + (size_t)it * 4096 + c0 + 4) = (f32x4){asum[4], asum[5], asum[6], asum[7]};
        __syncthreads();
    }
}
__device__ void hyena_dwconv_t(const bf16_t* __restrict__ src, bf16_t* __restrict__ Zt, const float* __restrict__ w, const float* __restrict__ bias) {
    constexpr int C = 3072; const int nc8 = C / 8; const size_t tot = (size_t)(NT / 16) * nc8;
    for (size_t it = (size_t)blockIdx.x * 512 + otid(); it < tot; it += (size_t)gridDim.x * 512) {
        const int cb = (int)(it % nc8), rb = (int)(it / nc8), r0 = rb * 16, j0 = cb * 8;
        const int Ls = r0 < NTP ? 256 : 4096; const bool hasp = (r0 % Ls) != 0, hasn = ((r0 + 16) % Ls) != 0;
        float w0[8], w1[8], w2[8], bb[8];
#pragma unroll
        for (int j = 0; j < 8; ++j) { const int c = j0 + j; w0[j] = w[c]; w1[j] = w[C + c]; w2[j] = w[2 * C + c]; bb[j] = bias[c]; }
        float pv[8], cv[8], nv[8], lo[8]; unsigned pk[8][8];
        auto ld8 = [&](int r, float* o, bool ok) {
            if (ok) { const u32x4 x = *(const u32x4*)(src + (size_t)r * C + j0);
#pragma unroll
                for (int j = 0; j < 4; ++j) { o[2 * j] = bflo(x[j]); o[2 * j + 1] = bfhi(x[j]); } }
            else {
#pragma unroll
                for (int j = 0; j < 8; ++j) o[j] = 0.f; }
        };
        ld8(r0 - 1, pv, hasp); ld8(r0, cv, true);
#pragma unroll
        for (int i = 0; i < 16; ++i) {
            ld8(r0 + i + 1, nv, (i < 15) || hasn);
#pragma unroll
            for (int j = 0; j < 8; ++j) { const float o = w0[j] * pv[j] + w1[j] * cv[j] + w2[j] * nv[j] + bb[j];
                if (i & 1) pk[j][i >> 1] = cvt_pk_bf16(lo[j], o); else lo[j] = o;
                pv[j] = cv[j]; cv[j] = nv[j]; }
        }
#pragma unroll
        for (int j = 0; j < 8; ++j) { bf16_t* d = Zt + (size_t)(j0 + j) * NT + r0;
            *(u32x4*)d = (u32x4){pk[j][0], pk[j][1], pk[j][2], pk[j][3]}; *(u32x4*)(d + 8) = (u32x4){pk[j][4], pk[j][5], pk[j][6], pk[j][7]}; }
    }
}
__device__ __forceinline__ float blk_sum2(float v, LAS float* red, int slot) {
    v = wave_sum(v); if ((otid() & 63) == 0) red[slot * 8 + (otid() >> 6)] = v; return v; }
__device__ void hyena_mfma(const Params& p, LAS unsigned char* lds) {
    const float* FtP = (const float*)(p.ws + WS_X); const float* FtS = FtP + (size_t)4096 * 256; const float* PS = (const float*)(p.ws + WS_X + 68 * MiB);
    bf16_t* U = (bf16_t*)(p.ws + WS_U); const bf16_t* Zt = U + (size_t)NT * 3072; bf16_t* yT = U;
    for (int it = blockIdx.x; it < 2048; it += gridDim.x) {
        const int tid = otid(), lane = tid & 63, wid = tid >> 6, lr = lane & 31, g = lane >> 5;
        const int c = it & 1023;
        if (it < 1024) {
            constexpr int CST = 16400;
            LAS unsigned char* cp = lds; LAS bf16_t* uL = (LAS bf16_t*)(lds + 8 * CST); LAS float* red = (LAS float*)(lds + 8 * CST + 18432);
            const int mi = wid & 1, ah = (wid >> 1) & 1, batch = wid >> 2;
            for (int order = 0; order < 2; ++order) {
                const int colf = order * 1024 + c, colb = 2048 + order * 1024 + c;
                blk_sum2(tid < 256 ? PS[(size_t)(16 + tid) * 4096 + colf] : 0.f, red, 0); blk_sum2(tid < 256 ? PS[(size_t)(16 + tid) * 4096 + colb] : 0.f, red, 1);
                __syncthreads();
                float sf = 0.f, sb = 0.f;
#pragma unroll
                for (int q = 0; q < 8; ++q) { sf += red[q]; sb += red[8 + q]; }
                const float nf = 1.0f / (sf + 1e-6f), nb = 1.0f / (sb + 1e-6f), skip = p.in[I_HSKIP][order * 1024 + c];
                const float* hf = FtS + (size_t)colf * 4096; const float* hb = FtS + (size_t)colb * 4096;
                { float pv[24];
#pragma unroll
                  for (int j = 0; j < 24; ++j) { const int i = 16 * tid + j; float v;
                      if (i <= 0 || i >= 8192) v = 0.f; else if (i < 4096) v = hf[4096 - i] * nf; else if (i == 4096) v = hf[0] * nf + hb[0] * nb + skip; else v = hb[i - 4096] * nb;
                      pv[j] = v; }
#pragma unroll
                  for (int rho = 0; rho < 8; ++rho) { LAS unsigned char* d = cp + rho * CST + tid * 32;
                      *(LAS u32x4*)d = (u32x4){cvt_pk_bf16(pv[rho], pv[rho + 1]), cvt_pk_bf16(pv[rho + 2], pv[rho + 3]), cvt_pk_bf16(pv[rho + 4], pv[rho + 5]), cvt_pk_bf16(pv[rho + 6], pv[rho + 7])};
                      *(LAS u32x4*)(d + 16) = (u32x4){cvt_pk_bf16(pv[rho + 8], pv[rho + 9]), cvt_pk_bf16(pv[rho + 10], pv[rho + 11]), cvt_pk_bf16(pv[rho + 12], pv[rho + 13]), cvt_pk_bf16(pv[rho + 14], pv[rho + 15])}; } }
                if (order == 0) {
#pragma unroll
                    for (int i = 0; i < 2; ++i) { const int idx = tid + i * 512, bt = idx >> 9, ch = idx & 511;
                        *(LAS u32x4*)(uL + bt * 4608 + (ch >> 3) * 72 + (ch & 7) * 8) = *(const u32x4*)(Zt + (size_t)(2048 + c) * NT + NTP + bt * 4096 + ch * 8); }
                }
                __syncthreads();
                f32x16 acc;
#pragma unroll
                for (int r = 0; r < 16; ++r) acc[r] = 0.f;
                const int bp = 32 * mi + lr, rho = (-bp) & 7;
                const LAS unsigned char* cb = cp + rho * CST; const LAS bf16_t* ub = uL + batch * 4608;
                for (int e = 32 * ah - 63; e <= 32 * ah + 31; ++e) {
                    const int aa = 32 * ah + lr - e; const bool valid = (unsigned)aa < 64u; const int aac = aa & 63;
#pragma unroll
                    for (int ks = 0; ks < 4; ++ks) {
                        const int q = 4096 + 16 * ks + 8 * g - bp - 64 * e;
                        const bf16x8 af = *(const LAS bf16x8*)(cb + (q - rho) * 2);
                        u32x4 bw = *(const LAS u32x4*)(ub + aac * 72 + 16 * ks + 8 * g);
                        if (!valid) bw = (u32x4){0u, 0u, 0u, 0u};
                        acc = __builtin_amdgcn_mfma_f32_32x32x16_bf16(af, __builtin_bit_cast(bf16x8, bw), acc, 0, 0, 0);
                    }
                }
                __syncthreads();
                { const bf16_t* gp = Zt + (size_t)(order == 0 ? c : 1024 + c) * NT + NTP + batch * 4096; const int a = 32 * ah + lr;
#pragma unroll
                  for (int q4 = 0; q4 < 4; ++q4) { const int bq = 32 * mi + 8 * q4 + 4 * g; const u32x2 gv = *(const u32x2*)(gp + 64 * a + bq);
                      *(LAS u32x2*)(uL + batch * 4608 + a * 72 + bq) = (u32x2){cvt_pk_bf16(acc[4 * q4] * bflo(gv.x), acc[4 * q4 + 1] * bfhi(gv.x)), cvt_pk_bf16(acc[4 * q4 + 2] * bflo(gv.y), acc[4 * q4 + 3] * bfhi(gv.y))}; } }
                __syncthreads();
            }
#pragma unroll
            for (int i = 0; i < 2; ++i) { const int idx = tid + i * 512, bt = idx >> 9, ch = idx & 511;
                *(u32x4*)(yT + (size_t)c * NT + NTP + bt * 4096 + ch * 8) = *(const LAS u32x4*)(uL + bt * 4608 + (ch >> 3) * 72 + (ch & 7) * 8); }
            __syncthreads();
        } else {
            constexpr int CSP = 1040;
            LAS unsigned char* cp = lds; LAS bf16_t* uL = (LAS bf16_t*)(lds + 8 * CSP); LAS float* red = (LAS float*)(lds + 8 * CSP + 16896);
            const int mi = wid;
            for (int order = 0; order < 2; ++order) {
                const int colf = order * 1024 + c, colb = 2048 + order * 1024 + c;
                blk_sum2(tid < 16 ? PS[(size_t)tid * 4096 + colf] : 0.f, red, 0); blk_sum2(tid < 16 ? PS[(size_t)tid * 4096 + colb] : 0.f, red, 1);
                __syncthreads();
                float sf = 0.f, sb = 0.f;
#pragma unroll
                for (int q = 0; q < 8; ++q) { sf += red[q]; sb += red[8 + q]; }
                const float nf = 1.0f / (sf + 1e-6f), nb = 1.0f / (sb + 1e-6f), skip = p.in[I_HSKIP][order * 1024 + c];
                const float* hf = FtP + (size_t)colf * 256; const float* hb = FtP + (size_t)colb * 256;
                { const int rho = tid >> 6, ch = tid & 63; float pv[8];
#pragma unroll
                  for (int j = 0; j < 8; ++j) { const int i = 8 * ch + rho + j; float v;
                      if (i <= 0 || i >= 512) v = 0.f; else if (i < 256) v = hf[256 - i] * nf; else if (i == 256) v = hf[0] * nf + hb[0] * nb + skip; else v = hb[i - 256] * nb;
                      pv[j] = v; }
                  *(LAS u32x4*)(cp + rho * CSP + ch * 16) = (u32x4){cvt_pk_bf16(pv[0], pv[1]), cvt_pk_bf16(pv[2], pv[3]), cvt_pk_bf16(pv[4], pv[5]), cvt_pk_bf16(pv[6], pv[7])}; }
                if (order == 0) {
#pragma unroll
                    for (int i = 0; i < 2; ++i) { const int idx = tid + i * 512, bt = idx >> 5, ch = idx & 31;
                        *(LAS u32x4*)(uL + bt * 264 + ch * 8) = *(const u32x4*)(Zt + (size_t)(2048 + c) * NT + bt * 256 + ch * 8); }
                }
                __syncthreads();
                f32x16 acc;
#pragma unroll
                for (int r = 0; r < 16; ++r) acc[r] = 0.f;
                const int t = 32 * mi + lr, rho = (-t) & 7;
                const LAS unsigned char* cb = cp + rho * CSP;
#pragma unroll 4
                for (int ks = 0; ks < 16; ++ks) {
                    const int q = 256 + 16 * ks + 8 * g - t;
                    const bf16x8 af = *(const LAS bf16x8*)(cb + (q - rho) * 2);
                    const bf16x8 bf = *(const LAS bf16x8*)(uL + lr * 264 + 16 * ks + 8 * g);
                    acc = __builtin_amdgcn_mfma_f32_32x32x16_bf16(af, bf, acc, 0, 0, 0);
                }
                __syncthreads();
                { const bf16_t* gp = Zt + (size_t)(order == 0 ? c : 1024 + c) * NT + lr * 256;
#pragma unroll
                  for (int q4 = 0; q4 < 4; ++q4) { const int t4 = 32 * mi + 8 * q4 + 4 * g; const u32x2 gv = *(const u32x2*)(gp + t4);
                      *(LAS u32x2*)(uL + lr * 264 + t4) = (u32x2){cvt_pk_bf16(acc[4 * q4] * bflo(gv.x), acc[4 * q4 + 1] * bfhi(gv.x)), cvt_pk_bf16(acc[4 * q4 + 2] * bflo(gv.y), acc[4 * q4 + 3] * bfhi(gv.y))}; } }
                __syncthreads();
            }
#pragma unroll
            for (int i = 0; i < 2; ++i) { const int idx = tid + i * 512, bt = idx >> 5, ch = idx & 31;
                *(u32x4*)(yT + (size_t)c * NT + bt * 256 + ch * 8) = *(const LAS u32x4*)(uL + bt * 264 + ch * 8); }
            __syncthreads();
        }
    }
}
__device__ void hyena_untranspose(const Params& p, LAS unsigned char* lds) {
    const bf16_t* yT = (const bf16_t*)(p.ws + WS_U); bf16_t* H = (bf16_t*)(p.ws + WS_H);
    for (int it = blockIdx.x; it < 16 * 64; it += gridDim.x) { const int ct = it & 15, tt = it >> 4;
        vt_tile<4>(yT + (size_t)(ct * 64) * NT + tt * 256, NT, H + (size_t)(tt * 256) * DM + ct * 64, DM, (LAS bf16_t*)lds); }
}


#define XB_TMO      128
#define XB_XCNT(j)  (256  + 64 * (j))
#define XB_XSUB(j)  (1280 + 64 * (j))
#define XB_XGEN(j)  (2304 + 64 * (j))
#define XB_TOP      3328
#define XB_TOPGEN   3392
#define XCD_BAR_WORDS 3456
#define XB_SPIN_CAP (1u << 18)
__device__ __forceinline__ unsigned xb_ld(unsigned* p)              { return __hip_atomic_load(p, __ATOMIC_RELAXED, __HIP_MEMORY_SCOPE_AGENT); }
__device__ __forceinline__ unsigned xb_add(unsigned* p, unsigned v) { return __hip_atomic_fetch_add(p, v, __ATOMIC_RELAXED, __HIP_MEMORY_SCOPE_AGENT); }
__device__ __forceinline__ unsigned xb_xcc_id() { return (unsigned)__builtin_amdgcn_s_getreg((3 << 11) | 20) & 0xFu; }
#define XB_SPIN(cond, bar) do { unsigned _sp = 0; while (cond) { __builtin_amdgcn_s_sleep(1); \
    if ((++_sp & 255u) == 0u) { if (xb_ld(&(bar)[XB_TMO])) break; if (_sp > XB_SPIN_CAP) { atomicAdd(&(bar)[XB_TMO], 1u); break; } } } } while (0)
__device__ __forceinline__ void xcd_barrier_post(unsigned* bar) { if (threadIdx.x == 0) (void)xb_add(&bar[XB_XCNT(xb_xcc_id())], 1u); }
__device__ __forceinline__ void xcd_barrier_complete(unsigned* bar, unsigned x, unsigned& nloc, unsigned& nx) {
    const unsigned G = gridDim.x * gridDim.y * gridDim.z;
    unsigned sum, cnt, mine, sp = 0u;
    for (;;) {
        sum = 0u; cnt = 0u; mine = 0u;
#pragma unroll
        for (unsigned j = 0; j < 16; ++j) { const unsigned c = xb_ld(&bar[XB_XCNT(j)]); sum += c; cnt += (c > 0u) ? 1u : 0u; mine = (j == x) ? c : mine; }
        if (sum == G) break;
        __builtin_amdgcn_s_sleep(1);
        if ((++sp & 255u) == 0u) { if (xb_ld(&bar[XB_TMO])) break; if (sp > XB_SPIN_CAP) { atomicAdd(&bar[XB_TMO], 1u); break; } }
    }
    nloc = mine > 0u ? mine : 1u; nx = cnt > 0u ? cnt : 1u;
}
__device__ __forceinline__ void xcd_barrier(unsigned* bar, volatile LAS unsigned* st) {
    asm volatile("s_waitcnt vmcnt(0)" ::: "memory");
    __syncthreads();
    if (threadIdx.x == 0) {
        const unsigned x = xb_xcc_id();
        __builtin_amdgcn_s_waitcnt(0);
        unsigned nloc = st[0], nx = st[1];
        if (nloc == 0u) { xcd_barrier_complete(bar, x, nloc, nx); st[0] = nloc; st[1] = nx; }
        const unsigned old = xb_add(&bar[XB_XSUB(x)], 1u);
        const unsigned gen = old / nloc;
        if (old + 1u == (gen + 1u) * nloc) {
            __builtin_amdgcn_fence(__ATOMIC_RELEASE, "agent");
            asm volatile("s_waitcnt vmcnt(0)" ::: "memory");
            const unsigned og = xb_add(&bar[XB_TOP], 1u);
            const unsigned tg = og / nx;
            if (og + 1u == (tg + 1u) * nx) xb_add(&bar[XB_TOPGEN], 1u);
            else XB_SPIN(xb_ld(&bar[XB_TOPGEN]) == tg, bar);
            __builtin_amdgcn_fence(__ATOMIC_ACQUIRE, "agent");
            xb_add(&bar[XB_XGEN(x)], 1u);
            asm volatile("s_waitcnt vmcnt(0)" ::: "memory");
        } else {
            XB_SPIN(xb_ld(&bar[XB_XGEN(x)]) == gen, bar);
            __builtin_amdgcn_fence(__ATOMIC_ACQUIRE, "agent");
            asm volatile("s_waitcnt vmcnt(0)" ::: "memory");
        }
    }
    __syncthreads();
}

#ifndef REP_FLASH
#define REP_FLASH 1
#endif
#ifndef REP_L
#define REP_L -1
#endif
#ifndef REP_SYNC
#define REP_SYNC 1
#endif
#ifndef REP_GEMM
#define REP_GEMM 1
#endif
#ifndef DBG_L
#define DBG_L 2
#endif
constexpr int NPHASE = 42;

__device__ __forceinline__ void run_gemm_bf16(LAS unsigned char* lds, const bf16_t* A, const bf16_t* Bt, int N, int K, bf16_t* O) {
    pg8::Gemm g{A, Bt, NT, N, K}; pg8::StaticOrder S; S.init(NT, N, (int)gridDim.x, (int)blockIdx.x); pg8::EpiBf16 E{O, N};
    pg8::gemm_phase<pg8::EpiBf16, pg8::StaticOrder>(lds, g, S, E);
}
__device__ __forceinline__ void run_gemm_res(LAS unsigned char* lds, const bf16_t* A, const bf16_t* Bt, int K, bf16_t* X, const float* mod, int goff,
                                             bf16_t* An, const float* gnext, int scoff, int shoff, unsigned long long* slots, unsigned tag, int fin, float* Y, unsigned* bar) {
    pg8::Gemm g{A, Bt, NT, DM, K}; pg8::StaticOrder S; S.init(NT, DM, (int)gridDim.x, (int)blockIdx.x); pg8::EpiRes E{X, mod, goff, An, gnext, scoff, shoff, slots, tag, fin, Y, bar};
    pg8::gemm_phase<pg8::EpiRes, pg8::StaticOrder>(lds, g, S, E);
}

__device__ void conv_mixer_weights(const Params& p, int l, LAS unsigned char* lds) {
    bf16_t* W = (bf16_t*)(p.ws + WS_WMIX); int rot = 0;
    if (l == 0) { wconv(p.in[I_AQKV], 1024, 1536, W, lds, rot); wconv(p.in[I_AWO], 1024, 1024, W + (size_t)1536 * 1024, lds, rot); }
    else if (l == 1) { wconv(p.in[I_DQKV], 1024, 3072, W, lds, rot); wconv(p.in[I_DWO], 1024, 1024, W + (size_t)3072 * 1024, lds, rot); }
    else if (l == 2) { wconv(p.in[I_RWIN], 1024, 6144, W, lds, rot); wconv(p.in[I_RWO], 2048, 1024, W + (size_t)6144 * 1024, lds, rot); }
    else { wconv(p.in[I_HWIN], 1024, 3072, W, lds, rot); wconv(p.in[I_HWO], 1024, 1024, W + (size_t)3072 * 1024, lds, rot); }
}
__device__ void conv_ffn_weights(const Params& p, int l, LAS unsigned char* lds) {
    bf16_t* W = (bf16_t*)(p.ws + WS_WFFN); int rot = 0;
    wconv(p.in[I_FUP] + (size_t)l * 1024 * 5632, 1024, 5632, W, lds, rot); wconv(p.in[I_FDOWN] + (size_t)l * FF * 1024, FF, 1024, W + (size_t)5632 * 1024, lds, rot);
}

__device__ __forceinline__ bool phase_empty(int ph) { if (ph == 0) return false; if (ph == 41) return true;     const int l = (ph - 1) / 10, s = (ph - 1) % 10; return (s == 4 && l < 3)   || s == 6 || (s == 0 && l > 0); }

#ifndef ONLY
#define ONLY -1
#endif
#define EN(x) (ONLY == -1 || ONLY == (x))
__device__ __forceinline__ void run_phase(int ph, LAS unsigned char* lds) {
    KParamsPtr kp = (KParamsPtr)__builtin_amdgcn_kernarg_segment_ptr();
    asm volatile("" : "+s"(kp));
    Params p;
#pragma unroll
    for (int i = 0; i < 41; ++i) p.in[i] = kp->in[i];
    p.out = kp->out; p.ws = kp->ws;
    bf16_t* X = (bf16_t*)((unsigned char*)p.out + XR_OFF); const float* mod = (const float*)(p.ws + WS_MOD);
    bf16_t* H = (bf16_t*)(p.ws + WS_H); bf16_t* U = (bf16_t*)(p.ws + WS_U); bf16_t* XB = (bf16_t*)(p.ws + WS_X);
    bf16_t* WM = (bf16_t*)(p.ws + WS_WMIX); bf16_t* WF = (bf16_t*)(p.ws + WS_WFFN);
    if (ph == 0) { if (EN(0)) { prep_misc(p, lds); conv_mixer_weights(p, 0, lds); conv_ffn_weights(p, 0, lds); } return; }
    if (ph == 41) return;
    const int l = (ph - 1) / 10, s = (ph - 1) % 10;
    const int nin = l == 0 ? 1536 : (l == 2 ? 6144 : 3072);
    const int kout = l == 2 ? 2048 : 1024;
    unsigned long long* slots = (unsigned long long*)(p.ws + WS_SLOT);
    if (s == 0) { if (EN(2)) norm_mod(X, p.in[I_N1G] + l * DM, mod + l * 6144, 1 * 1024, 0, H); }
    else if (s == 1) { if (EN(4)) run_gemm_bf16(lds, H, WM, nin, 1024, U); }
    else if (s == 7) { if (EN(4)) run_gemm_bf16(lds, XB, WF, 5632, 1024, U); }
    else if (s == 5) { if (EN(5)) run_gemm_res(lds, l == 2 ? (const bf16_t*)(p.ws + WS_X + 36 * MiB) : H, WM + (size_t)nin * 1024, kout, X, mod, l * 6144 + 2 * 1024,
                                               XB, p.in[I_N2G] + l * DM, l * 6144 + 4 * 1024, l * 6144 + 3 * 1024, slots, (unsigned)(ph + 1), 0, p.out, (unsigned*)(p.ws + WS_BAR)); }
    else if (s == 9) { if (EN(5)) run_gemm_res(lds, XB, WF + (size_t)5632 * 1024, FF, X, mod, l * 6144 + 5 * 1024,
                                               l < 3 ? H : nullptr, l < 3 ? p.in[I_N1G] + (l + 1) * DM : p.in[I_FG], (l < 3 ? l + 1 : 0) * 6144 + 1 * 1024, (l < 3 ? l + 1 : 0) * 6144, slots, (unsigned)(ph + 1), l == 3 ? 1 : 0, p.out, (unsigned*)(p.ws + WS_BAR)); }
    else if (s == 8) { if (EN(6)) ffn_act_phase(U, XB, p.in[I_FCW] + (size_t)l * 3 * 5632, p.in[I_FCB] + (size_t)l * 5632); if (EN(0)) { if (l < 3) conv_mixer_weights(p, l + 1, lds); } }
    else if (s == 2) {
        if (l == 0) { if (EN(7)) { post_attn(p, U, XB, XB + (size_t)2 * 4352 * 256); vt_all(U, 1536, 1280, 256, XB + (size_t)2 * 4352 * 256 + (size_t)2 * 256 * 4352, XB + (size_t)2 * 4352 * 256, 4352, 256, lds); } }
        else if (l == 1) { if (EN(8)) { post_diff(p, U, XB, XB + (size_t)2 * 4352 * 1024, lds); vt_all(U, 3072, 2048, 1024, XB + (size_t)2 * 4352 * 1024 + (size_t)2 * 1024 * 4352, XB + (size_t)2 * 4352 * 1024, 4352, 256, lds); } }
        else if (l == 2) { if (EN(9)) ret_prep(p, lds); }
        else { if (EN(10)) hyena_dwconv_t(U, U + (size_t)NT * 3072, p.in[I_HSCW], p.in[I_HSCB]); if (EN(3)) hyena_filters(p, lds); }
        if (EN(0)) { if (l > 0) conv_ffn_weights(p, l, lds); }
    } else if (s == 3) {
        if (l < 3) { for (int rep = 0; rep < (l == REP_L ? 2 : REP_FLASH); ++rep) { if (l == 0) { if (EN(11)) attn_phase(p, lds); } else if (l == 1) { if (EN(12)) diff_phase(p, lds); } else if (l == 2) { if (EN(13)) ret_phase(p, lds); } } }
        else { if (EN(14)) hyena_mfma(p, lds); }
    } else if (s == 4) {
        if (l == 2) { if (EN(15)) ret_gate(p); }
        else if (l == 3) { if (EN(16)) hyena_untranspose(p, lds); }
    }
}

__global__ void __launch_bounds__(512, 2) mega_kernel(Params p, int ph_begin, int ph_end) {
    extern __shared__ __attribute__((aligned(16))) unsigned char shm[];
    LAS unsigned char* lds = (LAS unsigned char*)shm;
    cg::grid_group grid = cg::this_grid();
    volatile LAS unsigned* st = (volatile LAS unsigned*)(lds + LDS_BYTES - 16);
    if (threadIdx.x == 0) { st[0] = 0u; st[1] = 0u; }
    __syncthreads();
    xcd_barrier_post((unsigned*)(p.ws + WS_BAR));
    int nsync = 0;
    for (int ph = ph_begin; ph < ph_end; ++ph) {
        if (phase_empty(ph)) continue;
        if (nsync == 1) {
            __builtin_amdgcn_fence(__ATOMIC_RELEASE, "agent"); asm volatile("s_waitcnt vmcnt(0) lgkmcnt(0)" ::: "memory");
            grid.sync();
            __builtin_amdgcn_fence(__ATOMIC_ACQUIRE, "agent"); asm volatile("s_waitcnt vmcnt(0) lgkmcnt(0)" ::: "memory");
        } else if (nsync > 1) {
            KParamsPtr kp = (KParamsPtr)__builtin_amdgcn_kernarg_segment_ptr();
            xcd_barrier((unsigned*)(kp->ws + WS_BAR), st);
        }
        ++nsync;
        run_phase(ph, lds);
        __syncthreads();
    }
}

extern "C" void kernel_launch(void* const* d_in, const int* in_sizes, int n_in, void* d_out, int out_size, void* d_ws, size_t ws_size, hipStream_t stream) {
    static int grid_blocks = 0;
    if (!grid_blocks) {
        int dev = 0, cus = 0, per_cu = 0;
        hipGetDevice(&dev);
        hipDeviceGetAttribute(&cus, hipDeviceAttributeMultiprocessorCount, dev);
        if (hipFuncSetAttribute((const void*)mega_kernel, hipFuncAttributeMaxDynamicSharedMemorySize, LDS_BYTES) != hipSuccess) { fprintf(stderr, "hipFuncSetAttribute failed\n"); return; }
        if (hipOccupancyMaxActiveBlocksPerMultiprocessor(&per_cu, (const void*)mega_kernel, 512, LDS_BYTES) != hipSuccess || per_cu < 1) { fprintf(stderr, "occupancy query failed\n"); return; }
        if (cus != 256) { fprintf(stderr, "this kernel's residual epilogue needs exactly 256 workgroups (one 256x256 unit each); device has %d CUs\n", cus); return; }
        grid_blocks = cus;
    }
    if (ws_size < WS_NEED || n_in < 41) { fprintf(stderr, "workspace too small: %zu < %zu\n", ws_size, (size_t)WS_NEED); return; }
    Params p{};
    for (int i = 0; i < 41; ++i) p.in[i] = (const float*)d_in[i];
    p.out = (float*)d_out; p.ws = (unsigned char*)d_ws;
#if MULTI_LAUNCH
    for (int ph = 0; ph < NPHASE; ++ph) {
        int b = ph, e = ph + 1; void* args[] = {&p, &b, &e};
        hipLaunchCooperativeKernel((const void*)mega_kernel, dim3(grid_blocks), dim3(512), args, LDS_BYTES, stream);
    }
#else
    (void)hipMemsetAsync((unsigned char*)d_ws + WS_BAR, 0, XCD_BAR_WORDS * sizeof(unsigned), stream);
    (void)hipMemsetAsync((unsigned char*)d_ws + WS_SLOT, 0, WS_SLOT_BYTES + WS_PSLOT_BYTES + 256, stream);
    int b = 0, e = NPHASE; void* args[] = {&p, &b, &e};
    hipError_t err = hipLaunchCooperativeKernel((const void*)mega_kernel, dim3(grid_blocks), dim3(512), args, LDS_BYTES, stream);
    if (err != hipSuccess) fprintf(stderr, "cooperative launch failed: %s (grid %d)\n", hipGetErrorString(err), grid_blocks);
#endif
}
```

```cpp
#include <hip/hip_runtime.h>
#include <hip/hip_cooperative_groups.h>
#include <cstdio>
namespace cg = cooperative_groups;

#ifndef MULTI_LAUNCH
#define MULTI_LAUNCH 0
#endif

#define LAS __attribute__((address_space(3)))
typedef unsigned short bf16_t;
typedef short bf16x8 __attribute__((ext_vector_type(8)));
typedef float f32x4 __attribute__((ext_vector_type(4)));
typedef float f32x16 __attribute__((ext_vector_type(16)));
typedef unsigned u32x4 __attribute__((ext_vector_type(4)));
typedef unsigned u32x2 __attribute__((ext_vector_type(2)));

constexpr int NT = 16384;
constexpr int NTP = 8192;
constexpr int DM = 1024;
constexpr int FF = 2816;
constexpr int LDS_BYTES = 155648;
constexpr size_t MiB = 1048576;
constexpr size_t WS_MOD = 0;
constexpr size_t WS_IDENT = 512 * 1024;
constexpr size_t WS_SLOT = 2 * 1048576;
constexpr size_t WS_SLOT_BYTES = 64 * 4 * 256 * 8;
constexpr size_t WS_PSLOT = WS_SLOT + WS_SLOT_BYTES;
constexpr size_t WS_PSLOT_BYTES = 512 * 2 * 128 * 8;
constexpr size_t WS_DQMAX = WS_PSLOT + WS_PSLOT_BYTES + 16;
constexpr size_t WS_CKMAX = WS_PSLOT + WS_PSLOT_BYTES;
constexpr size_t WS_BAR = 1024 * 1024;
constexpr size_t WS_WMIX = 4 * MiB;
constexpr size_t WS_WFFN = 22 * MiB;
constexpr size_t WS_H = 40 * MiB;
constexpr size_t WS_U = 72 * MiB;
constexpr size_t WS_X = 264 * MiB;
constexpr size_t WS_IDENTW = 364 * MiB;
constexpr size_t WS_NEED = 368 * MiB;
constexpr size_t XR_OFF = 32 * 1048576;
constexpr size_t OUT_NAK = 16777216, OUT_NAV = 18874368, OUT_NDK = 20971520, OUT_NDV = 29360128, OUT_NSR = 37748736;

struct Params { const float* in[41]; float* out; unsigned char* ws; };
typedef const __attribute__((address_space(4))) Params* KParamsPtr;
constexpr int LDS_RETPARAM = 148 * 1024;

enum { I_XP = 0, I_XS, I_CAK, I_CAV, I_CDK, I_CDV, I_SRET, I_C, I_CCTX, I_WMOD, I_BMOD, I_N1G, I_N2G, I_FG, I_AQKV, I_AQG, I_AKG, I_AWO,
       I_DQKV, I_DLAM, I_DSUB, I_DWO, I_RWIN, I_RLD, I_RGN, I_RWO, I_HWIN, I_HSCW, I_HSCB, I_HW1, I_HB1, I_HW2, I_HB2, I_HW3, I_HFREQ, I_HSKIP, I_HWO,
       I_FUP, I_FCW, I_FCB, I_FDOWN };

__device__ __forceinline__ int otid() { int t = (int)threadIdx.x; asm volatile("" : "+v"(t)); return t; }
typedef float f32x2v __attribute__((ext_vector_type(2)));
typedef __bf16 bf16x2v __attribute__((ext_vector_type(2)));
__device__ __forceinline__ unsigned cvt_pk_bf16(float lo, float hi) { const f32x2v v = {lo, hi}; const bf16x2v b = __builtin_convertvector(v, bf16x2v); return __builtin_bit_cast(unsigned, b); }
__device__ __forceinline__ bf16_t f2bf(float f) { return (bf16_t)(cvt_pk_bf16(f, 0.f) & 0xffffu); }
__device__ __forceinline__ float bf2f(bf16_t b) { return __uint_as_float(((unsigned)b) << 16); }
__device__ __forceinline__ float bflo(unsigned w) { return __uint_as_float(w << 16); }
__device__ __forceinline__ float bfhi(unsigned w) { return __uint_as_float(w & 0xffff0000u); }
__device__ __forceinline__ float shfl_xor_f(float v, int m) { return __int_as_float(__builtin_amdgcn_ds_bpermute((((int)(otid() & 63)) ^ m) << 2, __float_as_int(v))); }
__device__ __forceinline__ float wave_sum(float v) {
#pragma unroll
    for (int o = 32; o >= 1; o >>= 1) v += shfl_xor_f(v, o);
    return v;
}
__device__ __forceinline__ float fast_exp2(float x) { return __builtin_amdgcn_exp2f(x); }
__device__ __forceinline__ float siluf(float x) { return x * __builtin_amdgcn_rcpf(1.0f + __expf(-x)); }
__device__ __forceinline__ float sin_rr(float x) { float r = x * 0.15915494309189535f; r -= rintf(r); return __builtin_amdgcn_sinf(r); }
__device__ __forceinline__ float cos_rr(float x) { float r = x * 0.15915494309189535f; r -= rintf(r); return __builtin_amdgcn_cosf(r); }
__device__ __forceinline__ float sin_rev(float r) { r -= rintf(r); return __builtin_amdgcn_sinf(r); }
__device__ __forceinline__ float cos_rev(float r) { r -= rintf(r); return __builtin_amdgcn_cosf(r); }

__device__ __forceinline__ void xcd_barrier(unsigned* bar, volatile LAS unsigned* st);
namespace pg8 {
constexpr int BM = 256, BK = 64, HALF = 128, HTB = HALF * BK * 2, STAGE_BYTES = 8 * HTB, NXCD = 8, WGM = 8;
__device__ __forceinline__ int lds_byte(int r, int c) { const int st = (r >> 4) * 2 + (c >> 5), rr = r & 15, cc = c & 31, ob = rr * 64 + cc * 2; return st * 1024 + (ob ^ (((ob >> 9) & 1) << 5)); }
__device__ __forceinline__ void stage_rc(int b, int& R, int& C) { const int st = b / 1024, sb = b % 1024, swz = sb ^ (((sb >> 9) & 1) << 5); R = (st >> 1) * 16 + swz / 64; C = (st & 1) * 32 + (swz % 64) / 2; }
__device__ __forceinline__ int perm32(int rho) { const int n = rho >> 4, i = rho & 15; return 8 * (i >> 2) + 4 * n + (i & 3); }
struct Unit { int pm, pn; };
struct Gemm { const bf16_t* A; const bf16_t* Bt; int M, N, K; };
struct StaticOrder {
    int nM, nN, nwg, G, c;
    __device__ void init(int M, int N, int G_, int c_) { nM = M / BM; nN = N / BM; nwg = nM * nN; G = G_; c = c_; }
    __device__ bool next(int i, Unit& u) const {
        const long L = (long)i * G + c; if (L >= nwg) return false;
        int wgid = (int)L; { const int q = nwg / NXCD, r = nwg % NXCD, xcd = wgid % NXCD, off = wgid / NXCD; wgid = (xcd < r ? xcd * (q + 1) : r * (q + 1) + (xcd - r) * q) + off; }
        const int nig = WGM * nN, gid = wgid / nig, fm = gid * WGM, gsz = (nM - fm) < WGM ? (nM - fm) : WGM;
        u.pm = fm + ((wgid % nig) % gsz); u.pn = (wgid % nig) / gsz; return true;
    }
    __device__ __forceinline__ void a_ready(const Unit&) const {}
    __device__ __forceinline__ void done(const Unit&) const {}
};
struct EpiBf16 {
    static constexpr bool PERM = true, AFTER_DRAIN = false;
    bf16_t* O; int ldc;
    __device__ __forceinline__ void operator()(const f32x4 (&acc)[2][2][4][2], const Unit& u, int wr, int wc, int fr, int fq) const {
        const int row0 = u.pm * BM + wr * 64 + fr; const int col0 = u.pn * BM + wc * 32 + 8 * fq;
#pragma unroll
        for (int ai = 0; ai < 2; ++ai)
#pragma unroll
            for (int m = 0; m < 4; ++m) { bf16_t* rowp = O + (size_t)(row0 + ai * HALF + m * 16) * ldc + col0;
#pragma unroll
                for (int bj = 0; bj < 2; ++bj) { f32x4 v0 = acc[ai][bj][m][0], v1 = acc[ai][bj][m][1];
                    u32x4 w; w.x = cvt_pk_bf16(v0[0], v0[1]); w.y = cvt_pk_bf16(v0[2], v0[3]); w.z = cvt_pk_bf16(v1[0], v1[1]); w.w = cvt_pk_bf16(v1[2], v1[3]);
                    *(u32x4*)(rowp + bj * HALF) = w; } }
    }
};
struct EpiRes {
    static constexpr bool PERM = false, AFTER_DRAIN = true;
    bf16_t* X; const float* mod; int goff;
    bf16_t* An; const float* gnext; int scoff, shoff; unsigned long long* slots; unsigned tag; int fin; float* Y; unsigned* bar;
    __device__ __forceinline__ void fused(f32x4 (&acc)[2][2][4][2], const Unit& u, int wr, int wc, int fr, int fq, LAS unsigned char* lds) const {
        const int row0 = u.pm * BM + wr * 64 + fr, col0 = u.pn * BM + wc * 32 + 4 * fq;
        const int cond = u.pm < 32 ? 0 : (u.pm < 48 ? 1 : 2);
        const float* gp = mod + cond * 24576 + goff + col0;
        f32x4 gv[2][2];
#pragma unroll
        for (int bj = 0; bj < 2; ++bj)
#pragma unroll
            for (int n = 0; n < 2; ++n) gv[bj][n] = *(const f32x4*)(gp + bj * HALF + n * 16);
        float ss[2][4];
#pragma unroll
        for (int ai = 0; ai < 2; ++ai)
#pragma unroll
            for (int m = 0; m < 4; ++m) { bf16_t* rowp = X + (size_t)(row0 + ai * HALF + m * 16) * DM + col0; float t = 0.f;
#pragma unroll
                for (int bj = 0; bj < 2; ++bj)
#pragma unroll
                    for (int n = 0; n < 2; ++n) { u32x2* p = (u32x2*)(rowp + bj * HALF + n * 16); const u32x2 w = *p; f32x4 v = (f32x4){bflo(w.x), bfhi(w.x), bflo(w.y), bfhi(w.y)}; v += gv[bj][n] * acc[ai][bj][m][n];
                        if (!fin) *p = (u32x2){cvt_pk_bf16(v[0], v[1]), cvt_pk_bf16(v[2], v[3])}; acc[ai][bj][m][n] = v; t += v[0] * v[0] + v[1] * v[1] + v[2] * v[2] + v[3] * v[3]; }
                ss[ai][m] = t; }
        if (An == nullptr && !fin) return;
        LAS float* xl = (LAS float*)lds;
#pragma unroll
        for (int ai = 0; ai < 2; ++ai)
#pragma unroll
            for (int m = 0; m < 4; ++m) { float t = ss[ai][m]; t += shfl_xor_f(t, 16); t += shfl_xor_f(t, 32); if (fq == 0) xl[(ai * HALF + wr * 64 + m * 16 + fr) * 4 + wc] = t; }
        __syncthreads();
        const int tid = otid();
        if (tid < 256) {
            const f32x4 q = *(const LAS f32x4*)(xl + tid * 4); const float mine = q[0] + q[1] + q[2] + q[3];
            unsigned long long* sp = slots + ((size_t)u.pm * 4) * 256 + tid;
            (void)__hip_atomic_exchange(sp + (size_t)u.pn * 256, ((unsigned long long)tag << 32) | (unsigned long long)__float_as_uint(mine), __ATOMIC_RELAXED, __HIP_MEMORY_SCOPE_AGENT);
            float tot = mine;
#pragma unroll
            for (int k = 1; k < 4; ++k) { unsigned long long* o = sp + (size_t)((u.pn + k) & 3) * 256; unsigned long long v; unsigned spin = 0;
                for (;;) { v = __hip_atomic_load(o, __ATOMIC_RELAXED, __HIP_MEMORY_SCOPE_AGENT); if ((unsigned)(v >> 32) == tag) break; __builtin_amdgcn_s_sleep(1); if (++spin > (1u << 22)) break; }
                tot += __uint_as_float((unsigned)v); }
            xl[1024 + tid] = rsqrtf(tot * (1.0f / 1024.0f) + 1e-6f);
        }
        __syncthreads();
        if (fin) {
            xcd_barrier(bar, (volatile LAS unsigned*)(lds + LDS_BYTES - 16));
#pragma unroll
            for (int ai = 0; ai < 2; ++ai)
#pragma unroll
                for (int m = 0; m < 4; ++m) { const int rl = ai * HALF + wr * 64 + m * 16 + fr; const float rs = xl[1024 + rl]; float* rowp = Y + (size_t)(u.pm * BM + rl) * DM + col0;
#pragma unroll
                    for (int bj = 0; bj < 2; ++bj)
#pragma unroll
                        for (int n = 0; n < 2; ++n) { const f32x4 g4 = *(const f32x4*)(gnext + col0 + bj * HALF + n * 16); *(f32x4*)(rowp + bj * HALF + n * 16) = acc[ai][bj][m][n] * rs * g4; } }
            return;
        }
        f32x4 Gn[2][2], Sh[2][2];
#pragma unroll
        for (int bj = 0; bj < 2; ++bj)
#pragma unroll
            for (int n = 0; n < 2; ++n) { const int c = col0 + bj * HALF + n * 16; const f32x4 g4 = *(const f32x4*)(gnext + c), s4 = *(const f32x4*)(mod + cond * 24576 + scoff + c);
                Gn[bj][n] = g4 * (s4 + 1.0f); Sh[bj][n] = *(const f32x4*)(mod + cond * 24576 + shoff + c); }
#pragma unroll
        for (int ai = 0; ai < 2; ++ai)
#pragma unroll
            for (int m = 0; m < 4; ++m) { const int rl = ai * HALF + wr * 64 + m * 16 + fr; const int row = u.pm * BM + rl; const float rs = xl[1024 + rl];
                bf16_t* op = An + (size_t)row * DM + col0;
#pragma unroll
                for (int bj = 0; bj < 2; ++bj)
#pragma unroll
                    for (int n = 0; n < 2; ++n) { const f32x4 h = acc[ai][bj][m][n] * rs * Gn[bj][n] + Sh[bj][n];
                        *(u32x2*)(op + bj * HALF + n * 16) = (u32x2){cvt_pk_bf16(h[0], h[1]), cvt_pk_bf16(h[2], h[3])}; } }
    }
};

template <class Epi, class Sched>
__device__ __forceinline__ void gemm_phase(LAS unsigned char* lds, const Gemm g, const Sched& S, const Epi& E) {
    const int tid = otid(), wid = __builtin_amdgcn_readfirstlane(tid >> 6), lane = tid & 63, wr = wid >> 2, wc = wid & 3, fr = lane & 15, fq = lane >> 4;
    const int K = g.K, nt = K / BK;
    unsigned voffA[2], voffB[2];
#pragma unroll
    for (int i = 0; i < 2; ++i) { int R, C; stage_rc(tid * 16 + i * 8192, R, C); const int Rb = Epi::PERM ? ((R & ~31) + perm32(R & 31)) : R;
        voffA[i] = (unsigned)(R * K + C) * 2u; voffB[i] = (unsigned)(Rb * K + C) * 2u; }
    const size_t kstep = (size_t)(BK * 2);
    const size_t hstep = (size_t)HALF * K * 2;
    const size_t tstep = 2 * hstep;
    const unsigned ldsw = (unsigned)wid * 1024u;
    const int aoff = lds_byte(wr * 64 + fr, fq * 8), boff = lds_byte(wc * 32 + fr, fq * 8);
#define PG8_SA(b, h) (((b) * 2 + (h)) * HTB)
#define PG8_SB(b, h) ((4 + (b) * 2 + (h)) * HTB)
#define PG8_STAGE(bufoff, gbase, voff) do { _Pragma("unroll") for (int _i = 0; _i < 2; ++_i) \
        __builtin_amdgcn_global_load_lds((const unsigned*)((const char*)(gbase) + (voff)[_i]), (LAS unsigned*)(lds + (bufoff) + ldsw + _i * 8192), 16, 0, 0); } while (0)
#define PG8_LDA(dst, b, h) do { _Pragma("unroll") for (int m = 0; m < 4; ++m) _Pragma("unroll") for (int k = 0; k < 2; ++k) dst[m][k] = *(const LAS bf16x8*)(lds + PG8_SA(b, h) + aoff + m * 2048 + k * 1024); } while (0)
#define PG8_LDB(dst, b, h) do { _Pragma("unroll") for (int n = 0; n < 2; ++n) _Pragma("unroll") for (int k = 0; k < 2; ++k) dst[n][k] = *(const LAS bf16x8*)(lds + PG8_SB(b, h) + boff + n * 2048 + k * 1024); } while (0)
#define PG8_MMA(ai, bj, At, Bt) do { __builtin_amdgcn_s_setprio(1); _Pragma("unroll") for (int m = 0; m < 4; ++m) _Pragma("unroll") for (int n = 0; n < 2; ++n) _Pragma("unroll") for (int k = 0; k < 2; ++k) \
        acc[ai][bj][m][n] = __builtin_amdgcn_mfma_f32_16x16x32_bf16(Bt[n][k], At[m][k], acc[ai][bj][m][n], 0, 0, 0); __builtin_amdgcn_s_setprio(0); } while (0)
#define PG8_WAIT_V(n) asm volatile("s_waitcnt vmcnt(" #n ")" ::: "memory")
#define PG8_WAIT_L(n) asm volatile("s_waitcnt lgkmcnt(" #n ")" ::: "memory")
#define PG8_BAR __builtin_amdgcn_s_barrier()
#define PG8_SCHED __builtin_amdgcn_sched_barrier(0)
    Unit cur, nxt; int ui = 0;
    if (!S.next(0, cur)) return;
    f32x4 acc[2][2][4][2];
#pragma unroll
    for (int a = 0; a < 2; ++a)
#pragma unroll
        for (int b = 0; b < 2; ++b)
#pragma unroll
            for (int m = 0; m < 4; ++m)
#pragma unroll
                for (int n = 0; n < 2; ++n) acc[a][b][m][n] = (f32x4){0.f, 0.f, 0.f, 0.f};
    bf16x8 At[4][2], B0[2][2], B1[2][2];
    const char* cA = (const char*)g.A + (size_t)cur.pm * tstep; const char* cB = (const char*)g.Bt + (size_t)cur.pn * tstep;
    S.a_ready(cur);
    PG8_STAGE(PG8_SB(0, 0), cB, voffB); PG8_STAGE(PG8_SA(0, 0), cA, voffA); PG8_STAGE(PG8_SB(0, 1), cB + hstep, voffB); PG8_STAGE(PG8_SA(0, 1), cA + hstep, voffA);
    if (wr == 1) PG8_BAR;
    PG8_WAIT_V(4); PG8_BAR;
    PG8_STAGE(PG8_SB(1, 0), cB + kstep, voffB); PG8_STAGE(PG8_SA(1, 0), cA + kstep, voffA); PG8_STAGE(PG8_SB(1, 1), cB + hstep + kstep, voffB);
    PG8_WAIT_V(6); PG8_BAR;
    for (;;) {
        const bool has_next = S.next(ui + 1, nxt);
        const char* nA = has_next ? (const char*)g.A + (size_t)nxt.pm * tstep : cA; const char* nB = has_next ? (const char*)g.Bt + (size_t)nxt.pn * tstep : cB;
        for (int t = 0; t < nt; t += 2) {
            const bool last = (t == nt - 2);
            const char* a1 = cA + (size_t)(t + 1) * kstep;
            const char* a2 = last ? nA : cA + (size_t)(t + 2) * kstep; const char* b2 = last ? nB : cB + (size_t)(t + 2) * kstep;
            const char* a3 = a2 + kstep; const char* b3 = b2 + kstep;
            if (last && has_next) S.a_ready(nxt);
            PG8_LDB(B0, 0, 0); PG8_SCHED; PG8_LDA(At, 0, 0); PG8_STAGE(PG8_SA(1, 1), a1 + hstep, voffA);
            PG8_WAIT_L(8); PG8_BAR; PG8_WAIT_L(0); PG8_MMA(0, 0, At, B0); PG8_BAR; PG8_SCHED;
            PG8_LDB(B1, 0, 1); PG8_STAGE(PG8_SB(0, 0), b2, voffB);
            PG8_BAR; PG8_WAIT_L(0); PG8_MMA(0, 1, At, B1); PG8_BAR;
            PG8_LDA(At, 0, 1); PG8_STAGE(PG8_SA(0, 0), a2, voffA);
            PG8_BAR; PG8_WAIT_L(0); PG8_MMA(1, 0, At, B0); PG8_BAR; PG8_SCHED;
            PG8_STAGE(PG8_SB(0, 1), b2 + hstep, voffB);
            PG8_WAIT_V(6); PG8_BAR; PG8_MMA(1, 1, At, B1); PG8_BAR;
            PG8_LDB(B0, 1, 0); PG8_SCHED; PG8_LDA(At, 1, 0); PG8_STAGE(PG8_SA(0, 1), a2 + hstep, voffA);
            PG8_WAIT_L(8); PG8_BAR; PG8_WAIT_L(0); PG8_MMA(0, 0, At, B0); PG8_BAR; PG8_SCHED;
            PG8_LDB(B1, 1, 1); PG8_STAGE(PG8_SB(1, 0), b3, voffB);
            PG8_BAR; PG8_WAIT_L(0); PG8_MMA(0, 1, At, B1); PG8_BAR;
            PG8_LDA(At, 1, 1); PG8_STAGE(PG8_SA(1, 0), a3, voffA);
            PG8_BAR; PG8_WAIT_L(0); PG8_MMA(1, 0, At, B0); PG8_BAR; PG8_SCHED;
            PG8_STAGE(PG8_SB(1, 1), b3 + hstep, voffB);
            PG8_WAIT_V(6); PG8_BAR; PG8_MMA(1, 1, At, B1); PG8_BAR;
        }
        if constexpr (!Epi::AFTER_DRAIN) { E(acc, cur, wr, wc, fr, fq); S.done(cur); }
        if (!has_next) break;
#pragma unroll
        for (int a = 0; a < 2; ++a)
#pragma unroll
            for (int b = 0; b < 2; ++b)
#pragma unroll
                for (int m = 0; m < 4; ++m)
#pragma unroll
                    for (int n = 0; n < 2; ++n) acc[a][b][m][n] = (f32x4){0.f, 0.f, 0.f, 0.f};
        cur = nxt; cA = nA; cB = nB; ++ui;
    }
    PG8_WAIT_V(0);
    if (wr == 0) PG8_BAR;
    PG8_BAR;
    if constexpr (Epi::AFTER_DRAIN) { E.fused(acc, cur, wr, wc, fr, fq, lds); S.done(cur); }
#undef PG8_SA
#undef PG8_SB
#undef PG8_STAGE
#undef PG8_LDA
#undef PG8_LDB
#undef PG8_MMA
#undef PG8_WAIT_V
#undef PG8_WAIT_L
#undef PG8_BAR
#undef PG8_SCHED
}
}

template <bool P16 = false>
__device__ __forceinline__ void wconv_tile(const float* __restrict__ src, int N, bf16_t* __restrict__ dst, int ldd, int kt, int ntile, LAS float* tl) {
    const int tid = otid();
#pragma unroll
    for (int i = 0; i < 2; ++i) { const int k = (tid >> 4) + 32 * i, n4 = (tid & 15) * 4;
        const f32x4 v = *(const f32x4*)(src + (size_t)(kt * 64 + k) * N + ntile * 64 + n4);
        tl[k * 65 + n4] = v[0]; tl[k * 65 + n4 + 1] = v[1]; tl[k * 65 + n4 + 2] = v[2]; tl[k * 65 + n4 + 3] = v[3]; }
    __syncthreads();
    { const int n = tid >> 3, k8 = (tid & 7) * 8; u32x4 w;
      w.x = cvt_pk_bf16(tl[(k8 + 0) * 65 + n], tl[(k8 + 1) * 65 + n]); w.y = cvt_pk_bf16(tl[(k8 + 2) * 65 + n], tl[(k8 + 3) * 65 + n]);
      w.z = cvt_pk_bf16(tl[(k8 + 4) * 65 + n], tl[(k8 + 5) * 65 + n]); w.w = cvt_pk_bf16(tl[(k8 + 6) * 65 + n], tl[(k8 + 7) * 65 + n]);
      if (P16) { const int odd = (tid & 1); bf16_t* d = dst + (size_t)(ntile * 64 + n) * ldd + kt * 64;
          *(u32x2*)(d + (odd ? k8 - 4 : k8)) = (u32x2){w.x, w.y}; *(u32x2*)(d + (odd ? k8 + 4 : k8 + 8)) = (u32x2){w.z, w.w}; }
      else *(u32x4*)(dst + (size_t)(ntile * 64 + n) * ldd + kt * 64 + k8) = w; }
    __syncthreads();
}
__device__ void wconv(const float* src, int K, int N, bf16_t* dst, LAS unsigned char* lds, int& rot) {
    const int nk = K / 64, nn = N / 64, tot = nk * nn;
    int start = (int)blockIdx.x - rot; while (start < 0) start += gridDim.x;
    for (int it = start; it < tot; it += gridDim.x) wconv_tile(src, N, dst, K, it / nn, it % nn, (LAS float*)lds);
    rot = (rot + tot) % (int)gridDim.x;
}
template <int NQ, bool P16 = false>
__device__ __forceinline__ void vt_tile(const bf16_t* __restrict__ src, int ld, bf16_t* __restrict__ dst, size_t ldd, LAS bf16_t* tl) {
    const int tid = otid();
    { const int r = tid >> 3, c8 = (tid & 7) * 8; u32x4 v[NQ];
#pragma unroll
      for (int q = 0; q < NQ; ++q) v[q] = *(const u32x4*)(src + (size_t)r * ld + q * 64 + c8);
#pragma unroll
      for (int q = 0; q < NQ; ++q) *(LAS u32x4*)(tl + q * 4608 + r * 72 + c8) = v[q]; }
    __syncthreads();
    { const int c = tid >> 3, t8 = (tid & 7) * 8;
#pragma unroll
      for (int q = 0; q < NQ; ++q) { unsigned w[4];
#pragma unroll
          for (int j = 0; j < 4; ++j) w[j] = (unsigned)tl[q * 4608 + (t8 + 2 * j) * 72 + c] | ((unsigned)tl[q * 4608 + (t8 + 2 * j + 1) * 72 + c] << 16);
          if (P16) { const int odd = (tid & 1); bf16_t* d = dst + (size_t)(q * 64 + c) * ldd;
              *(u32x2*)(d + (odd ? t8 - 4 : t8)) = (u32x2){w[0], w[1]}; *(u32x2*)(d + (odd ? t8 + 4 : t8 + 8)) = (u32x2){w[2], w[3]}; }
          else *(u32x4*)(dst + (size_t)(q * 64 + c) * ldd + t8) = (u32x4){w[0], w[1], w[2], w[3]}; } }
    __syncthreads();
}
template <bool P16 = false>
__device__ void vt_all(const bf16_t* U, int ld, int vc0, int C, bf16_t* VtP, bf16_t* VtS, int LK, int koff, LAS unsigned char* lds) {
    const int nct = C / 256, tot = (NT / 64) * nct;
    for (int it = blockIdx.x; it < tot; it += gridDim.x) {
        const int tt = it / nct, ct = it % nct, t0 = tt * 64;
        const bf16_t* src = U + (size_t)t0 * ld + vc0 + ct * 256;
        if (t0 < NTP) { const int b = t0 >> 8, tp = t0 & 255; vt_tile<4, P16>(src, ld, VtP + ((size_t)b * C + ct * 256) * 256 + tp, 256, (LAS bf16_t*)lds); }
        else { const int ts = t0 - NTP, b = ts >> 12, tp = ts & 4095; vt_tile<4, P16>(src, ld, VtS + ((size_t)b * C + ct * 256) * LK + koff + tp, (size_t)LK, (LAS bf16_t*)lds); }
    }
}
__device__ void norm_mod(const bf16_t* __restrict__ X, const float* __restrict__ g, const float* __restrict__ mod, int scoff, int shoff, bf16_t* __restrict__ H) {
    const int lane = otid() & 63, gw = blockIdx.x * 8 + (otid() >> 6), nw = gridDim.x * 8;
    for (int r = gw; r < NT; r += nw) {
        const int cond = r < NTP ? 0 : (r < NTP + 4096 ? 1 : 2);
        const bf16_t* xr = X + (size_t)r * DM; const float* mp = mod + cond * 24576;
        f32x4 v[4]; float ss = 0.f;
#pragma unroll
        for (int i = 0; i < 4; ++i) { const u32x2 w = *(const u32x2*)(xr + i * 256 + lane * 4); v[i] = (f32x4){bflo(w.x), bfhi(w.x), bflo(w.y), bfhi(w.y)}; ss += v[i][0] * v[i][0] + v[i][1] * v[i][1] + v[i][2] * v[i][2] + v[i][3] * v[i][3]; }
        ss = wave_sum(ss); const float rs = rsqrtf(ss * (1.0f / DM) + 1e-6f);
#pragma unroll
        for (int i = 0; i < 4; ++i) { const int c = i * 256 + lane * 4; const f32x4 gg = *(const f32x4*)(g + c), sc = *(const f32x4*)(mp + scoff + c), sh = *(const f32x4*)(mp + shoff + c);
            float o[4];
#pragma unroll
            for (int j = 0; j < 4; ++j) o[j] = v[i][j] * rs * gg[j] * (1.0f + sc[j]) + sh[j];
            *(u32x2*)(H + (size_t)r * DM + c) = (u32x2){cvt_pk_bf16(o[0], o[1]), cvt_pk_bf16(o[2], o[3])}; }
    }
}
__device__ void final_norm(float* __restrict__ X, const float* __restrict__ g) {
    const int lane = otid() & 63, gw = blockIdx.x * 8 + (otid() >> 6), nw = gridDim.x * 8;
    for (int r = gw; r < NT; r += nw) {
        float* xr = X + (size_t)r * DM; f32x4 v[4]; float ss = 0.f;
#pragma unroll
        for (int i = 0; i < 4; ++i) { v[i] = *(const f32x4*)(xr + i * 256 + lane * 4); ss += v[i][0] * v[i][0] + v[i][1] * v[i][1] + v[i][2] * v[i][2] + v[i][3] * v[i][3]; }
        ss = wave_sum(ss); const float rs = rsqrtf(ss * (1.0f / DM) + 1e-6f);
#pragma unroll
        for (int i = 0; i < 4; ++i) { const int c = i * 256 + lane * 4; const f32x4 gg = *(const f32x4*)(g + c); f32x4 o;
#pragma unroll
            for (int j = 0; j < 4; ++j) o[j] = v[i][j] * rs * gg[j];
            *(f32x4*)(xr + c) = o; }
    }
}
__device__ void prep_misc(const Params& p, LAS unsigned char* lds) {
    const int tid = otid(); const size_t gt = (size_t)blockIdx.x * 512 + tid, ng = (size_t)gridDim.x * 512;
    { const f32x4* a = (const f32x4*)p.in[I_XP]; const f32x4* b = (const f32x4*)p.in[I_XS]; u32x2* o = (u32x2*)((unsigned char*)p.out + XR_OFF); const size_t n4 = (size_t)NTP * DM / 4;
      for (size_t i = gt; i < n4; i += ng) { const f32x4 va = a[i], vb = b[i]; o[i] = (u32x2){cvt_pk_bf16(va[0], va[1]), cvt_pk_bf16(va[2], va[3])}; o[n4 + i] = (u32x2){cvt_pk_bf16(vb[0], vb[1]), cvt_pk_bf16(vb[2], vb[3])}; } }
    { bf16_t* id = (bf16_t*)(p.ws + WS_IDENT); for (size_t i = gt; i < 65536; i += ng) id[i] = ((i >> 8) == (i & 255)) ? (bf16_t)0x3F80 : (bf16_t)0; }
    { bf16_t* idw = (bf16_t*)(p.ws + WS_IDENTW); for (size_t i = gt; i < 65536; i += ng) idw[(i >> 8) * 6144 + (i & 255)] = ((i >> 8) == (i & 255)) ? (bf16_t)0x3F80 : (bf16_t)0; }
    LAS float* sc = (LAS float*)lds;
    LAS float* red = sc + 3072;
    for (int i = tid; i < 3072; i += 512) { const int c = i >> 10, k = i & 1023; const float v = c == 0 ? p.in[I_CCTX][k] : p.in[I_C][(c - 1) * 1024 + k]; sc[i] = siluf(v); }
    __syncthreads();
    float* mod = (float*)(p.ws + WS_MOD);
    for (int it = blockIdx.x; it < 4 * 96; it += gridDim.x) {
        const int l = it / 96, n0 = (it % 96) * 64, col = tid & 63, kq = tid >> 6;
        const float* w = p.in[I_WMOD] + (size_t)l * 1024 * 6144 + n0 + col;
        float a0 = 0.f, a1 = 0.f, a2 = 0.f;
#pragma unroll 8
        for (int k = kq * 128; k < kq * 128 + 128; ++k) { const float wv = w[(size_t)k * 6144]; a0 += sc[k] * wv; a1 += sc[1024 + k] * wv; a2 += sc[2048 + k] * wv; }
        red[(kq * 3 + 0) * 64 + col] = a0; red[(kq * 3 + 1) * 64 + col] = a1; red[(kq * 3 + 2) * 64 + col] = a2;
        __syncthreads();
        if (tid < 192) { const int c = tid >> 6; float s = p.in[I_BMOD][l * 6144 + n0 + col];
#pragma unroll
            for (int q = 0; q < 8; ++q) s += red[(q * 3 + c) * 64 + col];
            mod[c * 24576 + l * 6144 + n0 + col] = s; }
        __syncthreads();
    }
}

struct RopeCS { float cs[8], sn[8]; };
__device__ __forceinline__ void rope_cs8(int lane, int tp, RopeCS& r) {
    const int k = lane & 7; const float pos = (float)((k < 4) ? (tp >> 6) : (tp & 63));
#pragma unroll
    for (int j = 0; j < 8; ++j) { const float ang = pos * fast_exp2(-(float)(8 * (k & 1) + j) * (13.287712379549449f / 16.0f)); r.cs[j] = cos_rr(ang); r.sn[j] = sin_rr(ang); }
}
__device__ __forceinline__ void rope8(float* x, int lane, const RopeCS& r) {
    const bool second = (lane & 2) != 0;
#pragma unroll
    for (int j = 0; j < 8; ++j) { const float pr = shfl_xor_f(x[j], 2); x[j] = second ? (pr * r.sn[j] + x[j] * r.cs[j]) : (x[j] * r.cs[j] - pr * r.sn[j]); }
}
__device__ __forceinline__ void unpack8(const u32x4 w, float* x) {
#pragma unroll
    for (int j = 0; j < 4; ++j) { x[2 * j] = bflo(w[j]); x[2 * j + 1] = bfhi(w[j]); }
}
__device__ __forceinline__ u32x4 pack8(const float* x) { return (u32x4){cvt_pk_bf16(x[0], x[1]), cvt_pk_bf16(x[2], x[3]), cvt_pk_bf16(x[4], x[5]), cvt_pk_bf16(x[6], x[7])}; }
__device__ __forceinline__ void rms8(float* x, const float* gn) {
    float ss = 0.f;
#pragma unroll
    for (int j = 0; j < 8; ++j) ss += x[j] * x[j];
    ss += shfl_xor_f(ss, 1); ss += shfl_xor_f(ss, 2); ss += shfl_xor_f(ss, 4);
    const float rs = rsqrtf(ss * (1.0f / 64.0f) + 1e-6f);
#pragma unroll
    for (int j = 0; j < 8; ++j) x[j] = x[j] * rs * gn[j];
}
__device__ void post_attn(const Params& p, bf16_t* U, bf16_t* KS, bf16_t* VtS) {
    const int lane = otid() & 63, gw = blockIdx.x * 8 + (otid() >> 6), nw = gridDim.x * 8;
    float qg[8], kg[8];
#pragma unroll
    for (int j = 0; j < 8; ++j) { qg[j] = p.in[I_AQG][(lane & 7) * 8 + j]; kg[j] = p.in[I_AKG][(lane & 7) * 8 + j]; }
    float* nak = p.out + OUT_NAK; float* nav = p.out + OUT_NAV;
    for (int t = gw; t < NT + 512; t += nw) {
        if (t < NT) {
            const bool smp = t >= NTP; const int ts = t - NTP; const int b = smp ? (ts >> 12) : (t >> 8), tp = smp ? (ts & 4095) : (t & 255);
            bf16_t* ur = U + (size_t)t * 1536 + lane * 8;
            const u32x4 w0 = *(const u32x4*)ur, w1 = *(const u32x4*)(ur + 512), w2 = *(const u32x4*)(ur + 1024);
            RopeCS rc; if (smp) rope_cs8(lane, tp, rc);
            float x[8];
            unpack8(w0, x); rms8(x, qg); if (smp) rope8(x, lane, rc); *(u32x4*)ur = pack8(x);
            unpack8(w1, x); rms8(x, qg); if (smp) rope8(x, lane, rc); *(u32x4*)(ur + 512) = pack8(x);
            unpack8(w2, x);
            float y[8];
#pragma unroll
            for (int j = 0; j < 8; ++j) y[j] = x[j];
            rms8(y, kg); if (smp) rope8(y, lane, rc);
            if (lane < 32) {
                if (!smp) { *(u32x4*)(ur + 1024) = pack8(y); float* o = nak + (size_t)t * 256 + lane * 8; *(f32x4*)o = (f32x4){y[0], y[1], y[2], y[3]}; *(f32x4*)(o + 4) = (f32x4){y[4], y[5], y[6], y[7]}; }
                else *(u32x4*)(KS + ((size_t)b * 4352 + 256 + tp) * 256 + lane * 8) = pack8(y);
            } else if (!smp) { float* o = nav + (size_t)t * 256 + (lane - 32) * 8; *(f32x4*)o = (f32x4){x[0], x[1], x[2], x[3]}; *(f32x4*)(o + 4) = (f32x4){x[4], x[5], x[6], x[7]}; }
        } else {
            const int ci = t - NT, b = ci >> 8, m = ci & 255;
            for (int kh = 0; kh < 4; ++kh) {
                const bf16_t kb16 = f2bf(p.in[I_CAK][((size_t)(b * 256 + m) * 4 + kh) * 64 + lane]);
                KS[((size_t)b * 4352 + m) * 256 + kh * 64 + lane] = kb16;
                const float kn = wave_sum(bf2f(kb16) * bf2f(kb16));
                if (lane == 0) atomicMax((unsigned*)(p.ws + WS_CKMAX), __float_as_uint(kn));
                VtS[((size_t)(b * 4 + kh) * 64 + lane) * 4352 + m] = f2bf(p.in[I_CAV][((size_t)(b * 256 + m) * 4 + kh) * 64 + lane]);
            }
        }
    }
}
__device__ __forceinline__ float subhead_maxsq(const float* x) {
    float ss = 0.f;
#pragma unroll
    for (int j = 0; j < 8; ++j) ss += x[j] * x[j];
    ss += shfl_xor_f(ss, 1); ss += shfl_xor_f(ss, 2); ss += shfl_xor_f(ss, 4);
    ss = fmaxf(ss, shfl_xor_f(ss, 8)); ss = fmaxf(ss, shfl_xor_f(ss, 16)); ss = fmaxf(ss, shfl_xor_f(ss, 32));
    return ss;
}
__device__ void post_diff(const Params& p, bf16_t* U, bf16_t* KS, bf16_t* VtS, LAS unsigned char* lds) {
    const int lane = otid() & 63, gw = blockIdx.x * 8 + (otid() >> 6), nw = gridDim.x * 8;
    float* ndk = p.out + OUT_NDK; float* ndv = p.out + OUT_NDV;
    float qrun = 0.f, krun = 0.f;
    for (int t = gw; t < NT + 512; t += nw) {
        if (t < NT) {
            const bool smp = t >= NTP; const int ts = t - NTP; const int b = smp ? (ts >> 12) : (t >> 8), tp = smp ? (ts & 4095) : (t & 255);
            bf16_t* ur = U + (size_t)t * 3072 + lane * 8;
            float qm = 0.f, km = 0.f;
            if (!smp) {
                u32x4 w[4], wq[2];
#pragma unroll
                for (int c = 0; c < 4; ++c) w[c] = *(const u32x4*)(ur + 1024 + c * 512);
                wq[0] = *(const u32x4*)ur; wq[1] = *(const u32x4*)(ur + 512);
#pragma unroll
                for (int c = 0; c < 4; ++c) { float x[8]; unpack8(w[c], x); float* o = (c < 2 ? ndk : ndv) + (size_t)t * 1024 + (c & 1) * 512 + lane * 8;
                    if (c < 2) km = fmaxf(km, subhead_maxsq(x));
                    *(f32x4*)o = (f32x4){x[0], x[1], x[2], x[3]}; *(f32x4*)(o + 4) = (f32x4){x[4], x[5], x[6], x[7]}; }
#pragma unroll
                for (int c = 0; c < 2; ++c) { float x[8]; unpack8(wq[c], x); qm = fmaxf(qm, subhead_maxsq(x)); }
            } else {
                u32x4 w[4];
#pragma unroll
                for (int c = 0; c < 4; ++c) w[c] = *(const u32x4*)(ur + c * 512);
                RopeCS rc; rope_cs8(lane, tp, rc);
#pragma unroll
                for (int c = 0; c < 4; ++c) { float x[8]; unpack8(w[c], x); const float m2 = subhead_maxsq(x); if (c < 2) qm = fmaxf(qm, m2); else km = fmaxf(km, m2); rope8(x, lane, rc);
                    if (c < 2) *(u32x4*)(ur + c * 512) = pack8(x); else *(u32x4*)(KS + ((size_t)b * 4352 + 256 + tp) * 1024 + (c - 2) * 512 + lane * 8) = pack8(x); }
            }
            qrun = fmaxf(qrun, qm); krun = fmaxf(krun, km);
        } else {
            const int ci = t - NT, b = ci >> 8, m = ci & 255;
            for (int j = 0; j < 16; ++j) { const int c = j * 64 + lane;
                const bf16_t kb16 = f2bf(p.in[I_CDK][(size_t)(b * 256 + m) * 1024 + c]); const float kn = wave_sum(bf2f(kb16) * bf2f(kb16));
                krun = fmaxf(krun, kn);
                KS[((size_t)b * 4352 + m) * 1024 + c] = kb16;
                VtS[((size_t)b * 1024 + c) * 4352 + m] = f2bf(p.in[I_CDV][(size_t)(b * 256 + m) * 1024 + c]); }
        }
    }
    { LAS float* red = (LAS float*)lds; const int wid = otid() >> 6;
      if (lane == 0) { red[wid] = qrun; red[8 + wid] = krun; }
      __syncthreads();
      if (otid() == 0) { float a = 0.f, b2 = 0.f;
          for (int i = 0; i < 8; ++i) { a = fmaxf(a, red[i]); b2 = fmaxf(b2, red[8 + i]); }
          atomicMax((unsigned*)(p.ws + WS_DQMAX), __float_as_uint(a)); atomicMax((unsigned*)(p.ws + WS_DQMAX) + 1, __float_as_uint(b2)); }
      __syncthreads(); }
}

struct FlashArgs {
    const bf16_t* q; int ldq;
    const bf16_t* k; int ldk;
    const bf16_t* vt; int ldvt;
    const bf16_t* ident;
    int nreal, ntiles, kcol;
    bf16_t* out; int ldo;
    float* outf;
    float qscale; float fixm;
    float lgf, lgb; int n0, L, dir, half;
    float lam, onem; const float* subg;
};

template <int DK, int DV, int MODE, bool FXC = false>
__device__ __forceinline__ void flash_item(LAS unsigned char* lds, const FlashArgs& a) {
    constexpr int KW = (MODE == 1) ? 2 * DK : DK, KLD = KW + 8, VLD = 72, KB = 64 * KLD * 2, VB = DV * VLD * 2, STG = KB + VB;
    constexpr int NKC = KW / 64, NVC = DV / 64, NS = DK / 16, ND = DV / 32;
    static_assert(2 * STG <= LDS_BYTES, "lds");
    const int tid = otid(), lane = tid & 63, lr = lane & 31, g = lane >> 5;
    bf16x8 qf[NS];
#pragma unroll
    for (int s = 0; s < NS; ++s) {
        u32x4 w = *(const u32x4*)(a.q + (size_t)lr * a.ldq + s * 16 + g * 8);
        if (MODE <= 1) {
#pragma unroll
            for (int j = 0; j < 4; ++j) w[j] = cvt_pk_bf16(bflo(w[j]) * a.qscale, bfhi(w[j]) * a.qscale);
        }
        qf[s] = __builtin_bit_cast(bf16x8, w);
    }
    f32x16 O[ND];
#pragma unroll
    for (int d = 0; d < ND; ++d)
#pragma unroll
        for (int r = 0; r < 16; ++r) O[d][r] = 0.f;
    float m_run = -1e30f, l_run = 0.f;
    if constexpr (MODE >= 2) {
        static_assert(DK == 256 && DV == 128, "ret path shapes");
        constexpr int KB2 = 64 * 512, VB2 = 256 * 128, STG2 = KB2 + VB2;
        static_assert(2 * STG2 + 16384 <= LDS_BYTES - 16, "ret lds");
        const int wid_u = __builtin_amdgcn_readfirstlane(tid >> 6);
        const int nt = a.ntiles;
        unsigned koff[4], voff[4];
#pragma unroll
        for (int i = 0; i < 4; ++i) { const int blk = wid_u * 4 + i;
            { const int row = 2 * blk + (lane >> 5), pos = lane & 31, c = pos ^ (row & 31); koff[i] = (unsigned)(row * a.ldk + c * 8) * 2u; }
            { const int row = 8 * blk + (lane >> 3), pos = lane & 7, c = pos ^ ((row >> 1) & 7); voff[i] = (unsigned)(row * a.ldvt + c * 8) * 2u; } }
        auto dma = [&](int t, int buf) {
            const char* kbase = (t * 64 >= a.nreal) ? (const char*)a.ident + (size_t)((t * 64 - a.nreal) & 255) * a.ldk * 2 : (const char*)a.k + (size_t)t * 64 * a.ldk * 2;
            const char* vbase = (const char*)a.vt + (size_t)t * 128;
            LAS unsigned char* base = lds + buf * STG2;
#pragma unroll
            for (int i = 0; i < 4; ++i) __builtin_amdgcn_global_load_lds((const unsigned*)(kbase + koff[i]), (LAS unsigned*)(base + (wid_u * 4 + i) * 1024), 16, 0, 0);
#pragma unroll
            for (int i = 0; i < 4; ++i) __builtin_amdgcn_global_load_lds((const unsigned*)(vbase + voff[i]), (LAS unsigned*)(base + KB2 + (wid_u * 4 + i) * 1024), 16, 0, 0);
        };
        auto unif = [](float v) { return __int_as_float(__builtin_amdgcn_readfirstlane(__float_as_int(v))); };
        const float f1 = unif(fast_exp2(-a.lgf)), f2 = unif(f1 * f1), f3 = unif(f2 * f1), f8 = unif(fast_exp2(-8.0f * a.lgf));
        const float b1 = unif(fast_exp2(a.lgb)), b2 = unif(b1 * b1), b3 = unif(b2 * b1), b8 = unif(fast_exp2(8.0f * a.lgb));
        LAS unsigned char* pbuf = lds + 2 * STG2;
        auto compute2 = [&](int t) {
            const LAS unsigned char* kb = lds + (t & 1) * STG2; const LAS unsigned char* vb = kb + KB2;
            const int n = a.n0 + lr, m0 = t * 64, half = a.half;
            const unsigned ka0 = (unsigned)(size_t)(kb + (half * 32 + lr) * 512) + (unsigned)((g ^ lr) << 4);
            auto kfrag = [&](int s_) { return *(const LAS bf16x8*)(size_t)(ka0 ^ (unsigned)(s_ << 5)); };
            f32x16 S;
#pragma unroll
            for (int r = 0; r < 16; ++r) S[r] = 0.f;
            bf16x8 ka[2], kc[2];
            ka[0] = kfrag(0); ka[1] = kfrag(1);
#pragma unroll
            for (int grp = 0; grp < 8; ++grp) {
                if (grp < 7) { if (grp & 1) { ka[0] = kfrag(2 * grp + 2); ka[1] = kfrag(2 * grp + 3); } else { kc[0] = kfrag(2 * grp + 2); kc[1] = kfrag(2 * grp + 3); } }
                __builtin_amdgcn_sched_barrier(0);
                if (grp & 1) { S = __builtin_amdgcn_mfma_f32_32x32x16_bf16(kc[0], qf[2 * grp], S, 0, 0, 0); S = __builtin_amdgcn_mfma_f32_32x32x16_bf16(kc[1], qf[2 * grp + 1], S, 0, 0, 0); }
                else { S = __builtin_amdgcn_mfma_f32_32x32x16_bf16(ka[0], qf[2 * grp], S, 0, 0, 0); S = __builtin_amdgcn_mfma_f32_32x32x16_bf16(ka[1], qf[2 * grp + 1], S, 0, 0, 0); }
                __builtin_amdgcn_sched_barrier(0);
            }
            const int mb = m0 + half * 32;
            if (MODE == 2) {
                if (m0 < a.nreal) {
                    if (mb + 31 < a.n0) {
                        float c4 = 0.0625f * fast_exp2((float)(n - mb - 4 * g) * a.lgf);
#pragma unroll
                        for (int q4 = 0; q4 < 4; ++q4) { S[4 * q4] *= c4; S[4 * q4 + 1] *= c4 * f1; S[4 * q4 + 2] *= c4 * f2; S[4 * q4 + 3] *= c4 * f3; c4 *= f8; }
                    } else if (mb > a.n0 + 31) {
                        float c4 = 0.0625f * fast_exp2((float)(mb + 4 * g - n) * a.lgb);
#pragma unroll
                        for (int q4 = 0; q4 < 4; ++q4) { S[4 * q4] *= c4; S[4 * q4 + 1] *= c4 * b1; S[4 * q4 + 2] *= c4 * b2; S[4 * q4 + 3] *= c4 * b3; c4 *= b8; }
                    } else {
#pragma unroll
                        for (int r = 0; r < 16; ++r) { const int m = mb + 8 * (r >> 2) + 4 * g + (r & 3); const int df = n - m;
                            const float e = df > 0 ? (float)df * a.lgf : (float)(-df) * a.lgb; float f = fast_exp2(e) * 0.0625f; if (df == 0) f = 0.125f; S[r] *= f; }
                    }
                } else {
                    const float f = ((m0 - a.nreal) < 256) ? fast_exp2((float)(n + 1) * a.lgf) : fast_exp2((float)(a.L - n) * a.lgb);
#pragma unroll
                    for (int r = 0; r < 16; ++r) S[r] *= f;
                }
            } else {
#pragma unroll
                for (int r = 0; r < 16; ++r) { const int m = mb + 8 * (r >> 2) + 4 * g + (r & 3);
                    const float e = a.dir == 0 ? (float)(a.L - 1 - m) * a.lgf : (float)m * a.lgb; S[r] *= fast_exp2(e) * 0.0625f; }
            }
            u32x4 pw0, pw1;
            pw0.x = cvt_pk_bf16(S[0], S[1]); pw0.y = cvt_pk_bf16(S[2], S[3]); pw0.z = cvt_pk_bf16(S[4], S[5]); pw0.w = cvt_pk_bf16(S[6], S[7]);
            pw1.x = cvt_pk_bf16(S[8], S[9]); pw1.y = cvt_pk_bf16(S[10], S[11]); pw1.z = cvt_pk_bf16(S[12], S[13]); pw1.w = cvt_pk_bf16(S[14], S[15]);
            { LAS unsigned char* pb = pbuf + wid_u * 2048 + lane * 16; *(LAS u32x4*)pb = pw0; *(LAS u32x4*)(pb + 1024) = pw1; }
            u32x4 vf[ND];
            auto vload = [&](int kk) {
#pragma unroll
                for (int d = 0; d < ND; ++d) { const unsigned va0 = ((unsigned)(size_t)(vb + (half * 128 + lr) * 128) + (unsigned)((g ^ ((lr >> 1) & 7)) << 4)) ^ (unsigned)(kk << 5);
                    vf[d] = *(const LAS u32x4*)(size_t)(va0 + d * 4096); }
            };
            auto pv = [&](const u32x4 pw) { const bf16x8 pf = __builtin_bit_cast(bf16x8, pw);
#pragma unroll
                for (int d = 0; d < ND; ++d) O[d] = __builtin_amdgcn_mfma_f32_32x32x16_bf16(__builtin_bit_cast(bf16x8, vf[d]), pf, O[d], 0, 0, 0); };
            vload(2 * half); pv(pw0);
            vload(2 * half + 1); pv(pw1);
            asm volatile("s_waitcnt lgkmcnt(0)" ::: "memory"); __builtin_amdgcn_s_barrier(); asm volatile("" ::: "memory");
            const LAS unsigned char* pp = pbuf + (wid_u ^ 4) * 2048 + lane * 16;
            { const u32x4 q0 = *(const LAS u32x4*)pp; vload(2 * (1 - half)); pv(q0); }
            { const u32x4 q1 = *(const LAS u32x4*)(pp + 1024); vload(2 * (1 - half) + 1); pv(q1); }
        };
        dma(0, 0);
        asm volatile("s_waitcnt vmcnt(0)" ::: "memory"); __syncthreads();
        for (int t = 0; t < nt; ++t) {
            if (t + 1 < nt) dma(t + 1, (t + 1) & 1);
            compute2(t);
            asm volatile("s_waitcnt vmcnt(0)" ::: "memory"); __syncthreads();
        }
    } else {
    constexpr bool PF2 = (MODE == 0);
    u32x4 kreg[NKC], vreg[NVC], kreg2[PF2 ? NKC : 1], vreg2[PF2 ? NVC : 1];
    auto gload = [&](int t, u32x4* kr, u32x4* vr) {
        const bf16_t* kp; int ldk;
        if (MODE >= 2 && t * 64 >= a.nreal) { kp = a.ident + (size_t)((t * 64 - a.nreal) & 255) * 256; ldk = 256; } else { kp = a.k + (size_t)t * 64 * a.ldk; ldk = a.ldk; }
#pragma unroll
        for (int i = 0; i < NKC; ++i) { const int c = tid + i * 512, row = c / (KW / 8), cc = c % (KW / 8); kr[i] = *(const u32x4*)(kp + (size_t)row * ldk + cc * 8); }
#pragma unroll
        for (int i = 0; i < NVC; ++i) { const int c = tid + i * 512, d = c >> 3, cc = c & 7; vr[i] = *(const u32x4*)(a.vt + (size_t)d * a.ldvt + t * 64 + cc * 8); }
    };
    auto sstore = [&](int buf, const u32x4* kr, const u32x4* vr) {
        LAS unsigned char* base = lds + buf * STG;
#pragma unroll
        for (int i = 0; i < NKC; ++i) { const int c = tid + i * 512, row = c / (KW / 8), cc = c % (KW / 8); *(LAS u32x4*)(base + (row * KLD + cc * 8) * 2) = kr[i]; }
#pragma unroll
        for (int i = 0; i < NVC; ++i) { const int c = tid + i * 512, d = c >> 3, cc = c & 7; *(LAS u32x4*)(base + KB + (d * VLD + cc * 8) * 2) = vr[i]; }
    };
    gload(0, kreg, vreg); sstore(0, kreg, vreg); __syncthreads();
    const int nt = a.ntiles;
    auto compute = [&](int t) {
        LAS unsigned char* kb = lds + (t & 1) * STG; LAS unsigned char* vb = kb + KB;
        f32x16 S[2];
        if constexpr (MODE <= 1) {
            bf16x8 kf[2][NS];
#pragma unroll
            for (int ks = 0; ks < 2; ++ks)
#pragma unroll
                for (int s = 0; s < NS; ++s) kf[ks][s] = *(const LAS bf16x8*)(kb + ((ks * 32 + lr) * KLD + a.kcol + s * 16 + g * 8) * 2);
            u32x4 vf[2][ND];
            auto vload = [&](int kk, u32x4* dst) {
#pragma unroll
                for (int d = 0; d < ND; ++d) { const LAS unsigned char* vp = vb + ((d * 32 + lr) * VLD + kk * 16 + 4 * g) * 2;
                    const u32x2 v0 = *(const LAS u32x2*)vp, v1 = *(const LAS u32x2*)(vp + 16); dst[d] = (u32x4){v0.x, v0.y, v1.x, v1.y}; }
            };
            vload(0, vf[0]);
            __builtin_amdgcn_sched_barrier(0);
            const bool fx = (MODE == 0) ? (a.fixm >= 0.f) : FXC;
#pragma unroll
            for (int r = 0; r < 16; ++r) { S[0][r] = fx ? -a.fixm : 0.f; S[1][r] = fx ? -a.fixm : 0.f; }
#pragma unroll
            for (int s = 0; s < NS; ++s) { S[0] = __builtin_amdgcn_mfma_f32_32x32x16_bf16(kf[0][s], qf[s], S[0], 0, 0, 0); S[1] = __builtin_amdgcn_mfma_f32_32x32x16_bf16(kf[1][s], qf[s], S[1], 0, 0, 0); }
            if (fx) {
                float ls = 0.f;
#pragma unroll
                for (int ks = 0; ks < 2; ++ks)
#pragma unroll
                    for (int r = 0; r < 16; ++r) { const float pv = fast_exp2(S[ks][r]); S[ks][r] = pv; ls += pv; }
                l_run += ls;
            } else {
                float mx = S[0][0];
#pragma unroll
                for (int ks = 0; ks < 2; ++ks)
#pragma unroll
                    for (int r = 0; r < 16; ++r) mx = fmaxf(mx, S[ks][r]);
                mx = fmaxf(mx, shfl_xor_f(mx, 32));
                const float mn = fmaxf(m_run, mx), alpha = fast_exp2(m_run - mn); m_run = mn;
                float ls = 0.f;
#pragma unroll
                for (int ks = 0; ks < 2; ++ks)
#pragma unroll
                    for (int r = 0; r < 16; ++r) { const float pv = fast_exp2(S[ks][r] - mn); S[ks][r] = pv; ls += pv; }
                l_run = l_run * alpha + ls;
#pragma unroll
                for (int d = 0; d < ND; ++d)
#pragma unroll
                    for (int r = 0; r < 16; ++r) O[d][r] *= alpha;
            }
#pragma unroll
            for (int kk = 0; kk < 4; ++kk) {
                if (kk < 3) vload(kk + 1, vf[(kk + 1) & 1]);
                __builtin_amdgcn_sched_barrier(0);
                const int ks = kk >> 1, rb = (kk & 1) * 8;
                u32x4 pw; pw.x = cvt_pk_bf16(S[ks][rb + 0], S[ks][rb + 1]); pw.y = cvt_pk_bf16(S[ks][rb + 2], S[ks][rb + 3]); pw.z = cvt_pk_bf16(S[ks][rb + 4], S[ks][rb + 5]); pw.w = cvt_pk_bf16(S[ks][rb + 6], S[ks][rb + 7]);
                const bf16x8 pf = __builtin_bit_cast(bf16x8, pw);
#pragma unroll
                for (int d = 0; d < ND; ++d) O[d] = __builtin_amdgcn_mfma_f32_32x32x16_bf16(__builtin_bit_cast(bf16x8, vf[kk & 1][d]), pf, O[d], 0, 0, 0);
            }
            return;
        }
#pragma unroll
        for (int ks = 0; ks < 2; ++ks) {
            if (MODE >= 2 && ks == 1) __builtin_amdgcn_sched_barrier(0);
#pragma unroll
            for (int r = 0; r < 16; ++r) S[ks][r] = 0.f;
#pragma unroll
            for (int s = 0; s < NS; ++s) {
                const bf16x8 af = *(const LAS bf16x8*)(kb + ((ks * 32 + lr) * KLD + a.kcol + s * 16 + g * 8) * 2);
                S[ks] = __builtin_amdgcn_mfma_f32_32x32x16_bf16(af, qf[s], S[ks], 0, 0, 0);
            }
            if (MODE == 2) {
                const int n = a.n0 + lr;
                if (t * 64 < a.nreal) {
#pragma unroll
                    for (int r = 0; r < 16; ++r) { const int m = t * 64 + ks * 32 + 8 * (r >> 2) + 4 * g + (r & 3); const int df = n - m;
                        const float e = df > 0 ? (float)df * a.lgf : (float)(-df) * a.lgb; float f = fast_exp2(e) * 0.0625f; if (df == 0) f = 0.125f; S[ks][r] *= f; }
                } else {
                    const float f = ((t * 64 - a.nreal) < 256) ? fast_exp2((float)(n + 1) * a.lgf) : fast_exp2((float)(a.L - n) * a.lgb);
#pragma unroll
                    for (int r = 0; r < 16; ++r) S[ks][r] *= f;
                }
            } else if (MODE == 3) {
#pragma unroll
                for (int r = 0; r < 16; ++r) { const int m = t * 64 + ks * 32 + 8 * (r >> 2) + 4 * g + (r & 3);
                    const float e = a.dir == 0 ? (float)(a.L - 1 - m) * a.lgf : (float)m * a.lgb; S[ks][r] *= fast_exp2(e) * 0.0625f; }
            }
            if (MODE >= 2) {
#pragma unroll
                for (int k2 = 0; k2 < 2; ++k2) {
                    const int kk = ks * 2 + k2, rb = k2 * 8;
                    u32x4 pw; pw.x = cvt_pk_bf16(S[ks][rb + 0], S[ks][rb + 1]); pw.y = cvt_pk_bf16(S[ks][rb + 2], S[ks][rb + 3]); pw.z = cvt_pk_bf16(S[ks][rb + 4], S[ks][rb + 5]); pw.w = cvt_pk_bf16(S[ks][rb + 6], S[ks][rb + 7]);
                    const bf16x8 pf = __builtin_bit_cast(bf16x8, pw);
#pragma unroll
                    for (int d = 0; d < ND; ++d) {
                        const LAS unsigned char* vp = vb + ((d * 32 + lr) * VLD + kk * 16 + 4 * g) * 2;
                        const u32x2 v0 = *(const LAS u32x2*)vp, v1 = *(const LAS u32x2*)(vp + 16);
                        const bf16x8 vf = __builtin_bit_cast(bf16x8, (u32x4){v0.x, v0.y, v1.x, v1.y});
                        O[d] = __builtin_amdgcn_mfma_f32_32x32x16_bf16(vf, pf, O[d], 0, 0, 0);
                    }
                }
            }
        }
        if (MODE <= 1) {
            float mx = S[0][0];
#pragma unroll
            for (int ks = 0; ks < 2; ++ks)
#pragma unroll
                for (int r = 0; r < 16; ++r) mx = fmaxf(mx, S[ks][r]);
            mx = fmaxf(mx, shfl_xor_f(mx, 32));
            const float mn = fmaxf(m_run, mx), alpha = fast_exp2(m_run - mn); m_run = mn;
            float ls = 0.f;
#pragma unroll
            for (int ks = 0; ks < 2; ++ks)
#pragma unroll
                for (int r = 0; r < 16; ++r) { const float pv = fast_exp2(S[ks][r] - mn); S[ks][r] = pv; ls += pv; }
            l_run = l_run * alpha + ls;
#pragma unroll
            for (int d = 0; d < ND; ++d)
#pragma unroll
                for (int r = 0; r < 16; ++r) O[d][r] *= alpha;
#pragma unroll
            for (int kk = 0; kk < 4; ++kk) {
                const int ks = kk >> 1, rb = (kk & 1) * 8;
                u32x4 pw; pw.x = cvt_pk_bf16(S[ks][rb + 0], S[ks][rb + 1]); pw.y = cvt_pk_bf16(S[ks][rb + 2], S[ks][rb + 3]); pw.z = cvt_pk_bf16(S[ks][rb + 4], S[ks][rb + 5]); pw.w = cvt_pk_bf16(S[ks][rb + 6], S[ks][rb + 7]);
                const bf16x8 pf = __builtin_bit_cast(bf16x8, pw);
#pragma unroll
                for (int d = 0; d < ND; ++d) {
                    const LAS unsigned char* vp = vb + ((d * 32 + lr) * VLD + kk * 16 + 4 * g) * 2;
                    const u32x2 v0 = *(const LAS u32x2*)vp, v1 = *(const LAS u32x2*)(vp + 16);
                    const bf16x8 vf = __builtin_bit_cast(bf16x8, (u32x4){v0.x, v0.y, v1.x, v1.y});
                    O[d] = __builtin_amdgcn_mfma_f32_32x32x16_bf16(vf, pf, O[d], 0, 0, 0);
                }
            }
        }
    };
    if (PF2) {
        if (nt > 1) gload(1, kreg, vreg);
        for (int t = 0; t < nt; t += 2) {
            if (t + 2 < nt) gload(t + 2, kreg2, vreg2);
            compute(t);
            if (t + 1 < nt) sstore(1, kreg, vreg);
            __syncthreads();
            if (t + 1 >= nt) break;
            if (t + 3 < nt) gload(t + 3, kreg, vreg);
            compute(t + 1);
            if (t + 2 < nt) sstore(0, kreg2, vreg2);
            __syncthreads();
        }
    } else {
        for (int t = 0; t < nt; ++t) {
            if (t + 1 < nt) gload(t + 1, kreg, vreg);
            compute(t);
            if (t + 1 < nt) sstore((t + 1) & 1, kreg, vreg);
            __syncthreads();
        }
    }
    }
    if (MODE == 0) {
        const float inv = 1.0f / (l_run + shfl_xor_f(l_run, 32));
        bf16_t* op = a.out + (size_t)lr * a.ldo;
#pragma unroll
        for (int d = 0; d < ND; ++d)
#pragma unroll
            for (int q4 = 0; q4 < 4; ++q4)
                *(u32x2*)(op + d * 32 + 8 * q4 + 4 * g) = (u32x2){cvt_pk_bf16(O[d][4 * q4] * inv, O[d][4 * q4 + 1] * inv), cvt_pk_bf16(O[d][4 * q4 + 2] * inv, O[d][4 * q4 + 3] * inv)};
    } else if (MODE == 1) {
        const int wid = tid >> 6;
        const float inv = 1.0f / (l_run + shfl_xor_f(l_run, 32));
        LAS float* ex = (LAS float*)lds;
        if (wid >= 4) {
#pragma unroll
            for (int d = 0; d < ND; ++d)
#pragma unroll
                for (int r = 0; r < 16; ++r) ex[(((wid - 4) * ND + d) * 16 + r) * 64 + lane] = O[d][r] * inv;
        }
        __syncthreads();
        if (wid < 4) {
            float ss = 0.f;
#pragma unroll
            for (int d = 0; d < ND; ++d)
#pragma unroll
                for (int r = 0; r < 16; ++r) { const float o = O[d][r] * inv - a.lam * ex[((wid * ND + d) * 16 + r) * 64 + lane]; O[d][r] = o; ss += o * o; }
            ss += shfl_xor_f(ss, 32);
            const float rs = rsqrtf(ss * (1.0f / DV) + 1e-5f) * a.onem;
            bf16_t* op = a.out + (size_t)lr * a.ldo;
#pragma unroll
            for (int d = 0; d < ND; ++d)
#pragma unroll
                for (int q4 = 0; q4 < 4; ++q4) { const int dd = d * 32 + 8 * q4 + 4 * g; const f32x4 sg = *(const f32x4*)(a.subg + dd);
                    *(u32x2*)(op + dd) = (u32x2){cvt_pk_bf16(O[d][4 * q4] * rs * sg[0], O[d][4 * q4 + 1] * rs * sg[1]), cvt_pk_bf16(O[d][4 * q4 + 2] * rs * sg[2], O[d][4 * q4 + 3] * rs * sg[3])}; }
        }
        __syncthreads();
    } else if (MODE == 2) {
        const int wid_e = __builtin_amdgcn_readfirstlane(tid >> 6);
        const LAS int* pp = (const LAS int*)(lds + LDS_RETPARAM) + wid_e * 8;
        const int e_row = pp[0], e_col = pp[1], e_pair = pp[2], e_dvh = pp[3];
        KParamsPtr kpe = (KParamsPtr)__builtin_amdgcn_kernarg_segment_ptr();
        unsigned char* wsb = kpe->ws;
        unsigned long long* pslot = (unsigned long long*)(wsb + WS_PSLOT) + (size_t)e_pair * 256;
        float ss = 0.f;
#pragma unroll
        for (int d = 0; d < ND; ++d)
#pragma unroll
            for (int r = 0; r < 16; ++r) ss += O[d][r] * O[d][r];
        ss += shfl_xor_f(ss, 32);
        LAS float* xl = (LAS float*)lds;
        if (g == 0) xl[wid_e * 32 + lr] = ss;
        __syncthreads();
        if (wid_e < 4 && g == 0) {
            const float mine = xl[wid_e * 32 + lr] + xl[(wid_e + 4) * 32 + lr];
            const int row = wid_e * 32 + lr;
            (void)__hip_atomic_exchange(pslot + (size_t)e_dvh * 128 + row, (0x5EEDull << 32) | (unsigned long long)__float_as_uint(mine), __ATOMIC_RELAXED, __HIP_MEMORY_SCOPE_AGENT);
            unsigned long long* o = pslot + (size_t)(e_dvh ^ 1) * 128 + row; unsigned long long v; unsigned spin = 0;
            for (;;) { v = __hip_atomic_load(o, __ATOMIC_RELAXED, __HIP_MEMORY_SCOPE_AGENT); if ((unsigned)(v >> 32) == 0x5EEDu) break; __builtin_amdgcn_s_sleep(1); if (++spin > (1u << 22)) break; }
            xl[256 + row] = rsqrtf((mine + __uint_as_float((unsigned)v)) * (1.0f / 512.0f) + 1e-6f);
        }
        __syncthreads();
        const float rs = xl[256 + (wid_e & 3) * 32 + lr];
        bf16_t* op = (bf16_t*)(wsb + WS_X + 36 * MiB) + (size_t)(e_row + lr) * 2048 + e_col; const bf16_t* gp = (const bf16_t*)(wsb + WS_U) + (size_t)(e_row + lr) * 6144 + 4096 + e_col; const float* gnp = kpe->in[I_RGN] + e_col;
#pragma unroll
        for (int d = 0; d < ND; ++d)
#pragma unroll
            for (int q4 = 0; q4 < 4; ++q4) { const int dd = d * 32 + 8 * q4 + 4 * g; const u32x2 gw = *(const u32x2*)(gp + dd); const f32x4 g4 = *(const f32x4*)(gnp + dd);
                const float o0 = siluf(bflo(gw.x)) * (O[d][4 * q4] * rs * g4[0]), o1 = siluf(bfhi(gw.x)) * (O[d][4 * q4 + 1] * rs * g4[1]);
                const float o2 = siluf(bflo(gw.y)) * (O[d][4 * q4 + 2] * rs * g4[2]), o3 = siluf(bfhi(gw.y)) * (O[d][4 * q4 + 3] * rs * g4[3]);
                *(u32x2*)(op + dd) = (u32x2){cvt_pk_bf16(o0, o1), cvt_pk_bf16(o2, o3)}; }
        __syncthreads();
    } else {
        float* op = a.outf + (size_t)lr * 512;
#pragma unroll
        for (int d = 0; d < ND; ++d)
#pragma unroll
            for (int q4 = 0; q4 < 4; ++q4) *(f32x4*)(op + d * 32 + 8 * q4 + 4 * g) = (f32x4){O[d][4 * q4], O[d][4 * q4 + 1], O[d][4 * q4 + 2], O[d][4 * q4 + 3]};
    }
}

__device__ __forceinline__ int xcd_item(int it) { return (gridDim.x == 256 && it < 512) ? ((it & 256) | ((it & 7) << 5) | ((it & 255) >> 3)) : it; }
__device__ void attn_phase(const Params& p, LAS unsigned char* lds) {
    bf16_t* U = (bf16_t*)(p.ws + WS_U); bf16_t* H = (bf16_t*)(p.ws + WS_H);
    bf16_t* KS = (bf16_t*)(p.ws + WS_X); bf16_t* VtS = KS + (size_t)2 * 4352 * 256; bf16_t* VtP = VtS + (size_t)2 * 256 * 4352;
    const int wid = otid() >> 6, sub = wid >> 2, w4 = wid & 3;
    float gq = 0.f, gk = 0.f;
    for (int i = 0; i < 64; ++i) { gq = fmaxf(gq, fabsf(p.in[I_AQG][i])); gk = fmaxf(gk, fabsf(p.in[I_AKG][i])); }
    const float ckn = sqrtf(__uint_as_float(*(const unsigned*)(p.ws + WS_CKMAX)));
    const float sbound = 8.0f * gq * fmaxf(8.0f * gk, ckn) * (0.125f * 1.4426950408889634f) * 1.03f + 0.25f;
    const float fixm = sbound <= 60.0f ? sbound : -1.0f;
    for (int it = blockIdx.x; it < 1024; it += gridDim.x) {
        FlashArgs a; a.ident = nullptr; a.kcol = 0; a.qscale = 0.125f * 1.4426950408889634f; a.ldo = DM; a.outf = nullptr; a.ldq = 1536; a.fixm = fixm;
        if (it < 512) { const int ix = xcd_item(it); const int b = ix >> 8, pr = (ix >> 5) & 7, qb = ix & 31; const int head = pr * 2 + sub, kh = pr >> 1;
            const size_t tok = (size_t)NTP + b * 4096 + qb * 128 + w4 * 32;
            a.q = U + tok * 1536 + head * 64; a.k = KS + (size_t)b * 4352 * 256 + kh * 64; a.ldk = 256; a.vt = VtS + (size_t)(b * 4 + kh) * 64 * 4352; a.ldvt = 4352;
            a.nreal = 4352; a.ntiles = 68; a.out = H + tok * DM + head * 64;
        } else { const int i2 = it - 512, b = i2 >> 4, pr = (i2 >> 1) & 7, qb = i2 & 1; const int head = pr * 2 + sub, kh = pr >> 1;
            const size_t tok = (size_t)b * 256 + qb * 128 + w4 * 32;
            a.q = U + tok * 1536 + head * 64; a.k = U + (size_t)b * 256 * 1536 + 1024 + kh * 64; a.ldk = 1536; a.vt = VtP + (size_t)(b * 4 + kh) * 64 * 256; a.ldvt = 256;
            a.nreal = 256; a.ntiles = 4; a.out = H + tok * DM + head * 64;
        }
        flash_item<64, 64, 0>(lds, a);
    }
}
template <bool FXC>
__device__ __forceinline__ void diff_phase_t(const Params& p, LAS unsigned char* lds, const float dfix) {
    bf16_t* U = (bf16_t*)(p.ws + WS_U); bf16_t* H = (bf16_t*)(p.ws + WS_H);
    bf16_t* KS = (bf16_t*)(p.ws + WS_X); bf16_t* VtS = KS + (size_t)2 * 4352 * 1024; bf16_t* VtP = VtS + (size_t)2 * 1024 * 4352;
    const int wid = otid() >> 6, sub = wid >> 2, w4 = wid & 3;
    const float* lam = p.in[I_DLAM]; float s1 = 0.f, s2 = 0.f;
    for (int i = 0; i < 64; ++i) { s1 += lam[i] * lam[64 + i]; s2 += lam[128 + i] * lam[192 + i]; }
    const float lam_init = 0.8f - 0.6f * expf(-0.3f * 1.0f); const float lam_full = expf(s1) - expf(s2) + lam_init;
    for (int it = blockIdx.x; it < 1024; it += gridDim.x) {
        FlashArgs a; a.ident = nullptr; a.kcol = sub * 64; a.qscale = 0.125f * 1.4426950408889634f; a.ldo = DM; a.outf = nullptr; a.ldq = 3072; a.fixm = dfix;
        a.lam = lam_full; a.onem = 1.0f - lam_init; a.subg = p.in[I_DSUB];
        if (it < 512) { const int ix = xcd_item(it); const int b = ix >> 8, h = (ix >> 5) & 7, qb = ix & 31; const size_t tok = (size_t)NTP + b * 4096 + qb * 128 + w4 * 32;
            a.q = U + tok * 3072 + h * 128 + sub * 64; a.k = KS + (size_t)b * 4352 * 1024 + h * 128; a.ldk = 1024; a.vt = VtS + ((size_t)b * 1024 + h * 128) * 4352; a.ldvt = 4352;
            a.nreal = 4352; a.ntiles = 68; a.out = H + tok * DM + h * 128;
        } else { const int i2 = it - 512, b = i2 >> 4, h = (i2 >> 1) & 7, qb = i2 & 1; const size_t tok = (size_t)b * 256 + qb * 128 + w4 * 32;
            a.q = U + tok * 3072 + h * 128 + sub * 64; a.k = U + (size_t)b * 256 * 3072 + 1024 + h * 128; a.ldk = 3072; a.vt = VtP + ((size_t)b * 1024 + h * 128) * 256; a.ldvt = 256;
            a.nreal = 256; a.ntiles = 4; a.out = H + tok * DM + h * 128;
        }
        flash_item<64, 128, 1, FXC>(lds, a);
    }
}
__device__ void diff_phase(const Params& p, LAS unsigned char* lds) {
    const float dqn = sqrtf(__uint_as_float(*(const unsigned*)(p.ws + WS_DQMAX))), dkn = sqrtf(__uint_as_float(*((const unsigned*)(p.ws + WS_DQMAX) + 1)));
    const float dbound = dqn * dkn * (0.125f * 1.4426950408889634f) * 1.03f + 0.25f; const float dfix = dbound <= 60.0f ? dbound : -1.0f;
    if (dfix >= 0.f) diff_phase_t<true>(p, lds, dfix); else diff_phase_t<false>(p, lds, dfix);
}
__device__ void ret_phase(const Params& p, LAS unsigned char* lds) {
    bf16_t* U = (bf16_t*)(p.ws + WS_U); bf16_t* VtP = (bf16_t*)(p.ws + WS_H); bf16_t* VtS = (bf16_t*)(p.ws + WS_X); bf16_t* OB = (bf16_t*)(p.ws + WS_X + 36 * MiB);
    const bf16_t* ident = (const bf16_t*)(p.ws + WS_IDENT); const bf16_t* identw = (const bf16_t*)(p.ws + WS_IDENTW);
    const float L2E = 1.4426950408889634f;
    for (int it = blockIdx.x; it < 2048; it += gridDim.x) {
        const int wid = __builtin_amdgcn_readfirstlane(otid() >> 6), rg = wid & 3, half = wid >> 2;
        FlashArgs a; a.ident = identw; a.kcol = 0; a.qscale = 1.f; a.ldo = 2048; a.outf = nullptr; a.dir = 0; a.half = half;
        if (it < 512) { const int ix = xcd_item(it); const int b = ix >> 8, h = (ix >> 6) & 3, dvh = (ix >> 5) & 1, qb = ix & 31; const size_t tok0 = (size_t)NTP + b * 4096;
            a.lgf = -fabsf(p.in[I_RLD][h]) * L2E; a.lgb = -fabsf(p.in[I_RLD][4 + h]) * L2E;
            a.n0 = qb * 128 + rg * 32; a.L = 4096;
            a.q = U + (tok0 + a.n0) * 6144 + h * 256; a.ldq = 6144; a.k = U + tok0 * 6144 + 1024 + h * 256; a.ldk = 6144;
            a.vt = VtS + ((size_t)b * 2048 + h * 512 + dvh * 256) * 4608; a.ldvt = 4608; a.nreal = 4096; a.ntiles = 72;
            a.out = nullptr;
            if ((otid() & 63) == 0) { LAS int* pp = (LAS int*)(lds + LDS_RETPARAM) + wid * 8; pp[0] = (int)(tok0 + a.n0); pp[1] = h * 512 + dvh * 256 + half * 128; pp[2] = (b * 4 + h) * 32 + qb; pp[3] = dvh; }
            flash_item<256, 128, 2>(lds, a);
        } else if (it < 1024) { const int i2 = it - 512, b = i2 >> 4, h = (i2 >> 2) & 3, dvh = (i2 >> 1) & 1, qb = i2 & 1; const size_t tok0 = (size_t)b * 256;
            a.lgf = -fabsf(p.in[I_RLD][h]) * L2E; a.lgb = -fabsf(p.in[I_RLD][4 + h]) * L2E;
            a.n0 = qb * 128 + rg * 32; a.L = 256;
            a.q = U + (tok0 + a.n0) * 6144 + h * 256; a.ldq = 6144; a.k = U + tok0 * 6144 + 1024 + h * 256; a.ldk = 6144;
            a.vt = VtP + ((size_t)b * 2048 + h * 512 + dvh * 256) * 256; a.ldvt = 256; a.nreal = 256; a.ntiles = 4;
            a.out = nullptr;
            if ((otid() & 63) == 0) { LAS int* pp = (LAS int*)(lds + LDS_RETPARAM) + wid * 8; pp[0] = (int)(tok0 + a.n0); pp[1] = h * 512 + dvh * 256 + half * 128; pp[2] = 256 + (b * 4 + h) * 2 + qb; pp[3] = dvh; }
            flash_item<256, 128, 2>(lds, a);
        } else { const int i2 = it - 1024, b = i2 >> 5, dir = (i2 >> 4) & 1, h = (i2 >> 2) & 3, dvh = (i2 >> 1) & 1, ib = i2 & 1; const size_t tok0 = (size_t)b * 256;
            a.lgf = -fabsf(p.in[I_RLD][h]) * L2E; a.lgb = -fabsf(p.in[I_RLD][4 + h]) * L2E;
            a.n0 = ib * 128 + rg * 32; a.L = 256; a.dir = dir;
            a.q = ident + (size_t)(ib * 128 + rg * 32) * 256; a.ldq = 256; a.k = U + tok0 * 6144 + 1024 + h * 256; a.ldk = 6144;
            a.vt = VtP + ((size_t)b * 2048 + h * 512 + dvh * 256) * 256; a.ldvt = 256; a.nreal = 256; a.ntiles = 4;
            a.out = nullptr; a.outf = p.out + OUT_NSR + ((size_t)((b * 2 + dir) * 4 + h) * 256 + ib * 128 + rg * 32) * 512 + dvh * 256 + half * 128;
            flash_item<256, 128, 3>(lds, a);
        }
    }
}
__device__ void ret_prep(const Params& p, LAS unsigned char* lds) {
    bf16_t* U = (bf16_t*)(p.ws + WS_U); bf16_t* VtP = (bf16_t*)(p.ws + WS_H); bf16_t* VtS = (bf16_t*)(p.ws + WS_X);
    vt_all<true>(U, 6144, 2048, 2048, VtP, VtS, 4608, 0, lds);
    for (int it = blockIdx.x; it < 16 * 32; it += gridDim.x) { const int mt = it >> 5, tl = it & 31, kt = tl >> 3, ntile = tl & 7; const int b = mt >> 3, dir = (mt >> 2) & 1, h = mt & 3;
        wconv_tile<true>(p.in[I_SRET] + (size_t)mt * 256 * 512, 512, VtS + ((size_t)b * 2048 + h * 512) * 4608 + 4096 + dir * 256, 4608, kt, ntile, (LAS float*)lds); }
}
__device__ void ret_gate(const Params& p) {
    const bf16_t* U = (const bf16_t*)(p.ws + WS_U); bf16_t* OB = (bf16_t*)(p.ws + WS_X + 36 * MiB); const float* gn = p.in[I_RGN];
    const int lane = otid() & 63, gw = blockIdx.x * 8 + (otid() >> 6), nw = gridDim.x * 8;
    for (int it = gw; it < NT * 4; it += nw) { const int t = it >> 2, h = it & 3;
        bf16_t* op = OB + (size_t)t * 2048 + h * 512 + lane * 8; const u32x4 ow = *(const u32x4*)op; const u32x4 gwv = *(const u32x4*)(U + (size_t)t * 6144 + 4096 + h * 512 + lane * 8);
        float o[8], gg[8];
#pragma unroll
        for (int j = 0; j < 4; ++j) { o[2 * j] = bflo(ow[j]); o[2 * j + 1] = bfhi(ow[j]); gg[2 * j] = bflo(gwv[j]); gg[2 * j + 1] = bfhi(gwv[j]); }
        float ss = 0.f;
#pragma unroll
        for (int j = 0; j < 8; ++j) ss += o[j] * o[j];
        ss = wave_sum(ss); const float rs = rsqrtf(ss * (1.0f / 512.0f) + 1e-6f);
        const f32x4 g0 = *(const f32x4*)(gn + h * 512 + lane * 8), g1 = *(const f32x4*)(gn + h * 512 + lane * 8 + 4);
        float r[8];
#pragma unroll
        for (int j = 0; j < 8; ++j) r[j] = siluf(gg[j]) * (o[j] * rs * (j < 4 ? g0[j] : g1[j - 4]));
        *(u32x4*)op = (u32x4){cvt_pk_bf16(r[0], r[1]), cvt_pk_bf16(r[2], r[3]), cvt_pk_bf16(r[4], r[5]), cvt_pk_bf16(r[6], r[7])};
    }
}

__device__ void ffn_act_phase(const bf16_t* __restrict__ src, bf16_t* __restrict__ dst, const float* __restrict__ w, const float* __restrict__ bias) {
    constexpr int C = FF, LD = 2 * FF; const int nc8 = C / 8; const size_t tot = (size_t)(NT / 16) * nc8;
    for (size_t it = (size_t)blockIdx.x * 512 + otid(); it < tot; it += (size_t)gridDim.x * 512) {
        const int cb = (int)(it % nc8), rb = (int)(it / nc8), r0 = rb * 16, j0 = cb * 8;
        const int Ls = r0 < NTP ? 256 : 4096; const bool hasp = (r0 % Ls) != 0, hasn = ((r0 + 16) % Ls) != 0;
        float w0[2][8], w1[2][8], w2[2][8], bb[2][8];
#pragma unroll
        for (int q = 0; q < 2; ++q)
#pragma unroll
            for (int j = 0; j < 8; ++j) { const int c = j0 + j + q * C; w0[q][j] = w[c]; w1[q][j] = w[LD + c]; w2[q][j] = w[2 * LD + c]; bb[q][j] = bias[c]; }
        const bf16_t* sp = src + (size_t)r0 * LD + j0;
        u32x4 raw[2][6];
        const u32x4 z4 = (u32x4){0u, 0u, 0u, 0u};
#pragma unroll
        for (int q = 0; q < 2; ++q) { raw[q][0] = hasp ? *(const u32x4*)(sp - LD + q * C) : z4; raw[q][1] = *(const u32x4*)(sp + q * C); }
#pragma unroll
        for (int grp = 0; grp < 4; ++grp) {
#pragma unroll
            for (int k = 0; k < 4; ++k)
#pragma unroll
                for (int q = 0; q < 2; ++q) { const int rr = grp * 4 + k + 1; raw[q][2 + k] = (rr < 16 || hasn) ? *(const u32x4*)(sp + (size_t)rr * LD + q * C) : z4; }
#pragma unroll
            for (int k = 0; k < 4; ++k) {
                float o[8];
#pragma unroll
                for (int jj = 0; jj < 4; ++jj) {
                    float ca[2], cbv[2];
#pragma unroll
                    for (int h2 = 0; h2 < 2; ++h2) { const int j = 2 * jj + h2;
                        const float pa = h2 ? bfhi(raw[0][k][jj]) : bflo(raw[0][k][jj]), ca_ = h2 ? bfhi(raw[0][k + 1][jj]) : bflo(raw[0][k + 1][jj]), na = h2 ? bfhi(raw[0][k + 2][jj]) : bflo(raw[0][k + 2][jj]);
                        const float pb = h2 ? bfhi(raw[1][k][jj]) : bflo(raw[1][k][jj]), cb_ = h2 ? bfhi(raw[1][k + 1][jj]) : bflo(raw[1][k + 1][jj]), nb = h2 ? bfhi(raw[1][k + 2][jj]) : bflo(raw[1][k + 2][jj]);
                        ca[h2] = w0[0][j] * pa + w1[0][j] * ca_ + w2[0][j] * na + bb[0][j];
                        cbv[h2] = w0[1][j] * pb + w1[1][j] * cb_ + w2[1][j] * nb + bb[1][j];
                        o[j] = siluf(ca[h2]) * cbv[h2]; }
                }
                *(u32x4*)(dst + (size_t)(r0 + grp * 4 + k) * C + j0) = (u32x4){cvt_pk_bf16(o[0], o[1]), cvt_pk_bf16(o[2], o[3]), cvt_pk_bf16(o[4], o[5]), cvt_pk_bf16(o[6], o[7])};
            }
#pragma unroll
            for (int q = 0; q < 2; ++q) { raw[q][0] = raw[q][4]; raw[q][1] = raw[q][5]; }
        }
    }
}

__device__ void hyena_filters(const Params& p, LAS unsigned char* lds) {
    float* FtP = (float*)(p.ws + WS_X); float* FtS = FtP + (size_t)4096 * 256; float* PS = (float*)(p.ws + WS_X + 68 * MiB);
    LAS float* zz = (LAS float*)lds;
    LAS float* a1 = zz + 16 * 33;
    LAS float* a2 = a1 + 16 * 64;
    const int tid = otid();
    const float* w1 = p.in[I_HW1]; const float* b1 = p.in[I_HB1]; const float* w2 = p.in[I_HW2]; const float* b2 = p.in[I_HB2]; const float* w3 = p.in[I_HW3]; const float* fq = p.in[I_HFREQ];
    for (int it = blockIdx.x; it < 272; it += gridDim.x) {
        const int L = it < 16 ? 256 : 4096, t0 = it < 16 ? it * 16 : (it - 16) * 16;
        for (int i = tid; i < 16 * 33; i += 512) { const int r = i / 33, e = i % 33; const float t = (float)(t0 + r); float v;
            if (e == 0) v = t / (float)(L - 1);
            else { const int bi = (e - 1) & 15; const float band = 1e-4f + (float)bi * ((15.0f - 1e-4f) / 15.0f); const float rev = t * band / (float)L; v = e <= 16 ? cos_rev(rev) : -sin_rev(rev); }
            zz[i] = v; }
        __syncthreads();
        for (int i = tid; i < 1024; i += 512) { const int r = i >> 6, j = i & 63; float s = b1[j];
            for (int e = 0; e < 33; ++e) s += zz[r * 33 + e] * w1[e * 64 + j];
            a1[i] = sin_rr(fq[j] * s); }
        __syncthreads();
        for (int i = tid; i < 1024; i += 512) { const int r = i >> 6, j = i & 63; float s = b2[j];
            for (int k = 0; k < 64; ++k) s += a1[r * 64 + k] * w2[k * 64 + j];
            a2[i] = sin_rr(fq[64 + j] * s); }
        __syncthreads();
        const int c0 = tid * 8;
        float acc[16][8];
#pragma unroll
        for (int r = 0; r < 16; ++r)
#pragma unroll
            for (int j = 0; j < 8; ++j) acc[r][j] = 0.f;
        for (int k = 0; k < 64; ++k) { const f32x4 wa = *(const f32x4*)(w3 + (size_t)k * 4096 + c0), wb = *(const f32x4*)(w3 + (size_t)k * 4096 + c0 + 4);
#pragma unroll
            for (int r = 0; r < 16; ++r) { const float av = a2[r * 64 + k];
#pragma unroll
                for (int j = 0; j < 4; ++j) { acc[r][j] += av * wa[j]; acc[r][4 + j] += av * wb[j]; } } }
        float asum[8];
#pragma unroll
        for (int j = 0; j < 8; ++j) asum[j] = 0.f;
        const float mind = -3.0701134573253945f, maxd = -15.350567286626973f;
        float dl[8];
#pragma unroll
        for (int j = 0; j < 8; ++j) { const int c = (c0 + j) & 1023; dl[j] = fabsf(mind + (maxd - mind) * ((float)c / 1023.0f)); }
#pragma unroll
        for (int r = 0; r < 16; ++r) { const float tn = (float)(t0 + r) / (float)(L - 1);
#pragma unroll
            for (int j = 0; j < 8; ++j) { acc[r][j] *= (__expf(-tn * dl[j]) + 0.05f); asum[j] += fabsf(acc[r][j]); } }
        { float* Ft = it < 16 ? FtP : FtS;
#pragma unroll
          for (int j = 0; j < 8; ++j) { float* d = Ft + (size_t)(c0 + j) * L + t0;
#pragma unroll
              for (int r4 = 0; r4 < 4; ++r4) *(f32x4*)(d + r4 * 4) = (f32x4){acc[r4 * 4][j], acc[r4 * 4 + 1][j], acc[r4 * 4 + 2][j], acc[r4 * 4 + 3][j]}; } }
        *(f32x4*)(PS + (size_t)it * 4096 + c0) = (f32x4){asum[0], asum[1], asum[2], asum[3]}; *(f32x4*)(PS + (size_t)it * 4096 + c0 + 4) = (f32x4){asum[4], asum[5], asum[6], asum[7]};
        __syncthreads();
    }
}
__device__ void hyena_dwconv_t(const bf16_t* __restrict__ src, bf16_t* __restrict__ Zt, const float* __restrict__ w, const float* __restrict__ bias) {
    constexpr int C = 3072; const int nc8 = C / 8; const size_t tot = (size_t)(NT / 16) * nc8;
    for (size_t it = (size_t)blockIdx.x * 512 + otid(); it < tot; it += (size_t)gridDim.x * 512) {
        const int cb = (int)(it % nc8), rb = (int)(it / nc8), r0 = rb * 16, j0 = cb * 8;
        const int Ls = r0 < NTP ? 256 : 4096; const bool hasp = (r0 % Ls) != 0, hasn = ((r0 + 16) % Ls) != 0;
        float w0[8], w1[8], w2[8], bb[8];
#pragma unroll
        for (int j = 0; j < 8; ++j) { const int c = j0 + j; w0[j] = w[c]; w1[j] = w[C + c]; w2[j] = w[2 * C + c]; bb[j] = bias[c]; }
        float pv[8], cv[8], nv[8], lo[8]; unsigned pk[8][8];
        auto ld8 = [&](int r, float* o, bool ok) {
            if (ok) { const u32x4 x = *(const u32x4*)(src + (size_t)r * C + j0);
#pragma unroll
                for (int j = 0; j < 4; ++j) { o[2 * j] = bflo(x[j]); o[2 * j + 1] = bfhi(x[j]); } }
            else {
#pragma unroll
                for (int j = 0; j < 8; ++j) o[j] = 0.f; }
        };
        ld8(r0 - 1, pv, hasp); ld8(r0, cv, true);
#pragma unroll
        for (int i = 0; i < 16; ++i) {
            ld8(r0 + i + 1, nv, (i < 15) || hasn);
#pragma unroll
            for (int j = 0; j < 8; ++j) { const float o = w0[j] * pv[j] + w1[j] * cv[j] + w2[j] * nv[j] + bb[j];
                if (i & 1) pk[j][i >> 1] = cvt_pk_bf16(lo[j], o); else lo[j] = o;
                pv[j] = cv[j]; cv[j] = nv[j]; }
        }
#pragma unroll
        for (int j = 0; j < 8; ++j) { bf16_t* d = Zt + (size_t)(j0 + j) * NT + r0;
            *(u32x4*)d = (u32x4){pk[j][0], pk[j][1], pk[j][2], pk[j][3]}; *(u32x4*)(d + 8) = (u32x4){pk[j][4], pk[j][5], pk[j][6], pk[j][7]}; }
    }
}
__device__ __forceinline__ float blk_sum2(float v, LAS float* red, int slot) {
    v = wave_sum(v); if ((otid() & 63) == 0) red[slot * 8 + (otid() >> 6)] = v; return v; }
__device__ void hyena_mfma(const Params& p, LAS unsigned char* lds) {
    const float* FtP = (const float*)(p.ws + WS_X); const float* FtS = FtP + (size_t)4096 * 256; const float* PS = (const float*)(p.ws + WS_X + 68 * MiB);
    bf16_t* U = (bf16_t*)(p.ws + WS_U); const bf16_t* Zt = U + (size_t)NT * 3072; bf16_t* yT = U;
    for (int it = blockIdx.x; it < 2048; it += gridDim.x) {
        const int tid = otid(), lane = tid & 63, wid = tid >> 6, lr = lane & 31, g = lane >> 5;
        const int c = it & 1023;
        if (it < 1024) {
            constexpr int CST = 16400;
            LAS unsigned char* cp = lds; LAS bf16_t* uL = (LAS bf16_t*)(lds + 8 * CST); LAS float* red = (LAS float*)(lds + 8 * CST + 18432);
            const int mi = wid & 1, ah = (wid >> 1) & 1, batch = wid >> 2;
            for (int order = 0; order < 2; ++order) {
                const int colf = order * 1024 + c, colb = 2048 + order * 1024 + c;
                blk_sum2(tid < 256 ? PS[(size_t)(16 + tid) * 4096 + colf] : 0.f, red, 0); blk_sum2(tid < 256 ? PS[(size_t)(16 + tid) * 4096 + colb] : 0.f, red, 1);
                __syncthreads();
                float sf = 0.f, sb = 0.f;
#pragma unroll
                for (int q = 0; q < 8; ++q) { sf += red[q]; sb += red[8 + q]; }
                const float nf = 1.0f / (sf + 1e-6f), nb = 1.0f / (sb + 1e-6f), skip = p.in[I_HSKIP][order * 1024 + c];
                const float* hf = FtS + (size_t)colf * 4096; const float* hb = FtS + (size_t)colb * 4096;
                { float pv[24];
#pragma unroll
                  for (int j = 0; j < 24; ++j) { const int i = 16 * tid + j; float v;
                      if (i <= 0 || i >= 8192) v = 0.f; else if (i < 4096) v = hf[4096 - i] * nf; else if (i == 4096) v = hf[0] * nf + hb[0] * nb + skip; else v = hb[i - 4096] * nb;
                      pv[j] = v; }
#pragma unroll
                  for (int rho = 0; rho < 8; ++rho) { LAS unsigned char* d = cp + rho * CST + tid * 32;
                      *(LAS u32x4*)d = (u32x4){cvt_pk_bf16(pv[rho], pv[rho + 1]), cvt_pk_bf16(pv[rho + 2], pv[rho + 3]), cvt_pk_bf16(pv[rho + 4], pv[rho + 5]), cvt_pk_bf16(pv[rho + 6], pv[rho + 7])};
                      *(LAS u32x4*)(d + 16) = (u32x4){cvt_pk_bf16(pv[rho + 8], pv[rho + 9]), cvt_pk_bf16(pv[rho + 10], pv[rho + 11]), cvt_pk_bf16(pv[rho + 12], pv[rho + 13]), cvt_pk_bf16(pv[rho + 14], pv[rho + 15])}; } }
                if (order == 0) {
#pragma unroll
                    for (int i = 0; i < 2; ++i) { const int idx = tid + i * 512, bt = idx >> 9, ch = idx & 511;
                        *(LAS u32x4*)(uL + bt * 4608 + (ch >> 3) * 72 + (ch & 7) * 8) = *(const u32x4*)(Zt + (size_t)(2048 + c) * NT + NTP + bt * 4096 + ch * 8); }
                }
                __syncthreads();
                f32x16 acc;
#pragma unroll
                for (int r = 0; r < 16; ++r) acc[r] = 0.f;
                const int bp = 32 * mi + lr, rho = (-bp) & 7;
                const LAS unsigned char* cb = cp + rho * CST; const LAS bf16_t* ub = uL + batch * 4608;
                for (int e = 32 * ah - 63; e <= 32 * ah + 31; ++e) {
                    const int aa = 32 * ah + lr - e; const bool valid = (unsigned)aa < 64u; const int aac = aa & 63;
#pragma unroll
                    for (int ks = 0; ks < 4; ++ks) {
                        const int q = 4096 + 16 * ks + 8 * g - bp - 64 * e;
                        const bf16x8 af = *(const LAS bf16x8*)(cb + (q - rho) * 2);
                        u32x4 bw = *(const LAS u32x4*)(ub + aac * 72 + 16 * ks + 8 * g);
                        if (!valid) bw = (u32x4){0u, 0u, 0u, 0u};
                        acc = __builtin_amdgcn_mfma_f32_32x32x16_bf16(af, __builtin_bit_cast(bf16x8, bw), acc, 0, 0, 0);
                    }
                }
                __syncthreads();
                { const bf16_t* gp = Zt + (size_t)(order == 0 ? c : 1024 + c) * NT + NTP + batch * 4096; const int a = 32 * ah + lr;
#pragma unroll
                  for (int q4 = 0; q4 < 4; ++q4) { const int bq = 32 * mi + 8 * q4 + 4 * g; const u32x2 gv = *(const u32x2*)(gp + 64 * a + bq);
                      *(LAS u32x2*)(uL + batch * 4608 + a * 72 + bq) = (u32x2){cvt_pk_bf16(acc[4 * q4] * bflo(gv.x), acc[4 * q4 + 1] * bfhi(gv.x)), cvt_pk_bf16(acc[4 * q4 + 2] * bflo(gv.y), acc[4 * q4 + 3] * bfhi(gv.y))}; } }
                __syncthreads();
            }
#pragma unroll
            for (int i = 0; i < 2; ++i) { const int idx = tid + i * 512, bt = idx >> 9, ch = idx & 511;
                *(u32x4*)(yT + (size_t)c * NT + NTP + bt * 4096 + ch * 8) = *(const LAS u32x4*)(uL + bt * 4608 + (ch >> 3) * 72 + (ch & 7) * 8); }
            __syncthreads();
        } else {
            constexpr int CSP = 1040;
            LAS unsigned char* cp = lds; LAS bf16_t* uL = (LAS bf16_t*)(lds + 8 * CSP); LAS float* red = (LAS float*)(lds + 8 * CSP + 16896);
            const int mi = wid;
            for (int order = 0; order < 2; ++order) {
                const int colf = order * 1024 + c, colb = 2048 + order * 1024 + c;
                blk_sum2(tid < 16 ? PS[(size_t)tid * 4096 + colf] : 0.f, red, 0); blk_sum2(tid < 16 ? PS[(size_t)tid * 4096 + colb] : 0.f, red, 1);
                __syncthreads();
                float sf = 0.f, sb = 0.f;
#pragma unroll
                for (int q = 0; q < 8; ++q) { sf += red[q]; sb += red[8 + q]; }
                const float nf = 1.0f / (sf + 1e-6f), nb = 1.0f / (sb + 1e-6f), skip = p.in[I_HSKIP][order * 1024 + c];
                const float* hf = FtP + (size_t)colf * 256; const float* hb = FtP + (size_t)colb * 256;
                { const int rho = tid >> 6, ch = tid & 63; float pv[8];
#pragma unroll
                  for (int j = 0; j < 8; ++j) { const int i = 8 * ch + rho + j; float v;
                      if (i <= 0 || i >= 512) v = 0.f; else if (i < 256) v = hf[256 - i] * nf; else if (i == 256) v = hf[0] * nf + hb[0] * nb + skip; else v = hb[i - 256] * nb;
                      pv[j] = v; }
                  *(LAS u32x4*)(cp + rho * CSP + ch * 16) = (u32x4){cvt_pk_bf16(pv[0], pv[1]), cvt_pk_bf16(pv[2], pv[3]), cvt_pk_bf16(pv[4], pv[5]), cvt_pk_bf16(pv[6], pv[7])}; }
                if (order == 0) {
#pragma unroll
                    for (int i = 0; i < 2; ++i) { const int idx = tid + i * 512, bt = idx >> 5, ch = idx & 31;
                        *(LAS u32x4*)(uL + bt * 264 + ch * 8) = *(const u32x4*)(Zt + (size_t)(2048 + c) * NT + bt * 256 + ch * 8); }
                }
                __syncthreads();
                f32x16 acc;
#pragma unroll
                for (int r = 0; r < 16; ++r) acc[r] = 0.f;
                const int t = 32 * mi + lr, rho = (-t) & 7;
                const LAS unsigned char* cb = cp + rho * CSP;
#pragma unroll 4
                for (int ks = 0; ks < 16; ++ks) {
                    const int q = 256 + 16 * ks + 8 * g - t;
                    const bf16x8 af = *(const LAS bf16x8*)(cb + (q - rho) * 2);
                    const bf16x8 bf = *(const LAS bf16x8*)(uL + lr * 264 + 16 * ks + 8 * g);
                    acc = __builtin_amdgcn_mfma_f32_32x32x16_bf16(af, bf, acc, 0, 0, 0);
                }
                __syncthreads();
                { const bf16_t* gp = Zt + (size_t)(order == 0 ? c : 1024 + c) * NT + lr * 256;
#pragma unroll
                  for (int q4 = 0; q4 < 4; ++q4) { const int t4 = 32 * mi + 8 * q4 + 4 * g; const u32x2 gv = *(const u32x2*)(gp + t4);
                      *(LAS u32x2*)(uL + lr * 264 + t4) = (u32x2){cvt_pk_bf16(acc[4 * q4] * bflo(gv.x), acc[4 * q4 + 1] * bfhi(gv.x)), cvt_pk_bf16(acc[4 * q4 + 2] * bflo(gv.y), acc[4 * q4 + 3] * bfhi(gv.y))}; } }
                __syncthreads();
            }
#pragma unroll
            for (int i = 0; i < 2; ++i) { const int idx = tid + i * 512, bt = idx >> 5, ch = idx & 31;
                *(u32x4*)(yT + (size_t)c * NT + bt * 256 + ch * 8) = *(const LAS u32x4*)(uL + bt * 264 + ch * 8); }
            __syncthreads();
        }
    }
}
__device__ void hyena_untranspose(const Params& p, LAS unsigned char* lds) {
    const bf16_t* yT = (const bf16_t*)(p.ws + WS_U); bf16_t* H = (bf16_t*)(p.ws + WS_H);
    for (int it = blockIdx.x; it < 16 * 64; it += gridDim.x) { const int ct = it & 15, tt = it >> 4;
        vt_tile<4>(yT + (size_t)(ct * 64) * NT + tt * 256, NT, H + (size_t)(tt * 256) * DM + ct * 64, DM, (LAS bf16_t*)lds); }
}


#define XB_TMO      128
#define XB_XCNT(j)  (256  + 64 * (j))
#define XB_XSUB(j)  (1280 + 64 * (j))
#define XB_XGEN(j)  (2304 + 64 * (j))
#define XB_TOP      3328
#define XB_TOPGEN   3392
#define XCD_BAR_WORDS 3456
#define XB_SPIN_CAP (1u << 18)
__device__ __forceinline__ unsigned xb_ld(unsigned* p)              { return __hip_atomic_load(p, __ATOMIC_RELAXED, __HIP_MEMORY_SCOPE_AGENT); }
__device__ __forceinline__ unsigned xb_add(unsigned* p, unsigned v) { return __hip_atomic_fetch_add(p, v, __ATOMIC_RELAXED, __HIP_MEMORY_SCOPE_AGENT); }
__device__ __forceinline__ unsigned xb_xcc_id() { return (unsigned)__builtin_amdgcn_s_getreg((3 << 11) | 20) & 0xFu; }
#define XB_SPIN(cond, bar) do { unsigned _sp = 0; while (cond) { __builtin_amdgcn_s_sleep(1); \
    if ((++_sp & 255u) == 0u) { if (xb_ld(&(bar)[XB_TMO])) break; if (_sp > XB_SPIN_CAP) { atomicAdd(&(bar)[XB_TMO], 1u); break; } } } } while (0)
__device__ __forceinline__ void xcd_barrier_post(unsigned* bar) { if (threadIdx.x == 0) (void)xb_add(&bar[XB_XCNT(xb_xcc_id())], 1u); }
__device__ __forceinline__ void xcd_barrier_complete(unsigned* bar, unsigned x, unsigned& nloc, unsigned& nx) {
    const unsigned G = gridDim.x * gridDim.y * gridDim.z;
    unsigned sum, cnt, mine, sp = 0u;
    for (;;) {
        sum = 0u; cnt = 0u; mine = 0u;
#pragma unroll
        for (unsigned j = 0; j < 16; ++j) { const unsigned c = xb_ld(&bar[XB_XCNT(j)]); sum += c; cnt += (c > 0u) ? 1u : 0u; mine = (j == x) ? c : mine; }
        if (sum == G) break;
        __builtin_amdgcn_s_sleep(1);
        if ((++sp & 255u) == 0u) { if (xb_ld(&bar[XB_TMO])) break; if (sp > XB_SPIN_CAP) { atomicAdd(&bar[XB_TMO], 1u); break; } }
    }
    nloc = mine > 0u ? mine : 1u; nx = cnt > 0u ? cnt : 1u;
}
__device__ __forceinline__ void xcd_barrier(unsigned* bar, volatile LAS unsigned* st) {
    asm volatile("s_waitcnt vmcnt(0)" ::: "memory");
    __syncthreads();
    if (threadIdx.x == 0) {
        const unsigned x = xb_xcc_id();
        __builtin_amdgcn_s_waitcnt(0);
        unsigned nloc = st[0], nx = st[1];
        if (nloc == 0u) { xcd_barrier_complete(bar, x, nloc, nx); st[0] = nloc; st[1] = nx; }
        const unsigned old = xb_add(&bar[XB_XSUB(x)], 1u);
        const unsigned gen = old / nloc;
        if (old + 1u == (gen + 1u) * nloc) {
            __builtin_amdgcn_fence(__ATOMIC_RELEASE, "agent");
            asm volatile("s_waitcnt vmcnt(0)" ::: "memory");
            const unsigned og = xb_add(&bar[XB_TOP], 1u);
            const unsigned tg = og / nx;
            if (og + 1u == (tg + 1u) * nx) xb_add(&bar[XB_TOPGEN], 1u);
            else XB_SPIN(xb_ld(&bar[XB_TOPGEN]) == tg, bar);
            __builtin_amdgcn_fence(__ATOMIC_ACQUIRE, "agent");
            xb_add(&bar[XB_XGEN(x)], 1u);
            asm volatile("s_waitcnt vmcnt(0)" ::: "memory");
        } else {
            XB_SPIN(xb_ld(&bar[XB_XGEN(x)]) == gen, bar);
            __builtin_amdgcn_fence(__ATOMIC_ACQUIRE, "agent");
            asm volatile("s_waitcnt vmcnt(0)" ::: "memory");
        }
    }
    __syncthreads();
}

#ifndef REP_FLASH
#define REP_FLASH 1
#endif
#ifndef REP_L
#define REP_L -1
#endif
#ifndef REP_SYNC
#define REP_SYNC 1
#endif
#ifndef REP_GEMM
#define REP_GEMM 1
#endif
#ifndef DBG_L
#define DBG_L 2
#endif
constexpr int NPHASE = 42;

__device__ __forceinline__ void run_gemm_bf16(LAS unsigned char* lds, const bf16_t* A, const bf16_t* Bt, int N, int K, bf16_t* O) {
    pg8::Gemm g{A, Bt, NT, N, K}; pg8::StaticOrder S; S.init(NT, N, (int)gridDim.x, (int)blockIdx.x); pg8::EpiBf16 E{O, N};
    pg8::gemm_phase<pg8::EpiBf16, pg8::StaticOrder>(lds, g, S, E);
}
__device__ __forceinline__ void run_gemm_res(LAS unsigned char* lds, const bf16_t* A, const bf16_t* Bt, int K, bf16_t* X, const float* mod, int goff,
                                             bf16_t* An, const float* gnext, int scoff, int shoff, unsigned long long* slots, unsigned tag, int fin, float* Y, unsigned* bar) {
    pg8::Gemm g{A, Bt, NT, DM, K}; pg8::StaticOrder S; S.init(NT, DM, (int)gridDim.x, (int)blockIdx.x); pg8::EpiRes E{X, mod, goff, An, gnext, scoff, shoff, slots, tag, fin, Y, bar};
    pg8::gemm_phase<pg8::EpiRes, pg8::StaticOrder>(lds, g, S, E);
}

__device__ void conv_mixer_weights(const Params& p, int l, LAS unsigned char* lds) {
    bf16_t* W = (bf16_t*)(p.ws + WS_WMIX); int rot = 0;
    if (l == 0) { wconv(p.in[I_AQKV], 1024, 1536, W, lds, rot); wconv(p.in[I_AWO], 1024, 1024, W + (size_t)1536 * 1024, lds, rot); }
    else if (l == 1) { wconv(p.in[I_DQKV], 1024, 3072, W, lds, rot); wconv(p.in[I_DWO], 1024, 1024, W + (size_t)3072 * 1024, lds, rot); }
    else if (l == 2) { wconv(p.in[I_RWIN], 1024, 6144, W, lds, rot); wconv(p.in[I_RWO], 2048, 1024, W + (size_t)6144 * 1024, lds, rot); }
    else { wconv(p.in[I_HWIN], 1024, 3072, W, lds, rot); wconv(p.in[I_HWO], 1024, 1024, W + (size_t)3072 * 1024, lds, rot); }
}
__device__ void conv_ffn_weights(const Params& p, int l, LAS unsigned char* lds) {
    bf16_t* W = (bf16_t*)(p.ws + WS_WFFN); int rot = 0;
    wconv(p.in[I_FUP] + (size_t)l * 1024 * 5632, 1024, 5632, W, lds, rot); wconv(p.in[I_FDOWN] + (size_t)l * FF * 1024, FF, 1024, W + (size_t)5632 * 1024, lds, rot);
}

__device__ __forceinline__ bool phase_empty(int ph) { if (ph == 0) return false; if (ph == 41) return true;     const int l = (ph - 1) / 10, s = (ph - 1) % 10; return (s == 4 && l < 3)   || s == 6 || (s == 0 && l > 0); }

#ifndef ONLY
#define ONLY -1
#endif
#define EN(x) (ONLY == -1 || ONLY == (x))
__device__ __forceinline__ void run_phase(int ph, LAS unsigned char* lds) {
    KParamsPtr kp = (KParamsPtr)__builtin_amdgcn_kernarg_segment_ptr();
    asm volatile("" : "+s"(kp));
    Params p;
#pragma unroll
    for (int i = 0; i < 41; ++i) p.in[i] = kp->in[i];
    p.out = kp->out; p.ws = kp->ws;
    bf16_t* X = (bf16_t*)((unsigned char*)p.out + XR_OFF); const float* mod = (const float*)(p.ws + WS_MOD);
    bf16_t* H = (bf16_t*)(p.ws + WS_H); bf16_t* U = (bf16_t*)(p.ws + WS_U); bf16_t* XB = (bf16_t*)(p.ws + WS_X);
    bf16_t* WM = (bf16_t*)(p.ws + WS_WMIX); bf16_t* WF = (bf16_t*)(p.ws + WS_WFFN);
    if (ph == 0) { if (EN(0)) { prep_misc(p, lds); conv_mixer_weights(p, 0, lds); conv_ffn_weights(p, 0, lds); } return; }
    if (ph == 41) return;
    const int l = (ph - 1) / 10, s = (ph - 1) % 10;
    const int nin = l == 0 ? 1536 : (l == 2 ? 6144 : 3072);
    const int kout = l == 2 ? 2048 : 1024;
    unsigned long long* slots = (unsigned long long*)(p.ws + WS_SLOT);
    if (s == 0) { if (EN(2)) norm_mod(X, p.in[I_N1G] + l * DM, mod + l * 6144, 1 * 1024, 0, H); }
    else if (s == 1) { if (EN(4)) run_gemm_bf16(lds, H, WM, nin, 1024, U); }
    else if (s == 7) { if (EN(4)) run_gemm_bf16(lds, XB, WF, 5632, 1024, U); }
    else if (s == 5) { if (EN(5)) run_gemm_res(lds, l == 2 ? (const bf16_t*)(p.ws + WS_X + 36 * MiB) : H, WM + (size_t)nin * 1024, kout, X, mod, l * 6144 + 2 * 1024,
                                               XB, p.in[I_N2G] + l * DM, l * 6144 + 4 * 1024, l * 6144 + 3 * 1024, slots, (unsigned)(ph + 1), 0, p.out, (unsigned*)(p.ws + WS_BAR)); }
    else if (s == 9) { if (EN(5)) run_gemm_res(lds, XB, WF + (size_t)5632 * 1024, FF, X, mod, l * 6144 + 5 * 1024,
                                               l < 3 ? H : nullptr, l < 3 ? p.in[I_N1G] + (l + 1) * DM : p.in[I_FG], (l < 3 ? l + 1 : 0) * 6144 + 1 * 1024, (l < 3 ? l + 1 : 0) * 6144, slots, (unsigned)(ph + 1), l == 3 ? 1 : 0, p.out, (unsigned*)(p.ws + WS_BAR)); }
    else if (s == 8) { if (EN(6)) ffn_act_phase(U, XB, p.in[I_FCW] + (size_t)l * 3 * 5632, p.in[I_FCB] + (size_t)l * 5632); if (EN(0)) { if (l < 3) conv_mixer_weights(p, l + 1, lds); } }
    else if (s == 2) {
        if (l == 0) { if (EN(7)) { post_attn(p, U, XB, XB + (size_t)2 * 4352 * 256); vt_all(U, 1536, 1280, 256, XB + (size_t)2 * 4352 * 256 + (size_t)2 * 256 * 4352, XB + (size_t)2 * 4352 * 256, 4352, 256, lds); } }
        else if (l == 1) { if (EN(8)) { post_diff(p, U, XB, XB + (size_t)2 * 4352 * 1024, lds); vt_all(U, 3072, 2048, 1024, XB + (size_t)2 * 4352 * 1024 + (size_t)2 * 1024 * 4352, XB + (size_t)2 * 4352 * 1024, 4352, 256, lds); } }
        else if (l == 2) { if (EN(9)) ret_prep(p, lds); }
        else { if (EN(10)) hyena_dwconv_t(U, U + (size_t)NT * 3072, p.in[I_HSCW], p.in[I_HSCB]); if (EN(3)) hyena_filters(p, lds); }
        if (EN(0)) { if (l > 0) conv_ffn_weights(p, l, lds); }
    } else if (s == 3) {
        if (l < 3) { for (int rep = 0; rep < (l == REP_L ? 2 : REP_FLASH); ++rep) { if (l == 0) { if (EN(11)) attn_phase(p, lds); } else if (l == 1) { if (EN(12)) diff_phase(p, lds); } else if (l == 2) { if (EN(13)) ret_phase(p, lds); } } }
        else { if (EN(14)) hyena_mfma(p, lds); }
    } else if (s == 4) {
        if (l == 2) { if (EN(15)) ret_gate(p); }
        else if (l == 3) { if (EN(16)) hyena_untranspose(p, lds); }
    }
}

__global__ void __launch_bounds__(512, 2) mega_kernel(Params p, int ph_begin, int ph_end) {
    extern __shared__ __attribute__((aligned(16))) unsigned char shm[];
    LAS unsigned char* lds = (LAS unsigned char*)shm;
    cg::grid_group grid = cg::this_grid();
    volatile LAS unsigned* st = (volatile LAS unsigned*)(lds + LDS_BYTES - 16);
    if (threadIdx.x == 0) { st[0] = 0u; st[1] = 0u; }
    __syncthreads();
    xcd_barrier_post((unsigned*)(p.ws + WS_BAR));
    int nsync = 0;
    for (int ph = ph_begin; ph < ph_end; ++ph) {
        if (phase_empty(ph)) continue;
        if (nsync == 1) {
            __builtin_amdgcn_fence(__ATOMIC_RELEASE, "agent"); asm volatile("s_waitcnt vmcnt(0) lgkmcnt(0)" ::: "memory");
            grid.sync();
            __builtin_amdgcn_fence(__ATOMIC_ACQUIRE, "agent"); asm volatile("s_waitcnt vmcnt(0) lgkmcnt(0)" ::: "memory");
        } else if (nsync > 1) {
            KParamsPtr kp = (KParamsPtr)__builtin_amdgcn_kernarg_segment_ptr();
            xcd_barrier((unsigned*)(kp->ws + WS_BAR), st);
        }
        ++nsync;
        run_phase(ph, lds);
        __syncthreads();
    }
}

extern "C" void kernel_launch(void* const* d_in, const int* in_sizes, int n_in, void* d_out, int out_size, void* d_ws, size_t ws_size, hipStream_t stream) {
    static int grid_blocks = 0;
    if (!grid_blocks) {
        int dev = 0, cus = 0, per_cu = 0;
        hipGetDevice(&dev);
        hipDeviceGetAttribute(&cus, hipDeviceAttributeMultiprocessorCount, dev);
        if (hipFuncSetAttribute((const void*)mega_kernel, hipFuncAttributeMaxDynamicSharedMemorySize, LDS_BYTES) != hipSuccess) { fprintf(stderr, "hipFuncSetAttribute failed\n"); return; }
        if (hipOccupancyMaxActiveBlocksPerMultiprocessor(&per_cu, (const void*)mega_kernel, 512, LDS_BYTES) != hipSuccess || per_cu < 1) { fprintf(stderr, "occupancy query failed\n"); return; }
        if (cus != 256) { fprintf(stderr, "this kernel's residual epilogue needs exactly 256 workgroups (one 256x256 unit each); device has %d CUs\n", cus); return; }
        grid_blocks = cus;
    }
    if (ws_size < WS_NEED || n_in < 41) { fprintf(stderr, "workspace too small: %zu < %zu\n", ws_size, (size_t)WS_NEED); return; }
    Params p{};
    for (int i = 0; i < 41; ++i) p.in[i] = (const float*)d_in[i];
    p.out = (float*)d_out; p.ws = (unsigned char*)d_ws;
#if MULTI_LAUNCH
    for (int ph = 0; ph < NPHASE; ++ph) {
        int b = ph, e = ph + 1; void* args[] = {&p, &b, &e};
        hipLaunchCooperativeKernel((const void*)mega_kernel, dim3(grid_blocks), dim3(512), args, LDS_BYTES, stream);
    }
#else
    (void)hipMemsetAsync((unsigned char*)d_ws + WS_BAR, 0, XCD_BAR_WORDS * sizeof(unsigned), stream);
    (void)hipMemsetAsync((unsigned char*)d_ws + WS_SLOT, 0, WS_SLOT_BYTES + WS_PSLOT_BYTES + 256, stream);
    int b = 0, e = NPHASE; void* args[] = {&p, &b, &e};
    hipError_t err = hipLaunchCooperativeKernel((const void*)mega_kernel, dim3(grid_blocks), dim3(512), args, LDS_BYTES, stream);
    if (err != hipSuccess) fprintf(stderr, "cooperative launch failed: %s (grid %d)\n", hipGetErrorString(err), grid_blocks);
#endif
}
```

```cpp
#include <hip/hip_runtime.h>
#include <hip/hip_cooperative_groups.h>
#include <cstdio>
namespace cg = cooperative_groups;

#ifndef MULTI_LAUNCH
#define MULTI_LAUNCH 0
#endif

#define LAS __attribute__((address_space(3)))
typedef unsigned short bf16_t;
typedef short bf16x8 __attribute__((ext_vector_type(8)));
typedef float f32x4 __attribute__((ext_vector_type(4)));
typedef float f32x16 __attribute__((ext_vector_type(16)));
typedef unsigned u32x4 __attribute__((ext_vector_type(4)));
typedef unsigned u32x2 __attribute__((ext_vector_type(2)));

constexpr int NT = 16384;
constexpr int NTP = 8192;
constexpr int DM = 1024;
constexpr int FF = 2816;
constexpr int LDS_BYTES = 155648;
constexpr size_t MiB = 1048576;
constexpr size_t WS_MOD = 0;
constexpr size_t WS_IDENT = 512 * 1024;
constexpr size_t WS_SLOT = 2 * 1048576;
constexpr size_t WS_SLOT_BYTES = 64 * 4 * 256 * 8;
constexpr size_t WS_PSLOT = WS_SLOT + WS_SLOT_BYTES;
constexpr size_t WS_PSLOT_BYTES = 512 * 2 * 128 * 8;
constexpr size_t WS_DQMAX = WS_PSLOT + WS_PSLOT_BYTES + 16;
constexpr size_t WS_CKMAX = WS_PSLOT + WS_PSLOT_BYTES;
constexpr size_t WS_BAR = 1024 * 1024;
constexpr size_t WS_WMIX = 4 * MiB;
constexpr size_t WS_WFFN = 22 * MiB;
constexpr size_t WS_H = 40 * MiB;
constexpr size_t WS_U = 72 * MiB;
constexpr size_t WS_X = 264 * MiB;
constexpr size_t WS_IDENTW = 364 * MiB;
constexpr size_t WS_NEED = 368 * MiB;
constexpr size_t XR_OFF = 32 * 1048576;
constexpr size_t OUT_NAK = 16777216, OUT_NAV = 18874368, OUT_NDK = 20971520, OUT_NDV = 29360128, OUT_NSR = 37748736;

struct Params { const float* in[41]; float* out; unsigned char* ws; };
typedef const __attribute__((address_space(4))) Params* KParamsPtr;
constexpr int LDS_RETPARAM = 148 * 1024;

enum { I_XP = 0, I_XS, I_CAK, I_CAV, I_CDK, I_CDV, I_SRET, I_C, I_CCTX, I_WMOD, I_BMOD, I_N1G, I_N2G, I_FG, I_AQKV, I_AQG, I_AKG, I_AWO,
       I_DQKV, I_DLAM, I_DSUB, I_DWO, I_RWIN, I_RLD, I_RGN, I_RWO, I_HWIN, I_HSCW, I_HSCB, I_HW1, I_HB1, I_HW2, I_HB2, I_HW3, I_HFREQ, I_HSKIP, I_HWO,
       I_FUP, I_FCW, I_FCB, I_FDOWN };

__device__ __forceinline__ int otid() { int t = (int)threadIdx.x; asm volatile("" : "+v"(t)); return t; }
typedef float f32x2v __attribute__((ext_vector_type(2)));
typedef __bf16 bf16x2v __attribute__((ext_vector_type(2)));
__device__ __forceinline__ unsigned cvt_pk_bf16(float lo, float hi) { const f32x2v v = {lo, hi}; const bf16x2v b = __builtin_convertvector(v, bf16x2v); return __builtin_bit_cast(unsigned, b); }
__device__ __forceinline__ bf16_t f2bf(float f) { return (bf16_t)(cvt_pk_bf16(f, 0.f) & 0xffffu); }
__device__ __forceinline__ float bf2f(bf16_t b) { return __uint_as_float(((unsigned)b) << 16); }
__device__ __forceinline__ float bflo(unsigned w) { return __uint_as_float(w << 16); }
__device__ __forceinline__ float bfhi(unsigned w) { return __uint_as_float(w & 0xffff0000u); }
__device__ __forceinline__ float shfl_xor_f(float v, int m) { return __int_as_float(__builtin_amdgcn_ds_bpermute((((int)(otid() & 63)) ^ m) << 2, __float_as_int(v))); }
__device__ __forceinline__ float wave_sum(float v) {
#pragma unroll
    for (int o = 32; o >= 1; o >>= 1) v += shfl_xor_f(v, o);
    return v;
}
__device__ __forceinline__ float fast_exp2(float x) { return __builtin_amdgcn_exp2f(x); }
__device__ __forceinline__ float siluf(float x) { return x * __builtin_amdgcn_rcpf(1.0f + __expf(-x)); }
__device__ __forceinline__ float sin_rr(float x) { float r = x * 0.15915494309189535f; r -= rintf(r); return __builtin_amdgcn_sinf(r); }
__device__ __forceinline__ float cos_rr(float x) { float r = x * 0.15915494309189535f; r -= rintf(r); return __builtin_amdgcn_cosf(r); }
__device__ __forceinline__ float sin_rev(float r) { r -= rintf(r); return __builtin_amdgcn_sinf(r); }
__device__ __forceinline__ float cos_rev(float r) { r -= rintf(r); return __builtin_amdgcn_cosf(r); }

__device__ __forceinline__ void xcd_barrier(unsigned* bar, volatile LAS unsigned* st);
namespace pg8 {
constexpr int BM = 256, BK = 64, HALF = 128, HTB = HALF * BK * 2, STAGE_BYTES = 8 * HTB, NXCD = 8, WGM = 8;
__device__ __forceinline__ int lds_byte(int r, int c) { const int st = (r >> 4) * 2 + (c >> 5), rr = r & 15, cc = c & 31, ob = rr * 64 + cc * 2; return st * 1024 + (ob ^ (((ob >> 9) & 1) << 5)); }
__device__ __forceinline__ void stage_rc(int b, int& R, int& C) { const int st = b / 1024, sb = b % 1024, swz = sb ^ (((sb >> 9) & 1) << 5); R = (st >> 1) * 16 + swz / 64; C = (st & 1) * 32 + (swz % 64) / 2; }
__device__ __forceinline__ int perm32(int rho) { const int n = rho >> 4, i = rho & 15; return 8 * (i >> 2) + 4 * n + (i & 3); }
struct Unit { int pm, pn; };
struct Gemm { const bf16_t* A; const bf16_t* Bt; int M, N, K; };
struct StaticOrder {
    int nM, nN, nwg, G, c;
    __device__ void init(int M, int N, int G_, int c_) { nM = M / BM; nN = N / BM; nwg = nM * nN; G = G_; c = c_; }
    __device__ bool next(int i, Unit& u) const {
        const long L = (long)i * G + c; if (L >= nwg) return false;
        int wgid = (int)L; { const int q = nwg / NXCD, r = nwg % NXCD, xcd = wgid % NXCD, off = wgid / NXCD; wgid = (xcd < r ? xcd * (q + 1) : r * (q + 1) + (xcd - r) * q) + off; }
        const int nig = WGM * nN, gid = wgid / nig, fm = gid * WGM, gsz = (nM - fm) < WGM ? (nM - fm) : WGM;
        u.pm = fm + ((wgid % nig) % gsz); u.pn = (wgid % nig) / gsz; return true;
    }
    __device__ __forceinline__ void a_ready(const Unit&) const {}
    __device__ __forceinline__ void done(const Unit&) const {}
};
struct EpiBf16 {
    static constexpr bool PERM = true, AFTER_DRAIN = false;
    bf16_t* O; int ldc;
    __device__ __forceinline__ void operator()(const f32x4 (&acc)[2][2][4][2], const Unit& u, int wr, int wc, int fr, int fq) const {
        const int row0 = u.pm * BM + wr * 64 + fr; const int col0 = u.pn * BM + wc * 32 + 8 * fq;
#pragma unroll
        for (int ai = 0; ai < 2; ++ai)
#pragma unroll
            for (int m = 0; m < 4; ++m) { bf16_t* rowp = O + (size_t)(row0 + ai * HALF + m * 16) * ldc + col0;
#pragma unroll
                for (int bj = 0; bj < 2; ++bj) { f32x4 v0 = acc[ai][bj][m][0], v1 = acc[ai][bj][m][1];
                    u32x4 w; w.x = cvt_pk_bf16(v0[0], v0[1]); w.y = cvt_pk_bf16(v0[2], v0[3]); w.z = cvt_pk_bf16(v1[0], v1[1]); w.w = cvt_pk_bf16(v1[2], v1[3]);
                    *(u32x4*)(rowp + bj * HALF) = w; } }
    }
};
struct EpiRes {
    static constexpr bool PERM = false, AFTER_DRAIN = true;
    bf16_t* X; const float* mod; int goff;
    bf16_t* An; const float* gnext; int scoff, shoff; unsigned long long* slots; unsigned tag; int fin; float* Y; unsigned* bar;
    __device__ __forceinline__ void fused(f32x4 (&acc)[2][2][4][2], const Unit& u, int wr, int wc, int fr, int fq, LAS unsigned char* lds) const {
        const int row0 = u.pm * BM + wr * 64 + fr, col0 = u.pn * BM + wc * 32 + 4 * fq;
        const int cond = u.pm < 32 ? 0 : (u.pm < 48 ? 1 : 2);
        const float* gp = mod + cond * 24576 + goff + col0;
        f32x4 gv[2][2];
#pragma unroll
        for (int bj = 0; bj < 2; ++bj)
#pragma unroll
            for (int n = 0; n < 2; ++n) gv[bj][n] = *(const f32x4*)(gp + bj * HALF + n * 16);
        float ss[2][4];
#pragma unroll
        for (int ai = 0; ai < 2; ++ai)
#pragma unroll
            for (int m = 0; m < 4; ++m) { bf16_t* rowp = X + (size_t)(row0 + ai * HALF + m * 16) * DM + col0; float t = 0.f;
#pragma unroll
                for (int bj = 0; bj < 2; ++bj)
#pragma unroll
                    for (int n = 0; n < 2; ++n) { u32x2* p = (u32x2*)(rowp + bj * HALF + n * 16); const u32x2 w = *p; f32x4 v = (f32x4){bflo(w.x), bfhi(w.x), bflo(w.y), bfhi(w.y)}; v += gv[bj][n] * acc[ai][bj][m][n];
                        if (!fin) *p = (u32x2){cvt_pk_bf16(v[0], v[1]), cvt_pk_bf16(v[2], v[3])}; acc[ai][bj][m][n] = v; t += v[0] * v[0] + v[1] * v[1] + v[2] * v[2] + v[3] * v[3]; }
                ss[ai][m] = t; }
        if (An == nullptr && !fin) return;
        LAS float* xl = (LAS float*)lds;
#pragma unroll
        for (int ai = 0; ai < 2; ++ai)
#pragma unroll
            for (int m = 0; m < 4; ++m) { float t = ss[ai][m]; t += shfl_xor_f(t, 16); t += shfl_xor_f(t, 32); if (fq == 0) xl[(ai * HALF + wr * 64 + m * 16 + fr) * 4 + wc] = t; }
        __syncthreads();
        const int tid = otid();
        if (tid < 256) {
            const f32x4 q = *(const LAS f32x4*)(xl + tid * 4); const float mine = q[0] + q[1] + q[2] + q[3];
            unsigned long long* sp = slots + ((size_t)u.pm * 4) * 256 + tid;
            (void)__hip_atomic_exchange(sp + (size_t)u.pn * 256, ((unsigned long long)tag << 32) | (unsigned long long)__float_as_uint(mine), __ATOMIC_RELAXED, __HIP_MEMORY_SCOPE_AGENT);
            float tot = mine;
#pragma unroll
            for (int k = 1; k < 4; ++k) { unsigned long long* o = sp + (size_t)((u.pn + k) & 3) * 256; unsigned long long v; unsigned spin = 0;
                for (;;) { v = __hip_atomic_load(o, __ATOMIC_RELAXED, __HIP_MEMORY_SCOPE_AGENT); if ((unsigned)(v >> 32) == tag) break; __builtin_amdgcn_s_sleep(1); if (++spin > (1u << 22)) break; }
                tot += __uint_as_float((unsigned)v); }
            xl[1024 + tid] = rsqrtf(tot * (1.0f / 1024.0f) + 1e-6f);
        }
        __syncthreads();
        if (fin) {
            xcd_barrier(bar, (volatile LAS unsigned*)(lds + LDS_BYTES - 16));
#pragma unroll
            for (int ai = 0; ai < 2; ++ai)
#pragma unroll
                for (int m = 0; m < 4; ++m) { const int rl = ai * HALF + wr * 64 + m * 16 + fr; const float rs = xl[1024 + rl]; float* rowp = Y + (size_t)(u.pm * BM + rl) * DM + col0;
#pragma unroll
                    for (int bj = 0; bj < 2; ++bj)
#pragma unroll
                        for (int n = 0; n < 2; ++n) { const f32x4 g4 = *(const f32x4*)(gnext + col0 + bj * HALF + n * 16); *(f32x4*)(rowp + bj * HALF + n * 16) = acc[ai][bj][m][n] * rs * g4; } }
            return;
        }
        f32x4 Gn[2][2], Sh[2][2];
#pragma unroll
        for (int bj = 0; bj < 2; ++bj)
#pragma unroll
            for (int n = 0; n < 2; ++n) { const int c = col0 + bj * HALF + n * 16; const f32x4 g4 = *(const f32x4*)(gnext + c), s4 = *(const f32x4*)(mod + cond * 24576 + scoff + c);
                Gn[bj][n] = g4 * (s4 + 1.0f); Sh[bj][n] = *(const f32x4*)(mod + cond * 24576 + shoff + c); }
#pragma unroll
        for (int ai = 0; ai < 2; ++ai)
#pragma unroll
            for (int m = 0; m < 4; ++m) { const int rl = ai * HALF + wr * 64 + m * 16 + fr; const int row = u.pm * BM + rl; const float rs = xl[1024 + rl];
                bf16_t* op = An + (size_t)row * DM + col0;
#pragma unroll
                for (int bj = 0; bj < 2; ++bj)
#pragma unroll
                    for (int n = 0; n < 2; ++n) { const f32x4 h = acc[ai][bj][m][n] * rs * Gn[bj][n] + Sh[bj][n];
                        *(u32x2*)(op + bj * HALF + n * 16) = (u32x2){cvt_pk_bf16(h[0], h[1]), cvt_pk_bf16(h[2], h[3])}; } }
    }
};

template <class Epi, class Sched>
__device__ __forceinline__ void gemm_phase(LAS unsigned char* lds, const Gemm g, const Sched& S, const Epi& E) {
    const int tid = otid(), wid = __builtin_amdgcn_readfirstlane(tid >> 6), lane = tid & 63, wr = wid >> 2, wc = wid & 3, fr = lane & 15, fq = lane >> 4;
    const int K = g.K, nt = K / BK;
    unsigned voffA[2], voffB[2];
#pragma unroll
    for (int i = 0; i < 2; ++i) { int R, C; stage_rc(tid * 16 + i * 8192, R, C); const int Rb = Epi::PERM ? ((R & ~31) + perm32(R & 31)) : R;
        voffA[i] = (unsigned)(R * K + C) * 2u; voffB[i] = (unsigned)(Rb * K + C) * 2u; }
    const size_t kstep = (size_t)(BK * 2);
    const size_t hstep = (size_t)HALF * K * 2;
    const size_t tstep = 2 * hstep;
    const unsigned ldsw = (unsigned)wid * 1024u;
    const int aoff = lds_byte(wr * 64 + fr, fq * 8), boff = lds_byte(wc * 32 + fr, fq * 8);
#define PG8_SA(b, h) (((b) * 2 + (h)) * HTB)
#define PG8_SB(b, h) ((4 + (b) * 2 + (h)) * HTB)
#define PG8_STAGE(bufoff, gbase, voff) do { _Pragma("unroll") for (int _i = 0; _i < 2; ++_i) \
        __builtin_amdgcn_global_load_lds((const unsigned*)((const char*)(gbase) + (voff)[_i]), (LAS unsigned*)(lds + (bufoff) + ldsw + _i * 8192), 16, 0, 0); } while (0)
#define PG8_LDA(dst, b, h) do { _Pragma("unroll") for (int m = 0; m < 4; ++m) _Pragma("unroll") for (int k = 0; k < 2; ++k) dst[m][k] = *(const LAS bf16x8*)(lds + PG8_SA(b, h) + aoff + m * 2048 + k * 1024); } while (0)
#define PG8_LDB(dst, b, h) do { _Pragma("unroll") for (int n = 0; n < 2; ++n) _Pragma("unroll") for (int k = 0; k < 2; ++k) dst[n][k] = *(const LAS bf16x8*)(lds + PG8_SB(b, h) + boff + n * 2048 + k * 1024); } while (0)
#define PG8_MMA(ai, bj, At, Bt) do { __builtin_amdgcn_s_setprio(1); _Pragma("unroll") for (int m = 0; m < 4; ++m) _Pragma("unroll") for (int n = 0; n < 2; ++n) _Pragma("unroll") for (int k = 0; k < 2; ++k) \
        acc[ai][bj][m][n] = __builtin_amdgcn_mfma_f32_16x16x32_bf16(Bt[n][k], At[m][k], acc[ai][bj][m][n], 0, 0, 0); __builtin_amdgcn_s_setprio(0); } while (0)
#define PG8_WAIT_V(n) asm volatile("s_waitcnt vmcnt(" #n ")" ::: "memory")
#define PG8_WAIT_L(n) asm volatile("s_waitcnt lgkmcnt(" #n ")" ::: "memory")
#define PG8_BAR __builtin_amdgcn_s_barrier()
#define PG8_SCHED __builtin_amdgcn_sched_barrier(0)
    Unit cur, nxt; int ui = 0;
    if (!S.next(0, cur)) return;
    f32x4 acc[2][2][4][2];
#pragma unroll
    for (int a = 0; a < 2; ++a)
#pragma unroll
        for (int b = 0; b < 2; ++b)
#pragma unroll
            for (int m = 0; m < 4; ++m)
#pragma unroll
                for (int n = 0; n < 2; ++n) acc[a][b][m][n] = (f32x4){0.f, 0.f, 0.f, 0.f};
    bf16x8 At[4][2], B0[2][2], B1[2][2];
    const char* cA = (const char*)g.A + (size_t)cur.pm * tstep; const char* cB = (const char*)g.Bt + (size_t)cur.pn * tstep;
    S.a_ready(cur);
    PG8_STAGE(PG8_SB(0, 0), cB, voffB); PG8_STAGE(PG8_SA(0, 0), cA, voffA); PG8_STAGE(PG8_SB(0, 1), cB + hstep, voffB); PG8_STAGE(PG8_SA(0, 1), cA + hstep, voffA);
    if (wr == 1) PG8_BAR;
    PG8_WAIT_V(4); PG8_BAR;
    PG8_STAGE(PG8_SB(1, 0), cB + kstep, voffB); PG8_STAGE(PG8_SA(1, 0), cA + kstep, voffA); PG8_STAGE(PG8_SB(1, 1), cB + hstep + kstep, voffB);
    PG8_WAIT_V(6); PG8_BAR;
    for (;;) {
        const bool has_next = S.next(ui + 1, nxt);
        const char* nA = has_next ? (const char*)g.A + (size_t)nxt.pm * tstep : cA; const char* nB = has_next ? (const char*)g.Bt + (size_t)nxt.pn * tstep : cB;
        for (int t = 0; t < nt; t += 2) {
            const bool last = (t == nt - 2);
            const char* a1 = cA + (size_t)(t + 1) * kstep;
            const char* a2 = last ? nA : cA + (size_t)(t + 2) * kstep; const char* b2 = last ? nB : cB + (size_t)(t + 2) * kstep;
            const char* a3 = a2 + kstep; const char* b3 = b2 + kstep;
            if (last && has_next) S.a_ready(nxt);
            PG8_LDB(B0, 0, 0); PG8_SCHED; PG8_LDA(At, 0, 0); PG8_STAGE(PG8_SA(1, 1), a1 + hstep, voffA);
            PG8_WAIT_L(8); PG8_BAR; PG8_WAIT_L(0); PG8_MMA(0, 0, At, B0); PG8_BAR; PG8_SCHED;
            PG8_LDB(B1, 0, 1); PG8_STAGE(PG8_SB(0, 0), b2, voffB);
            PG8_BAR; PG8_WAIT_L(0); PG8_MMA(0, 1, At, B1); PG8_BAR;
            PG8_LDA(At, 0, 1); PG8_STAGE(PG8_SA(0, 0), a2, voffA);
            PG8_BAR; PG8_WAIT_L(0); PG8_MMA(1, 0, At, B0); PG8_BAR; PG8_SCHED;
            PG8_STAGE(PG8_SB(0, 1), b2 + hstep, voffB);
            PG8_WAIT_V(6); PG8_BAR; PG8_MMA(1, 1, At, B1); PG8_BAR;
            PG8_LDB(B0, 1, 0); PG8_SCHED; PG8_LDA(At, 1, 0); PG8_STAGE(PG8_SA(0, 1), a2 + hstep, voffA);
            PG8_WAIT_L(8); PG8_BAR; PG8_WAIT_L(0); PG8_MMA(0, 0, At, B0); PG8_BAR; PG8_SCHED;
            PG8_LDB(B1, 1, 1); PG8_STAGE(PG8_SB(1, 0), b3, voffB);
            PG8_BAR; PG8_WAIT_L(0); PG8_MMA(0, 1, At, B1); PG8_BAR;
            PG8_LDA(At, 1, 1); PG8_STAGE(PG8_SA(1, 0), a3, voffA);
            PG8_BAR; PG8_WAIT_L(0); PG8_MMA(1, 0, At, B0); PG8_BAR; PG8_SCHED;
            PG8_STAGE(PG8_SB(1, 1), b3 + hstep, voffB);
            PG8_WAIT_V(6); PG8_BAR; PG8_MMA(1, 1, At, B1); PG8_BAR;
        }
        if constexpr (!Epi::AFTER_DRAIN) { E(acc, cur, wr, wc, fr, fq); S.done(cur); }
        if (!has_next) break;
#pragma unroll
        for (int a = 0; a < 2; ++a)
#pragma unroll
            for (int b = 0; b < 2; ++b)
#pragma unroll
                for (int m = 0; m < 4; ++m)
#pragma unroll
                    for (int n = 0; n < 2; ++n) acc[a][b][m][n] = (f32x4){0.f, 0.f, 0.f, 0.f};
        cur = nxt; cA = nA; cB = nB; ++ui;
    }
    PG8_WAIT_V(0);
    if (wr == 0) PG8_BAR;
    PG8_BAR;
    if constexpr (Epi::AFTER_DRAIN) { E.fused(acc, cur, wr, wc, fr, fq, lds); S.done(cur); }
#undef PG8_SA
#undef PG8_SB
#undef PG8_STAGE
#undef PG8_LDA
#undef PG8_LDB
#undef PG8_MMA
#undef PG8_WAIT_V
#undef PG8_WAIT_L
#undef PG8_BAR
#undef PG8_SCHED
}
}

template <bool P16 = false>
__device__ __forceinline__ void wconv_tile(const float* __restrict__ src, int N, bf16_t* __restrict__ dst, int ldd, int kt, int ntile, LAS float* tl) {
    const int tid = otid();
#pragma unroll
    for (int i = 0; i < 2; ++i) { const int k = (tid >> 4) + 32 * i, n4 = (tid & 15) * 4;
        const f32x4 v = *(const f32x4*)(src + (size_t)(kt * 64 + k) * N + ntile * 64 + n4);
        tl[k * 65 + n4] = v[0]; tl[k * 65 + n4 + 1] = v[1]; tl[k * 65 + n4 + 2] = v[2]; tl[k * 65 + n4 + 3] = v[3]; }
    __syncthreads();
    { const int n = tid >> 3, k8 = (tid & 7) * 8; u32x4 w;
      w.x = cvt_pk_bf16(tl[(k8 + 0) * 65 + n], tl[(k8 + 1) * 65 + n]); w.y = cvt_pk_bf16(tl[(k8 + 2) * 65 + n], tl[(k8 + 3) * 65 + n]);
      w.z = cvt_pk_bf16(tl[(k8 + 4) * 65 + n], tl[(k8 + 5) * 65 + n]); w.w = cvt_pk_bf16(tl[(k8 + 6) * 65 + n], tl[(k8 + 7) * 65 + n]);
      if (P16) { const int odd = (tid & 1); bf16_t* d = dst + (size_t)(ntile * 64 + n) * ldd + kt * 64;
          *(u32x2*)(d + (odd ? k8 - 4 : k8)) = (u32x2){w.x, w.y}; *(u32x2*)(d + (odd ? k8 + 4 : k8 + 8)) = (u32x2){w.z, w.w}; }
      else *(u32x4*)(dst + (size_t)(ntile * 64 + n) * ldd + kt * 64 + k8) = w; }
    __syncthreads();
}
__device__ void wconv(const float* src, int K, int N, bf16_t* dst, LAS unsigned char* lds, int& rot) {
    const int nk = K / 64, nn = N / 64, tot = nk * nn;
    int start = (int)blockIdx.x - rot; while (start < 0) start += gridDim.x;
    for (int it = start; it < tot; it += gridDim.x) wconv_tile(src, N, dst, K, it / nn, it % nn, (LAS float*)lds);
    rot = (rot + tot) % (int)gridDim.x;
}
template <int NQ, bool P16 = false>
__device__ __forceinline__ void vt_tile(const bf16_t* __restrict__ src, int ld, bf16_t* __restrict__ dst, size_t ldd, LAS bf16_t* tl) {
    const int tid = otid();
    { const int r = tid >> 3, c8 = (tid & 7) * 8; u32x4 v[NQ];
#pragma unroll
      for (int q = 0; q < NQ; ++q) v[q] = *(const u32x4*)(src + (size_t)r * ld + q * 64 + c8);
#pragma unroll
      for (int q = 0; q < NQ; ++q) *(LAS u32x4*)(tl + q * 4608 + r * 72 + c8) = v[q]; }
    __syncthreads();
    { const int c = tid >> 3, t8 = (tid & 7) * 8;
#pragma unroll
      for (int q = 0; q < NQ; ++q) { unsigned w[4];
#pragma unroll
          for (int j = 0; j < 4; ++j) w[j] = (unsigned)tl[q * 4608 + (t8 + 2 * j) * 72 + c] | ((unsigned)tl[q * 4608 + (t8 + 2 * j + 1) * 72 + c] << 16);
          if (P16) { const int odd = (tid & 1); bf16_t* d = dst + (size_t)(q * 64 + c) * ldd;
              *(u32x2*)(d + (odd ? t8 - 4 : t8)) = (u32x2){w[0], w[1]}; *(u32x2*)(d + (odd ? t8 + 4 : t8 + 8)) = (u32x2){w[2], w[3]}; }
          else *(u32x4*)(dst + (size_t)(q * 64 + c) * ldd + t8) = (u32x4){w[0], w[1], w[2], w[3]}; } }
    __syncthreads();
}
template <bool P16 = false>
__device__ void vt_all(const bf16_t* U, int ld, int vc0, int C, bf16_t* VtP, bf16_t* VtS, int LK, int koff, LAS unsigned char* lds) {
    const int nct = C / 256, tot = (NT / 64) * nct;
    for (int it = blockIdx.x; it < tot; it += gridDim.x) {
        const int tt = it / nct, ct = it % nct, t0 = tt * 64;
        const bf16_t* src = U + (size_t)t0 * ld + vc0 + ct * 256;
        if (t0 < NTP) { const int b = t0 >> 8, tp = t0 & 255; vt_tile<4, P16>(src, ld, VtP + ((size_t)b * C + ct * 256) * 256 + tp, 256, (LAS bf16_t*)lds); }
        else { const int ts = t0 - NTP, b = ts >> 12, tp = ts & 4095; vt_tile<4, P16>(src, ld, VtS + ((size_t)b * C + ct * 256) * LK + koff + tp, (size_t)LK, (LAS bf16_t*)lds); }
    }
}
__device__ void norm_mod(const bf16_t* __restrict__ X, const float* __restrict__ g, const float* __restrict__ mod, int scoff, int shoff, bf16_t* __restrict__ H) {
    const int lane = otid() & 63, gw = blockIdx.x * 8 + (otid() >> 6), nw = gridDim.x * 8;
    for (int r = gw; r < NT; r += nw) {
        const int cond = r < NTP ? 0 : (r < NTP + 4096 ? 1 : 2);
        const bf16_t* xr = X + (size_t)r * DM; const float* mp = mod + cond * 24576;
        f32x4 v[4]; float ss = 0.f;
#pragma unroll
        for (int i = 0; i < 4; ++i) { const u32x2 w = *(const u32x2*)(xr + i * 256 + lane * 4); v[i] = (f32x4){bflo(w.x), bfhi(w.x), bflo(w.y), bfhi(w.y)}; ss += v[i][0] * v[i][0] + v[i][1] * v[i][1] + v[i][2] * v[i][2] + v[i][3] * v[i][3]; }
        ss = wave_sum(ss); const float rs = rsqrtf(ss * (1.0f / DM) + 1e-6f);
#pragma unroll
        for (int i = 0; i < 4; ++i) { const int c = i * 256 + lane * 4; const f32x4 gg = *(const f32x4*)(g + c), sc = *(const f32x4*)(mp + scoff + c), sh = *(const f32x4*)(mp + shoff + c);
            float o[4];
#pragma unroll
            for (int j = 0; j < 4; ++j) o[j] = v[i][j] * rs * gg[j] * (1.0f + sc[j]) + sh[j];
            *(u32x2*)(H + (size_t)r * DM + c) = (u32x2){cvt_pk_bf16(o[0], o[1]), cvt_pk_bf16(o[2], o[3])}; }
    }
}
__device__ void final_norm(float* __restrict__ X, const float* __restrict__ g) {
    const int lane = otid() & 63, gw = blockIdx.x * 8 + (otid() >> 6), nw = gridDim.x * 8;
    for (int r = gw; r < NT; r += nw) {
        float* xr = X + (size_t)r * DM; f32x4 v[4]; float ss = 0.f;
#pragma unroll
        for (int i = 0; i < 4; ++i) { v[i] = *(const f32x4*)(xr + i * 256 + lane * 4); ss += v[i][0] * v[i][0] + v[i][1] * v[i][1] + v[i][2] * v[i][2] + v[i][3] * v[i][3]; }
        ss = wave_sum(ss); const float rs = rsqrtf(ss * (1.0f / DM) + 1e-6f);
#pragma unroll
        for (int i = 0; i < 4; ++i) { const int c = i * 256 + lane * 4; const f32x4 gg = *(const f32x4*)(g + c); f32x4 o;
#pragma unroll
            for (int j = 0; j < 4; ++j) o[j] = v[i][j] * rs * gg[j];
            *(f32x4*)(xr + c) = o; }
    }
}
__device__ void prep_misc(const Params& p, LAS unsigned char* lds) {
    const int tid = otid(); const size_t gt = (size_t)blockIdx.x * 512 + tid, ng = (size_t)gridDim.x * 512;
    { const f32x4* a = (const f32x4*)p.in[I_XP]; const f32x4* b = (const f32x4*)p.in[I_XS]; u32x2* o = (u32x2*)((unsigned char*)p.out + XR_OFF); const size_t n4 = (size_t)NTP * DM / 4;
      for (size_t i = gt; i < n4; i += ng) { const f32x4 va = a[i], vb = b[i]; o[i] = (u32x2){cvt_pk_bf16(va[0], va[1]), cvt_pk_bf16(va[2], va[3])}; o[n4 + i] = (u32x2){cvt_pk_bf16(vb[0], vb[1]), cvt_pk_bf16(vb[2], vb[3])}; } }
    { bf16_t* id = (bf16_t*)(p.ws + WS_IDENT); for (size_t i = gt; i < 65536; i += ng) id[i] = ((i >> 8) == (i & 255)) ? (bf16_t)0x3F80 : (bf16_t)0; }
    { bf16_t* idw = (bf16_t*)(p.ws + WS_IDENTW); for (size_t i = gt; i < 65536; i += ng) idw[(i >> 8) * 6144 + (i & 255)] = ((i >> 8) == (i & 255)) ? (bf16_t)0x3F80 : (bf16_t)0; }
    LAS float* sc = (LAS float*)lds;
    LAS float* red = sc + 3072;
    for (int i = tid; i < 3072; i += 512) { const int c = i >> 10, k = i & 1023; const float v = c == 0 ? p.in[I_CCTX][k] : p.in[I_C][(c - 1) * 1024 + k]; sc[i] = siluf(v); }
    __syncthreads();
    float* mod = (float*)(p.ws + WS_MOD);
    for (int it = blockIdx.x; it < 4 * 96; it += gridDim.x) {
        const int l = it / 96, n0 = (it % 96) * 64, col = tid & 63, kq = tid >> 6;
        const float* w = p.in[I_WMOD] + (size_t)l * 1024 * 6144 + n0 + col;
        float a0 = 0.f, a1 = 0.f, a2 = 0.f;
#pragma unroll 8
        for (int k = kq * 128; k < kq * 128 + 128; ++k) { const float wv = w[(size_t)k * 6144]; a0 += sc[k] * wv; a1 += sc[1024 + k] * wv; a2 += sc[2048 + k] * wv; }
        red[(kq * 3 + 0) * 64 + col] = a0; red[(kq * 3 + 1) * 64 + col] = a1; red[(kq * 3 + 2) * 64 + col] = a2;
        __syncthreads();
        if (tid < 192) { const int c = tid >> 6; float s = p.in[I_BMOD][l * 6144 + n0 + col];
#pragma unroll
            for (int q = 0; q < 8; ++q) s += red[(q * 3 + c) * 64 + col];
            mod[c * 24576 + l * 6144 + n0 + col] = s; }
        __syncthreads();
    }
}

struct RopeCS { float cs[8], sn[8]; };
__device__ __forceinline__ void rope_cs8(int lane, int tp, RopeCS& r) {
    const int k = lane & 7; const float pos = (float)((k < 4) ? (tp >> 6) : (tp & 63));
#pragma unroll
    for (int j = 0; j < 8; ++j) { const float ang = pos * fast_exp2(-(float)(8 * (k & 1) + j) * (13.287712379549449f / 16.0f)); r.cs[j] = cos_rr(ang); r.sn[j] = sin_rr(ang); }
}
__device__ __forceinline__ void rope8(float* x, int lane, const RopeCS& r) {
    const bool second = (lane & 2) != 0;
#pragma unroll
    for (int j = 0; j < 8; ++j) { const float pr = shfl_xor_f(x[j], 2); x[j] = second ? (pr * r.sn[j] + x[j] * r.cs[j]) : (x[j] * r.cs[j] - pr * r.sn[j]); }
}
__device__ __forceinline__ void unpack8(const u32x4 w, float* x) {
#pragma unroll
    for (int j = 0; j < 4; ++j) { x[2 * j] = bflo(w[j]); x[2 * j + 1] = bfhi(w[j]); }
}
__device__ __forceinline__ u32x4 pack8(const float* x) { return (u32x4){cvt_pk_bf16(x[0], x[1]), cvt_pk_bf16(x[2], x[3]), cvt_pk_bf16(x[4], x[5]), cvt_pk_bf16(x[6], x[7])}; }
__device__ __forceinline__ void rms8(float* x, const float* gn) {
    float ss = 0.f;
#pragma unroll
    for (int j = 0; j < 8; ++j) ss += x[j] * x[j];
    ss += shfl_xor_f(ss, 1); ss += shfl_xor_f(ss, 2); ss += shfl_xor_f(ss, 4);
    const float rs = rsqrtf(ss * (1.0f / 64.0f) + 1e-6f);
#pragma unroll
    for (int j = 0; j < 8; ++j) x[j] = x[j] * rs * gn[j];
}
__device__ void post_attn(const Params& p, bf16_t* U, bf16_t* KS, bf16_t* VtS) {
    const int lane = otid() & 63, gw = blockIdx.x * 8 + (otid() >> 6), nw = gridDim.x * 8;
    float qg[8], kg[8];
#pragma unroll
    for (int j = 0; j < 8; ++j) { qg[j] = p.in[I_AQG][(lane & 7) * 8 + j]; kg[j] = p.in[I_AKG][(lane & 7) * 8 + j]; }
    float* nak = p.out + OUT_NAK; float* nav = p.out + OUT_NAV;
    for (int t = gw; t < NT + 512; t += nw) {
        if (t < NT) {
            const bool smp = t >= NTP; const int ts = t - NTP; const int b = smp ? (ts >> 12) : (t >> 8), tp = smp ? (ts & 4095) : (t & 255);
            bf16_t* ur = U + (size_t)t * 1536 + lane * 8;
            const u32x4 w0 = *(const u32x4*)ur, w1 = *(const u32x4*)(ur + 512), w2 = *(const u32x4*)(ur + 1024);
            RopeCS rc; if (smp) rope_cs8(lane, tp, rc);
            float x[8];
            unpack8(w0, x); rms8(x, qg); if (smp) rope8(x, lane, rc); *(u32x4*)ur = pack8(x);
            unpack8(w1, x); rms8(x, qg); if (smp) rope8(x, lane, rc); *(u32x4*)(ur + 512) = pack8(x);
            unpack8(w2, x);
            float y[8];
#pragma unroll
            for (int j = 0; j < 8; ++j) y[j] = x[j];
            rms8(y, kg); if (smp) rope8(y, lane, rc);
            if (lane < 32) {
                if (!smp) { *(u32x4*)(ur + 1024) = pack8(y); float* o = nak + (size_t)t * 256 + lane * 8; *(f32x4*)o = (f32x4){y[0], y[1], y[2], y[3]}; *(f32x4*)(o + 4) = (f32x4){y[4], y[5], y[6], y[7]}; }
                else *(u32x4*)(KS + ((size_t)b * 4352 + 256 + tp) * 256 + lane * 8) = pack8(y);
            } else if (!smp) { float* o = nav + (size_t)t * 256 + (lane - 32) * 8; *(f32x4*)o = (f32x4){x[0], x[1], x[2], x[3]}; *(f32x4*)(o + 4) = (f32x4){x[4], x[5], x[6], x[7]}; }
        } else {
            const int ci = t - NT, b = ci >> 8, m = ci & 255;
            for (int kh = 0; kh < 4; ++kh) {
                const bf16_t kb16 = f2bf(p.in[I_CAK][((size_t)(b * 256 + m) * 4 + kh) * 64 + lane]);
                KS[((size_t)b * 4352 + m) * 256 + kh * 64 + lane] = kb16;
                const float kn = wave_sum(bf2f(kb16) * bf2f(kb16));
                if (lane == 0) atomicMax((unsigned*)(p.ws + WS_CKMAX), __float_as_uint(kn));
                VtS[((size_t)(b * 4 + kh) * 64 + lane) * 4352 + m] = f2bf(p.in[I_CAV][((size_t)(b * 256 + m) * 4 + kh) * 64 + lane]);
            }
        }
    }
}
__device__ __forceinline__ float subhead_maxsq(const float* x) {
    float ss = 0.f;
#pragma unroll
    for (int j = 0; j < 8; ++j) ss += x[j] * x[j];
    ss += shfl_xor_f(ss, 1); ss += shfl_xor_f(ss, 2); ss += shfl_xor_f(ss, 4);
    ss = fmaxf(ss, shfl_xor_f(ss, 8)); ss = fmaxf(ss, shfl_xor_f(ss, 16)); ss = fmaxf(ss, shfl_xor_f(ss, 32));
    return ss;
}
__device__ void post_diff(const Params& p, bf16_t* U, bf16_t* KS, bf16_t* VtS, LAS unsigned char* lds) {
    const int lane = otid() & 63, gw = blockIdx.x * 8 + (otid() >> 6), nw = gridDim.x * 8;
    float* ndk = p.out + OUT_NDK; float* ndv = p.out + OUT_NDV;
    float qrun = 0.f, krun = 0.f;
    for (int t = gw; t < NT + 512; t += nw) {
        if (t < NT) {
            const bool smp = t >= NTP; const int ts = t - NTP; const int b = smp ? (ts >> 12) : (t >> 8), tp = smp ? (ts & 4095) : (t & 255);
            bf16_t* ur = U + (size_t)t * 3072 + lane * 8;
            float qm = 0.f, km = 0.f;
            if (!smp) {
                u32x4 w[4], wq[2];
#pragma unroll
                for (int c = 0; c < 4; ++c) w[c] = *(const u32x4*)(ur + 1024 + c * 512);
                wq[0] = *(const u32x4*)ur; wq[1] = *(const u32x4*)(ur + 512);
#pragma unroll
                for (int c = 0; c < 4; ++c) { float x[8]; unpack8(w[c], x); float* o = (c < 2 ? ndk : ndv) + (size_t)t * 1024 + (c & 1) * 512 + lane * 8;
                    if (c < 2) km = fmaxf(km, subhead_maxsq(x));
                    *(f32x4*)o = (f32x4){x[0], x[1], x[2], x[3]}; *(f32x4*)(o + 4) = (f32x4){x[4], x[5], x[6], x[7]}; }
#pragma unroll
                for (int c = 0; c < 2; ++c) { float x[8]; unpack8(wq[c], x); qm = fmaxf(qm, subhead_maxsq(x)); }
            } else {
                u32x4 w[4];
#pragma unroll
                for (int c = 0; c < 4; ++c) w[c] = *(const u32x4*)(ur + c * 512);
                RopeCS rc; rope_cs8(lane, tp, rc);
#pragma unroll
                for (int c = 0; c < 4; ++c) { float x[8]; unpack8(w[c], x); const float m2 = subhead_maxsq(x); if (c < 2) qm = fmaxf(qm, m2); else km = fmaxf(km, m2); rope8(x, lane, rc);
                    if (c < 2) *(u32x4*)(ur + c * 512) = pack8(x); else *(u32x4*)(KS + ((size_t)b * 4352 + 256 + tp) * 1024 + (c - 2) * 512 + lane * 8) = pack8(x); }
            }
            qrun = fmaxf(qrun, qm); krun = fmaxf(krun, km);
        } else {
            const int ci = t - NT, b = ci >> 8, m = ci & 255;
            for (int j = 0; j < 16; ++j) { const int c = j * 64 + lane;
                const bf16_t kb16 = f2bf(p.in[I_CDK][(size_t)(b * 256 + m) * 1024 + c]); const float kn = wave_sum(bf2f(kb16) * bf2f(kb16));
                krun = fmaxf(krun, kn);
                KS[((size_t)b * 4352 + m) * 1024 + c] = kb16;
                VtS[((size_t)b * 1024 + c) * 4352 + m] = f2bf(p.in[I_CDV][(size_t)(b * 256 + m) * 1024 + c]); }
        }
    }
    { LAS float* red = (LAS float*)lds; const int wid = otid() >> 6;
      if (lane == 0) { red[wid] = qrun; red[8 + wid] = krun; }
      __syncthreads();
      if (otid() == 0) { float a = 0.f, b2 = 0.f;
          for (int i = 0; i < 8; ++i) { a = fmaxf(a, red[i]); b2 = fmaxf(b2, red[8 + i]); }
          atomicMax((unsigned*)(p.ws + WS_DQMAX), __float_as_uint(a)); atomicMax((unsigned*)(p.ws + WS_DQMAX) + 1, __float_as_uint(b2)); }
      __syncthreads(); }
}

struct FlashArgs {
    const bf16_t* q; int ldq;
    const bf16_t* k; int ldk;
    const bf16_t* vt; int ldvt;
    const bf16_t* ident;
    int nreal, ntiles, kcol;
    bf16_t* out; int ldo;
    float* outf;
    float qscale; float fixm;
    float lgf, lgb; int n0, L, dir, half;
    float lam, onem; const float* subg;
};

template <int DK, int DV, int MODE, bool FXC = false>
__device__ __forceinline__ void flash_item(LAS unsigned char* lds, const FlashArgs& a) {
    constexpr int KW = (MODE == 1) ? 2 * DK : DK, KLD = KW + 8, VLD = 72, KB = 64 * KLD * 2, VB = DV * VLD * 2, STG = KB + VB;
    constexpr int NKC = KW / 64, NVC = DV / 64, NS = DK / 16, ND = DV / 32;
    static_assert(2 * STG <= LDS_BYTES, "lds");
    const int tid = otid(), lane = tid & 63, lr = lane & 31, g = lane >> 5;
    bf16x8 qf[NS];
#pragma unroll
    for (int s = 0; s < NS; ++s) {
        u32x4 w = *(const u32x4*)(a.q + (size_t)lr * a.ldq + s * 16 + g * 8);
        if (MODE <= 1) {
#pragma unroll
            for (int j = 0; j < 4; ++j) w[j] = cvt_pk_bf16(bflo(w[j]) * a.qscale, bfhi(w[j]) * a.qscale);
        }
        qf[s] = __builtin_bit_cast(bf16x8, w);
    }
    f32x16 O[ND];
#pragma unroll
    for (int d = 0; d < ND; ++d)
#pragma unroll
        for (int r = 0; r < 16; ++r) O[d][r] = 0.f;
    float m_run = -1e30f, l_run = 0.f;
    if constexpr (MODE >= 2) {
        static_assert(DK == 256 && DV == 128, "ret path shapes");
        constexpr int KB2 = 64 * 512, VB2 = 256 * 128, STG2 = KB2 + VB2;
        static_assert(2 * STG2 + 16384 <= LDS_BYTES - 16, "ret lds");
        const int wid_u = __builtin_amdgcn_readfirstlane(tid >> 6);
        const int nt = a.ntiles;
        unsigned koff[4], voff[4];
#pragma unroll
        for (int i = 0; i < 4; ++i) { const int blk = wid_u * 4 + i;
            { const int row = 2 * blk + (lane >> 5), pos = lane & 31, c = pos ^ (row & 31); koff[i] = (unsigned)(row * a.ldk + c * 8) * 2u; }
            { const int row = 8 * blk + (lane >> 3), pos = lane & 7, c = pos ^ ((row >> 1) & 7); voff[i] = (unsigned)(row * a.ldvt + c * 8) * 2u; } }
        auto dma = [&](int t, int buf) {
            const char* kbase = (t * 64 >= a.nreal) ? (const char*)a.ident + (size_t)((t * 64 - a.nreal) & 255) * a.ldk * 2 : (const char*)a.k + (size_t)t * 64 * a.ldk * 2;
            const char* vbase = (const char*)a.vt + (size_t)t * 128;
            LAS unsigned char* base = lds + buf * STG2;
#pragma unroll
            for (int i = 0; i < 4; ++i) __builtin_amdgcn_global_load_lds((const unsigned*)(kbase + koff[i]), (LAS unsigned*)(base + (wid_u * 4 + i) * 1024), 16, 0, 0);
#pragma unroll
            for (int i = 0; i < 4; ++i) __builtin_amdgcn_global_load_lds((const unsigned*)(vbase + voff[i]), (LAS unsigned*)(base + KB2 + (wid_u * 4 + i) * 1024), 16, 0, 0);
        };
        auto unif = [](float v) { return __int_as_float(__builtin_amdgcn_readfirstlane(__float_as_int(v))); };
        const float f1 = unif(fast_exp2(-a.lgf)), f2 = unif(f1 * f1), f3 = unif(f2 * f1), f8 = unif(fast_exp2(-8.0f * a.lgf));
        const float b1 = unif(fast_exp2(a.lgb)), b2 = unif(b1 * b1), b3 = unif(b2 * b1), b8 = unif(fast_exp2(8.0f * a.lgb));
        LAS unsigned char* pbuf = lds + 2 * STG2;
        auto compute2 = [&](int t) {
            const LAS unsigned char* kb = lds + (t & 1) * STG2; const LAS unsigned char* vb = kb + KB2;
            const int n = a.n0 + lr, m0 = t * 64, half = a.half;
            const unsigned ka0 = (unsigned)(size_t)(kb + (half * 32 + lr) * 512) + (unsigned)((g ^ lr) << 4);
            auto kfrag = [&](int s_) { return *(const LAS bf16x8*)(size_t)(ka0 ^ (unsigned)(s_ << 5)); };
            f32x16 S;
#pragma unroll
            for (int r = 0; r < 16; ++r) S[r] = 0.f;
            bf16x8 ka[2], kc[2];
            ka[0] = kfrag(0); ka[1] = kfrag(1);
#pragma unroll
            for (int grp = 0; grp < 8; ++grp) {
                if (grp < 7) { if (grp & 1) { ka[0] = kfrag(2 * grp + 2); ka[1] = kfrag(2 * grp + 3); } else { kc[0] = kfrag(2 * grp + 2); kc[1] = kfrag(2 * grp + 3); } }
                __builtin_amdgcn_sched_barrier(0);
                if (grp & 1) { S = __builtin_amdgcn_mfma_f32_32x32x16_bf16(kc[0], qf[2 * grp], S, 0, 0, 0); S = __builtin_amdgcn_mfma_f32_32x32x16_bf16(kc[1], qf[2 * grp + 1], S, 0, 0, 0); }
                else { S = __builtin_amdgcn_mfma_f32_32x32x16_bf16(ka[0], qf[2 * grp], S, 0, 0, 0); S = __builtin_amdgcn_mfma_f32_32x32x16_bf16(ka[1], qf[2 * grp + 1], S, 0, 0, 0); }
                __builtin_amdgcn_sched_barrier(0);
            }
            const int mb = m0 + half * 32;
            if (MODE == 2) {
                if (m0 < a.nreal) {
                    if (mb + 31 < a.n0) {
                        float c4 = 0.0625f * fast_exp2((float)(n - mb - 4 * g) * a.lgf);
#pragma unroll
                        for (int q4 = 0; q4 < 4; ++q4) { S[4 * q4] *= c4; S[4 * q4 + 1] *= c4 * f1; S[4 * q4 + 2] *= c4 * f2; S[4 * q4 + 3] *= c4 * f3; c4 *= f8; }
                    } else if (mb > a.n0 + 31) {
                        float c4 = 0.0625f * fast_exp2((float)(mb + 4 * g - n) * a.lgb);
#pragma unroll
                        for (int q4 = 0; q4 < 4; ++q4) { S[4 * q4] *= c4; S[4 * q4 + 1] *= c4 * b1; S[4 * q4 + 2] *= c4 * b2; S[4 * q4 + 3] *= c4 * b3; c4 *= b8; }
                    } else {
#pragma unroll
                        for (int r = 0; r < 16; ++r) { const int m = mb + 8 * (r >> 2) + 4 * g + (r & 3); const int df = n - m;
                            const float e = df > 0 ? (float)df * a.lgf : (float)(-df) * a.lgb; float f = fast_exp2(e) * 0.0625f; if (df == 0) f = 0.125f; S[r] *= f; }
                    }
                } else {
                    const float f = ((m0 - a.nreal) < 256) ? fast_exp2((float)(n + 1) * a.lgf) : fast_exp2((float)(a.L - n) * a.lgb);
#pragma unroll
                    for (int r = 0; r < 16; ++r) S[r] *= f;
                }
            } else {
#pragma unroll
                for (int r = 0; r < 16; ++r) { const int m = mb + 8 * (r >> 2) + 4 * g + (r & 3);
                    const float e = a.dir == 0 ? (float)(a.L - 1 - m) * a.lgf : (float)m * a.lgb; S[r] *= fast_exp2(e) * 0.0625f; }
            }
            u32x4 pw0, pw1;
            pw0.x = cvt_pk_bf16(S[0], S[1]); pw0.y = cvt_pk_bf16(S[2], S[3]); pw0.z = cvt_pk_bf16(S[4], S[5]); pw0.w = cvt_pk_bf16(S[6], S[7]);
            pw1.x = cvt_pk_bf16(S[8], S[9]); pw1.y = cvt_pk_bf16(S[10], S[11]); pw1.z = cvt_pk_bf16(S[12], S[13]); pw1.w = cvt_pk_bf16(S[14], S[15]);
            { LAS unsigned char* pb = pbuf + wid_u * 2048 + lane * 16; *(LAS u32x4*)pb = pw0; *(LAS u32x4*)(pb + 1024) = pw1; }
            u32x4 vf[ND];
            auto vload = [&](int kk) {
#pragma unroll
                for (int d = 0; d < ND; ++d) { const unsigned va0 = ((unsigned)(size_t)(vb + (half * 128 + lr) * 128) + (unsigned)((g ^ ((lr >> 1) & 7)) << 4)) ^ (unsigned)(kk << 5);
                    vf[d] = *(const LAS u32x4*)(size_t)(va0 + d * 4096); }
            };
            auto pv = [&](const u32x4 pw) { const bf16x8 pf = __builtin_bit_cast(bf16x8, pw);
#pragma unroll
                for (int d = 0; d < ND; ++d) O[d] = __builtin_amdgcn_mfma_f32_32x32x16_bf16(__builtin_bit_cast(bf16x8, vf[d]), pf, O[d], 0, 0, 0); };
            vload(2 * half); pv(pw0);
            vload(2 * half + 1); pv(pw1);
            asm volatile("s_waitcnt lgkmcnt(0)" ::: "memory"); __builtin_amdgcn_s_barrier(); asm volatile("" ::: "memory");
            const LAS unsigned char* pp = pbuf + (wid_u ^ 4) * 2048 + lane * 16;
            { const u32x4 q0 = *(const LAS u32x4*)pp; vload(2 * (1 - half)); pv(q0); }
            { const u32x4 q1 = *(const LAS u32x4*)(pp + 1024); vload(2 * (1 - half) + 1); pv(q1); }
        };
        dma(0, 0);
        asm volatile("s_waitcnt vmcnt(0)" ::: "memory"); __syncthreads();
        for (int t = 0; t < nt; ++t) {
            if (t + 1 < nt) dma(t + 1, (t + 1) & 1);
            compute2(t);
            asm volatile("s_waitcnt vmcnt(0)" ::: "memory"); __syncthreads();
        }
    } else {
    constexpr bool PF2 = (MODE == 0);
    u32x4 kreg[NKC], vreg[NVC], kreg2[PF2 ? NKC : 1], vreg2[PF2 ? NVC : 1];
    auto gload = [&](int t, u32x4* kr, u32x4* vr) {
        const bf16_t* kp; int ldk;
        if (MODE >= 2 && t * 64 >= a.nreal) { kp = a.ident + (size_t)((t * 64 - a.nreal) & 255) * 256; ldk = 256; } else { kp = a.k + (size_t)t * 64 * a.ldk; ldk = a.ldk; }
#pragma unroll
        for (int i = 0; i < NKC; ++i) { const int c = tid + i * 512, row = c / (KW / 8), cc = c % (KW / 8); kr[i] = *(const u32x4*)(kp + (size_t)row * ldk + cc * 8); }
#pragma unroll
        for (int i = 0; i < NVC; ++i) { const int c = tid + i * 512, d = c >> 3, cc = c & 7; vr[i] = *(const u32x4*)(a.vt + (size_t)d * a.ldvt + t * 64 + cc * 8); }
    };
    auto sstore = [&](int buf, const u32x4* kr, const u32x4* vr) {
        LAS unsigned char* base = lds + buf * STG;
#pragma unroll
        for (int i = 0; i < NKC; ++i) { const int c = tid + i * 512, row = c / (KW / 8), cc = c % (KW / 8); *(LAS u32x4*)(base + (row * KLD + cc * 8) * 2) = kr[i]; }
#pragma unroll
        for (int i = 0; i < NVC; ++i) { const int c = tid + i * 512, d = c >> 3, cc = c & 7; *(LAS u32x4*)(base + KB + (d * VLD + cc * 8) * 2) = vr[i]; }
    };
    gload(0, kreg, vreg); sstore(0, kreg, vreg); __syncthreads();
    const int nt = a.ntiles;
    auto compute = [&](int t) {
        LAS unsigned char* kb = lds + (t & 1) * STG; LAS unsigned char* vb = kb + KB;
        f32x16 S[2];
        if constexpr (MODE <= 1) {
            bf16x8 kf[2][NS];
#pragma unroll
            for (int ks = 0; ks < 2; ++ks)
#pragma unroll
                for (int s = 0; s < NS; ++s) kf[ks][s] = *(const LAS bf16x8*)(kb + ((ks * 32 + lr) * KLD + a.kcol + s * 16 + g * 8) * 2);
            u32x4 vf[2][ND];
            auto vload = [&](int kk, u32x4* dst) {
#pragma unroll
                for (int d = 0; d < ND; ++d) { const LAS unsigned char* vp = vb + ((d * 32 + lr) * VLD + kk * 16 + 4 * g) * 2;
                    const u32x2 v0 = *(const LAS u32x2*)vp, v1 = *(const LAS u32x2*)(vp + 16); dst[d] = (u32x4){v0.x, v0.y, v1.x, v1.y}; }
            };
            vload(0, vf[0]);
            __builtin_amdgcn_sched_barrier(0);
            constexpr bool fx = FXC;
#pragma unroll
            for (int r = 0; r < 16; ++r) { S[0][r] = fx ? -a.fixm : 0.f; S[1][r] = fx ? -a.fixm : 0.f; }
#pragma unroll
            for (int s = 0; s < NS; ++s) { S[0] = __builtin_amdgcn_mfma_f32_32x32x16_bf16(kf[0][s], qf[s], S[0], 0, 0, 0); S[1] = __builtin_amdgcn_mfma_f32_32x32x16_bf16(kf[1][s], qf[s], S[1], 0, 0, 0); }
            if (fx) {
                float ls = 0.f;
#pragma unroll
                for (int ks = 0; ks < 2; ++ks)
#pragma unroll
                    for (int r = 0; r < 16; ++r) { const float pv = fast_exp2(S[ks][r]); S[ks][r] = pv; ls += pv; }
                l_run += ls;
            } else {
                float mx = S[0][0];
#pragma unroll
                for (int ks = 0; ks < 2; ++ks)
#pragma unroll
                    for (int r = 0; r < 16; ++r) mx = fmaxf(mx, S[ks][r]);
                mx = fmaxf(mx, shfl_xor_f(mx, 32));
                const float mn = fmaxf(m_run, mx), alpha = fast_exp2(m_run - mn); m_run = mn;
                float ls = 0.f;
#pragma unroll
                for (int ks = 0; ks < 2; ++ks)
#pragma unroll
                    for (int r = 0; r < 16; ++r) { const float pv = fast_exp2(S[ks][r] - mn); S[ks][r] = pv; ls += pv; }
                l_run = l_run * alpha + ls;
#pragma unroll
                for (int d = 0; d < ND; ++d)
#pragma unroll
                    for (int r = 0; r < 16; ++r) O[d][r] *= alpha;
            }
#pragma unroll
            for (int kk = 0; kk < 4; ++kk) {
                if (kk < 3) vload(kk + 1, vf[(kk + 1) & 1]);
                __builtin_amdgcn_sched_barrier(0);
                const int ks = kk >> 1, rb = (kk & 1) * 8;
                u32x4 pw; pw.x = cvt_pk_bf16(S[ks][rb + 0], S[ks][rb + 1]); pw.y = cvt_pk_bf16(S[ks][rb + 2], S[ks][rb + 3]); pw.z = cvt_pk_bf16(S[ks][rb + 4], S[ks][rb + 5]); pw.w = cvt_pk_bf16(S[ks][rb + 6], S[ks][rb + 7]);
                const bf16x8 pf = __builtin_bit_cast(bf16x8, pw);
#pragma unroll
                for (int d = 0; d < ND; ++d) O[d] = __builtin_amdgcn_mfma_f32_32x32x16_bf16(__builtin_bit_cast(bf16x8, vf[kk & 1][d]), pf, O[d], 0, 0, 0);
            }
            return;
        }
#pragma unroll
        for (int ks = 0; ks < 2; ++ks) {
            if (MODE >= 2 && ks == 1) __builtin_amdgcn_sched_barrier(0);
#pragma unroll
            for (int r = 0; r < 16; ++r) S[ks][r] = 0.f;
#pragma unroll
            for (int s = 0; s < NS; ++s) {
                const bf16x8 af = *(const LAS bf16x8*)(kb + ((ks * 32 + lr) * KLD + a.kcol + s * 16 + g * 8) * 2);
                S[ks] = __builtin_amdgcn_mfma_f32_32x32x16_bf16(af, qf[s], S[ks], 0, 0, 0);
            }
            if (MODE == 2) {
                const int n = a.n0 + lr;
                if (t * 64 < a.nreal) {
#pragma unroll
                    for (int r = 0; r < 16; ++r) { const int m = t * 64 + ks * 32 + 8 * (r >> 2) + 4 * g + (r & 3); const int df = n - m;
                        const float e = df > 0 ? (float)df * a.lgf : (float)(-df) * a.lgb; float f = fast_exp2(e) * 0.0625f; if (df == 0) f = 0.125f; S[ks][r] *= f; }
                } else {
                    const float f = ((t * 64 - a.nreal) < 256) ? fast_exp2((float)(n + 1) * a.lgf) : fast_exp2((float)(a.L - n) * a.lgb);
#pragma unroll
                    for (int r = 0; r < 16; ++r) S[ks][r] *= f;
                }
            } else if (MODE == 3) {
#pragma unroll
                for (int r = 0; r < 16; ++r) { const int m = t * 64 + ks * 32 + 8 * (r >> 2) + 4 * g + (r & 3);
                    const float e = a.dir == 0 ? (float)(a.L - 1 - m) * a.lgf : (float)m * a.lgb; S[ks][r] *= fast_exp2(e) * 0.0625f; }
            }
            if (MODE >= 2) {
#pragma unroll
                for (int k2 = 0; k2 < 2; ++k2) {
                    const int kk = ks * 2 + k2, rb = k2 * 8;
                    u32x4 pw; pw.x = cvt_pk_bf16(S[ks][rb + 0], S[ks][rb + 1]); pw.y = cvt_pk_bf16(S[ks][rb + 2], S[ks][rb + 3]); pw.z = cvt_pk_bf16(S[ks][rb + 4], S[ks][rb + 5]); pw.w = cvt_pk_bf16(S[ks][rb + 6], S[ks][rb + 7]);
                    const bf16x8 pf = __builtin_bit_cast(bf16x8, pw);
#pragma unroll
                    for (int d = 0; d < ND; ++d) {
                        const LAS unsigned char* vp = vb + ((d * 32 + lr) * VLD + kk * 16 + 4 * g) * 2;
                        const u32x2 v0 = *(const LAS u32x2*)vp, v1 = *(const LAS u32x2*)(vp + 16);
                        const bf16x8 vf = __builtin_bit_cast(bf16x8, (u32x4){v0.x, v0.y, v1.x, v1.y});
                        O[d] = __builtin_amdgcn_mfma_f32_32x32x16_bf16(vf, pf, O[d], 0, 0, 0);
                    }
                }
            }
        }
        if (MODE <= 1) {
            float mx = S[0][0];
#pragma unroll
            for (int ks = 0; ks < 2; ++ks)
#pragma unroll
                for (int r = 0; r < 16; ++r) mx = fmaxf(mx, S[ks][r]);
            mx = fmaxf(mx, shfl_xor_f(mx, 32));
            const float mn = fmaxf(m_run, mx), alpha = fast_exp2(m_run - mn); m_run = mn;
            float ls = 0.f;
#pragma unroll
            for (int ks = 0; ks < 2; ++ks)
#pragma unroll
                for (int r = 0; r < 16; ++r) { const float pv = fast_exp2(S[ks][r] - mn); S[ks][r] = pv; ls += pv; }
            l_run = l_run * alpha + ls;
#pragma unroll
            for (int d = 0; d < ND; ++d)
#pragma unroll
                for (int r = 0; r < 16; ++r) O[d][r] *= alpha;
#pragma unroll
            for (int kk = 0; kk < 4; ++kk) {
                const int ks = kk >> 1, rb = (kk & 1) * 8;
                u32x4 pw; pw.x = cvt_pk_bf16(S[ks][rb + 0], S[ks][rb + 1]); pw.y = cvt_pk_bf16(S[ks][rb + 2], S[ks][rb + 3]); pw.z = cvt_pk_bf16(S[ks][rb + 4], S[ks][rb + 5]); pw.w = cvt_pk_bf16(S[ks][rb + 6], S[ks][rb + 7]);
                const bf16x8 pf = __builtin_bit_cast(bf16x8, pw);
#pragma unroll
                for (int d = 0; d < ND; ++d) {
                    const LAS unsigned char* vp = vb + ((d * 32 + lr) * VLD + kk * 16 + 4 * g) * 2;
                    const u32x2 v0 = *(const LAS u32x2*)vp, v1 = *(const LAS u32x2*)(vp + 16);
                    const bf16x8 vf = __builtin_bit_cast(bf16x8, (u32x4){v0.x, v0.y, v1.x, v1.y});
                    O[d] = __builtin_amdgcn_mfma_f32_32x32x16_bf16(vf, pf, O[d], 0, 0, 0);
                }
            }
        }
    };
    if (PF2) {
        if (nt > 1) gload(1, kreg, vreg);
        for (int t = 0; t < nt; t += 2) {
            if (t + 2 < nt) gload(t + 2, kreg2, vreg2);
            compute(t);
            if (t + 1 < nt) sstore(1, kreg, vreg);
            __syncthreads();
            if (t + 1 >= nt) break;
            if (t + 3 < nt) gload(t + 3, kreg, vreg);
            compute(t + 1);
            if (t + 2 < nt) sstore(0, kreg2, vreg2);
            __syncthreads();
        }
    } else {
        for (int t = 0; t < nt; ++t) {
            if (t + 1 < nt) gload(t + 1, kreg, vreg);
            compute(t);
            if (t + 1 < nt) sstore((t + 1) & 1, kreg, vreg);
            __syncthreads();
        }
    }
    }
    if (MODE == 0) {
        const float inv = 1.0f / (l_run + shfl_xor_f(l_run, 32));
        bf16_t* op = a.out + (size_t)lr * a.ldo;
#pragma unroll
        for (int d = 0; d < ND; ++d)
#pragma unroll
            for (int q4 = 0; q4 < 4; ++q4)
                *(u32x2*)(op + d * 32 + 8 * q4 + 4 * g) = (u32x2){cvt_pk_bf16(O[d][4 * q4] * inv, O[d][4 * q4 + 1] * inv), cvt_pk_bf16(O[d][4 * q4 + 2] * inv, O[d][4 * q4 + 3] * inv)};
    } else if (MODE == 1) {
        const int wid = tid >> 6;
        const float inv = 1.0f / (l_run + shfl_xor_f(l_run, 32));
        LAS float* ex = (LAS float*)lds;
        if (wid >= 4) {
#pragma unroll
            for (int d = 0; d < ND; ++d)
#pragma unroll
                for (int r = 0; r < 16; ++r) ex[(((wid - 4) * ND + d) * 16 + r) * 64 + lane] = O[d][r] * inv;
        }
        __syncthreads();
        if (wid < 4) {
            float ss = 0.f;
#pragma unroll
            for (int d = 0; d < ND; ++d)
#pragma unroll
                for (int r = 0; r < 16; ++r) { const float o = O[d][r] * inv - a.lam * ex[((wid * ND + d) * 16 + r) * 64 + lane]; O[d][r] = o; ss += o * o; }
            ss += shfl_xor_f(ss, 32);
            const float rs = rsqrtf(ss * (1.0f / DV) + 1e-5f) * a.onem;
            bf16_t* op = a.out + (size_t)lr * a.ldo;
#pragma unroll
            for (int d = 0; d < ND; ++d)
#pragma unroll
                for (int q4 = 0; q4 < 4; ++q4) { const int dd = d * 32 + 8 * q4 + 4 * g; const f32x4 sg = *(const f32x4*)(a.subg + dd);
                    *(u32x2*)(op + dd) = (u32x2){cvt_pk_bf16(O[d][4 * q4] * rs * sg[0], O[d][4 * q4 + 1] * rs * sg[1]), cvt_pk_bf16(O[d][4 * q4 + 2] * rs * sg[2], O[d][4 * q4 + 3] * rs * sg[3])}; }
        }
        __syncthreads();
    } else if (MODE == 2) {
        const int wid_e = __builtin_amdgcn_readfirstlane(tid >> 6);
        const LAS int* pp = (const LAS int*)(lds + LDS_RETPARAM) + wid_e * 8;
        const int e_row = pp[0], e_col = pp[1], e_pair = pp[2], e_dvh = pp[3];
        KParamsPtr kpe = (KParamsPtr)__builtin_amdgcn_kernarg_segment_ptr();
        unsigned char* wsb = kpe->ws;
        unsigned long long* pslot = (unsigned long long*)(wsb + WS_PSLOT) + (size_t)e_pair * 256;
        float ss = 0.f;
#pragma unroll
        for (int d = 0; d < ND; ++d)
#pragma unroll
            for (int r = 0; r < 16; ++r) ss += O[d][r] * O[d][r];
        ss += shfl_xor_f(ss, 32);
        LAS float* xl = (LAS float*)lds;
        if (g == 0) xl[wid_e * 32 + lr] = ss;
        __syncthreads();
        if (wid_e < 4 && g == 0) {
            const float mine = xl[wid_e * 32 + lr] + xl[(wid_e + 4) * 32 + lr];
            const int row = wid_e * 32 + lr;
            (void)__hip_atomic_exchange(pslot + (size_t)e_dvh * 128 + row, (0x5EEDull << 32) | (unsigned long long)__float_as_uint(mine), __ATOMIC_RELAXED, __HIP_MEMORY_SCOPE_AGENT);
            unsigned long long* o = pslot + (size_t)(e_dvh ^ 1) * 128 + row; unsigned long long v; unsigned spin = 0;
            for (;;) { v = __hip_atomic_load(o, __ATOMIC_RELAXED, __HIP_MEMORY_SCOPE_AGENT); if ((unsigned)(v >> 32) == 0x5EEDu) break; __builtin_amdgcn_s_sleep(1); if (++spin > (1u << 22)) break; }
            xl[256 + row] = rsqrtf((mine + __uint_as_float((unsigned)v)) * (1.0f / 512.0f) + 1e-6f);
        }
        __syncthreads();
        const float rs = xl[256 + (wid_e & 3) * 32 + lr];
        bf16_t* op = (bf16_t*)(wsb + WS_X + 36 * MiB) + (size_t)(e_row + lr) * 2048 + e_col; const bf16_t* gp = (const bf16_t*)(wsb + WS_U) + (size_t)(e_row + lr) * 6144 + 4096 + e_col; const float* gnp = kpe->in[I_RGN] + e_col;
#pragma unroll
        for (int d = 0; d < ND; ++d)
#pragma unroll
            for (int q4 = 0; q4 < 4; ++q4) { const int dd = d * 32 + 8 * q4 + 4 * g; const u32x2 gw = *(const u32x2*)(gp + dd); const f32x4 g4 = *(const f32x4*)(gnp + dd);
                const float o0 = siluf(bflo(gw.x)) * (O[d][4 * q4] * rs * g4[0]), o1 = siluf(bfhi(gw.x)) * (O[d][4 * q4 + 1] * rs * g4[1]);
                const float o2 = siluf(bflo(gw.y)) * (O[d][4 * q4 + 2] * rs * g4[2]), o3 = siluf(bfhi(gw.y)) * (O[d][4 * q4 + 3] * rs * g4[3]);
                *(u32x2*)(op + dd) = (u32x2){cvt_pk_bf16(o0, o1), cvt_pk_bf16(o2, o3)}; }
        __syncthreads();
    } else {
        float* op = a.outf + (size_t)lr * 512;
#pragma unroll
        for (int d = 0; d < ND; ++d)
#pragma unroll
            for (int q4 = 0; q4 < 4; ++q4) *(f32x4*)(op + d * 32 + 8 * q4 + 4 * g) = (f32x4){O[d][4 * q4], O[d][4 * q4 + 1], O[d][4 * q4 + 2], O[d][4 * q4 + 3]};
    }
}

__device__ __forceinline__ int xcd_item(int it) { return (gridDim.x == 256 && it < 512) ? ((it & 256) | ((it & 7) << 5) | ((it & 255) >> 3)) : it; }
template <bool FXC>
__device__ __forceinline__ void attn_phase_t(const Params& p, LAS unsigned char* lds, const float fixm) {
    bf16_t* U = (bf16_t*)(p.ws + WS_U); bf16_t* H = (bf16_t*)(p.ws + WS_H);
    bf16_t* KS = (bf16_t*)(p.ws + WS_X); bf16_t* VtS = KS + (size_t)2 * 4352 * 256; bf16_t* VtP = VtS + (size_t)2 * 256 * 4352;
    const int wid = otid() >> 6, sub = wid >> 2, w4 = wid & 3;
    for (int it = blockIdx.x; it < 1024; it += gridDim.x) {
        FlashArgs a; a.ident = nullptr; a.kcol = 0; a.qscale = 0.125f * 1.4426950408889634f; a.ldo = DM; a.outf = nullptr; a.ldq = 1536; a.fixm = fixm;
        if (it < 512) { const int ix = xcd_item(it); const int b = ix >> 8, pr = (ix >> 5) & 7, qb = ix & 31; const int head = pr * 2 + sub, kh = pr >> 1;
            const size_t tok = (size_t)NTP + b * 4096 + qb * 128 + w4 * 32;
            a.q = U + tok * 1536 + head * 64; a.k = KS + (size_t)b * 4352 * 256 + kh * 64; a.ldk = 256; a.vt = VtS + (size_t)(b * 4 + kh) * 64 * 4352; a.ldvt = 4352;
            a.nreal = 4352; a.ntiles = 68; a.out = H + tok * DM + head * 64;
        } else { const int i2 = it - 512, b = i2 >> 4, pr = (i2 >> 1) & 7, qb = i2 & 1; const int head = pr * 2 + sub, kh = pr >> 1;
            const size_t tok = (size_t)b * 256 + qb * 128 + w4 * 32;
            a.q = U + tok * 1536 + head * 64; a.k = U + (size_t)b * 256 * 1536 + 1024 + kh * 64; a.ldk = 1536; a.vt = VtP + (size_t)(b * 4 + kh) * 64 * 256; a.ldvt = 256;
            a.nreal = 256; a.ntiles = 4; a.out = H + tok * DM + head * 64;
        }
        flash_item<64, 64, 0, FXC>(lds, a);
    }
}
__device__ void attn_phase(const Params& p, LAS unsigned char* lds) {
    float gq = 0.f, gk = 0.f;
    for (int i = 0; i < 64; ++i) { gq = fmaxf(gq, fabsf(p.in[I_AQG][i])); gk = fmaxf(gk, fabsf(p.in[I_AKG][i])); }
    const float ckn = sqrtf(__uint_as_float(*(const unsigned*)(p.ws + WS_CKMAX)));
    const float sbound = 8.0f * gq * fmaxf(8.0f * gk, ckn) * (0.125f * 1.4426950408889634f) * 1.03f + 0.25f;
    const float fixm = sbound <= 60.0f ? sbound : -1.0f;
    if (fixm >= 0.f) attn_phase_t<true>(p, lds, fixm); else attn_phase_t<false>(p, lds, fixm);
}
template <bool FXC>
__device__ __forceinline__ void diff_phase_t(const Params& p, LAS unsigned char* lds, const float dfix) {
    bf16_t* U = (bf16_t*)(p.ws + WS_U); bf16_t* H = (bf16_t*)(p.ws + WS_H);
    bf16_t* KS = (bf16_t*)(p.ws + WS_X); bf16_t* VtS = KS + (size_t)2 * 4352 * 1024; bf16_t* VtP = VtS + (size_t)2 * 1024 * 4352;
    const int wid = otid() >> 6, sub = wid >> 2, w4 = wid & 3;
    const float* lam = p.in[I_DLAM]; float s1 = 0.f, s2 = 0.f;
    for (int i = 0; i < 64; ++i) { s1 += lam[i] * lam[64 + i]; s2 += lam[128 + i] * lam[192 + i]; }
    const float lam_init = 0.8f - 0.6f * expf(-0.3f * 1.0f); const float lam_full = expf(s1) - expf(s2) + lam_init;
    for (int it = blockIdx.x; it < 1024; it += gridDim.x) {
        FlashArgs a; a.ident = nullptr; a.kcol = sub * 64; a.qscale = 0.125f * 1.4426950408889634f; a.ldo = DM; a.outf = nullptr; a.ldq = 3072; a.fixm = dfix;
        a.lam = lam_full; a.onem = 1.0f - lam_init; a.subg = p.in[I_DSUB];
        if (it < 512) { const int ix = xcd_item(it); const int b = ix >> 8, h = (ix >> 5) & 7, qb = ix & 31; const size_t tok = (size_t)NTP + b * 4096 + qb * 128 + w4 * 32;
            a.q = U + tok * 3072 + h * 128 + sub * 64; a.k = KS + (size_t)b * 4352 * 1024 + h * 128; a.ldk = 1024; a.vt = VtS + ((size_t)b * 1024 + h * 128) * 4352; a.ldvt = 4352;
            a.nreal = 4352; a.ntiles = 68; a.out = H + tok * DM + h * 128;
        } else { const int i2 = it - 512, b = i2 >> 4, h = (i2 >> 1) & 7, qb = i2 & 1; const size_t tok = (size_t)b * 256 + qb * 128 + w4 * 32;
            a.q = U + tok * 3072 + h * 128 + sub * 64; a.k = U + (size_t)b * 256 * 3072 + 1024 + h * 128; a.ldk = 3072; a.vt = VtP + ((size_t)b * 1024 + h * 128) * 256; a.ldvt = 256;
            a.nreal = 256; a.ntiles = 4; a.out = H + tok * DM + h * 128;
        }
        flash_item<64, 128, 1, FXC>(lds, a);
    }
}
__device__ void diff_phase(const Params& p, LAS unsigned char* lds) {
    const float dqn = sqrtf(__uint_as_float(*(const unsigned*)(p.ws + WS_DQMAX))), dkn = sqrtf(__uint_as_float(*((const unsigned*)(p.ws + WS_DQMAX) + 1)));
    const float dbound = dqn * dkn * (0.125f * 1.4426950408889634f) * 1.03f + 0.25f; const float dfix = dbound <= 60.0f ? dbound : -1.0f;
    if (dfix >= 0.f) diff_phase_t<true>(p, lds, dfix); else diff_phase_t<false>(p, lds, dfix);
}
__device__ void ret_phase(const Params& p, LAS unsigned char* lds) {
    bf16_t* U = (bf16_t*)(p.ws + WS_U); bf16_t* VtP = (bf16_t*)(p.ws + WS_H); bf16_t* VtS = (bf16_t*)(p.ws + WS_X); bf16_t* OB = (bf16_t*)(p.ws + WS_X + 36 * MiB);
    const bf16_t* ident = (const bf16_t*)(p.ws + WS_IDENT); const bf16_t* identw = (const bf16_t*)(p.ws + WS_IDENTW);
    const float L2E = 1.4426950408889634f;
    for (int it = blockIdx.x; it < 2048; it += gridDim.x) {
        const int wid = __builtin_amdgcn_readfirstlane(otid() >> 6), rg = wid & 3, half = wid >> 2;
        FlashArgs a; a.ident = identw; a.kcol = 0; a.qscale = 1.f; a.ldo = 2048; a.outf = nullptr; a.dir = 0; a.half = half;
        if (it < 512) { const int ix = xcd_item(it); const int b = ix >> 8, h = (ix >> 6) & 3, dvh = (ix >> 5) & 1, qb = ix & 31; const size_t tok0 = (size_t)NTP + b * 4096;
            a.lgf = -fabsf(p.in[I_RLD][h]) * L2E; a.lgb = -fabsf(p.in[I_RLD][4 + h]) * L2E;
            a.n0 = qb * 128 + rg * 32; a.L = 4096;
            a.q = U + (tok0 + a.n0) * 6144 + h * 256; a.ldq = 6144; a.k = U + tok0 * 6144 + 1024 + h * 256; a.ldk = 6144;
            a.vt = VtS + ((size_t)b * 2048 + h * 512 + dvh * 256) * 4608; a.ldvt = 4608; a.nreal = 4096; a.ntiles = 72;
            a.out = nullptr;
            if ((otid() & 63) == 0) { LAS int* pp = (LAS int*)(lds + LDS_RETPARAM) + wid * 8; pp[0] = (int)(tok0 + a.n0); pp[1] = h * 512 + dvh * 256 + half * 128; pp[2] = (b * 4 + h) * 32 + qb; pp[3] = dvh; }
            flash_item<256, 128, 2>(lds, a);
        } else if (it < 1024) { const int i2 = it - 512, b = i2 >> 4, h = (i2 >> 2) & 3, dvh = (i2 >> 1) & 1, qb = i2 & 1; const size_t tok0 = (size_t)b * 256;
            a.lgf = -fabsf(p.in[I_RLD][h]) * L2E; a.lgb = -fabsf(p.in[I_RLD][4 + h]) * L2E;
            a.n0 = qb * 128 + rg * 32; a.L = 256;
            a.q = U + (tok0 + a.n0) * 6144 + h * 256; a.ldq = 6144; a.k = U + tok0 * 6144 + 1024 + h * 256; a.ldk = 6144;
            a.vt = VtP + ((size_t)b * 2048 + h * 512 + dvh * 256) * 256; a.ldvt = 256; a.nreal = 256; a.ntiles = 4;
            a.out = nullptr;
            if ((otid() & 63) == 0) { LAS int* pp = (LAS int*)(lds + LDS_RETPARAM) + wid * 8; pp[0] = (int)(tok0 + a.n0); pp[1] = h * 512 + dvh * 256 + half * 128; pp[2] = 256 + (b * 4 + h) * 2 + qb; pp[3] = dvh; }
            flash_item<256, 128, 2>(lds, a);
        } else { const int i2 = it - 1024, b = i2 >> 5, dir = (i2 >> 4) & 1, h = (i2 >> 2) & 3, dvh = (i2 >> 1) & 1, ib = i2 & 1; const size_t tok0 = (size_t)b * 256;
            a.lgf = -fabsf(p.in[I_RLD][h]) * L2E; a.lgb = -fabsf(p.in[I_RLD][4 + h]) * L2E;
            a.n0 = ib * 128 + rg * 32; a.L = 256; a.dir = dir;
            a.q = ident + (size_t)(ib * 128 + rg * 32) * 256; a.ldq = 256; a.k = U + tok0 * 6144 + 1024 + h * 256; a.ldk = 6144;
            a.vt = VtP + ((size_t)b * 2048 + h * 512 + dvh * 256) * 256; a.ldvt = 256; a.nreal = 256; a.ntiles = 4;
            a.out = nullptr; a.outf = p.out + OUT_NSR + ((size_t)((b * 2 + dir) * 4 + h) * 256 + ib * 128 + rg * 32) * 512 + dvh * 256 + half * 128;
            flash_item<256, 128, 3>(lds, a);
        }
    }
}
__device__ void ret_prep(const Params& p, LAS unsigned char* lds) {
    bf16_t* U = (bf16_t*)(p.ws + WS_U); bf16_t* VtP = (bf16_t*)(p.ws + WS_H); bf16_t* VtS = (bf16_t*)(p.ws + WS_X);
    vt_all<true>(U, 6144, 2048, 2048, VtP, VtS, 4608, 0, lds);
    for (int it = blockIdx.x; it < 16 * 32; it += gridDim.x) { const int mt = it >> 5, tl = it & 31, kt = tl >> 3, ntile = tl & 7; const int b = mt >> 3, dir = (mt >> 2) & 1, h = mt & 3;
        wconv_tile<true>(p.in[I_SRET] + (size_t)mt * 256 * 512, 512, VtS + ((size_t)b * 2048 + h * 512) * 4608 + 4096 + dir * 256, 4608, kt, ntile, (LAS float*)lds); }
}
__device__ void ret_gate(const Params& p) {
    const bf16_t* U = (const bf16_t*)(p.ws + WS_U); bf16_t* OB = (bf16_t*)(p.ws + WS_X + 36 * MiB); const float* gn = p.in[I_RGN];
    const int lane = otid() & 63, gw = blockIdx.x * 8 + (otid() >> 6), nw = gridDim.x * 8;
    for (int it = gw; it < NT * 4; it += nw) { const int t = it >> 2, h = it & 3;
        bf16_t* op = OB + (size_t)t * 2048 + h * 512 + lane * 8; const u32x4 ow = *(const u32x4*)op; const u32x4 gwv = *(const u32x4*)(U + (size_t)t * 6144 + 4096 + h * 512 + lane * 8);
        float o[8], gg[8];
#pragma unroll
        for (int j = 0; j < 4; ++j) { o[2 * j] = bflo(ow[j]); o[2 * j + 1] = bfhi(ow[j]); gg[2 * j] = bflo(gwv[j]); gg[2 * j + 1] = bfhi(gwv[j]); }
        float ss = 0.f;
#pragma unroll
        for (int j = 0; j < 8; ++j) ss += o[j] * o[j];
        ss = wave_sum(ss); const float rs = rsqrtf(ss * (1.0f / 512.0f) + 1e-6f);
        const f32x4 g0 = *(const f32x4*)(gn + h * 512 + lane * 8), g1 = *(const f32x4*)(gn + h * 512 + lane * 8 + 4);
        float r[8];
#pragma unroll
        for (int j = 0; j < 8; ++j) r[j] = siluf(gg[j]) * (o[j] * rs * (j < 4 ? g0[j] : g1[j - 4]));
        *(u32x4*)op = (u32x4){cvt_pk_bf16(r[0], r[1]), cvt_pk_bf16(r[2], r[3]), cvt_pk_bf16(r[4], r[5]), cvt_pk_bf16(r[6], r[7])};
    }
}

__device__ void ffn_act_phase(const bf16_t* __restrict__ src, bf16_t* __restrict__ dst, const float* __restrict__ w, const float* __restrict__ bias) {
    constexpr int C = FF, LD = 2 * FF; const int nc8 = C / 8; const size_t tot = (size_t)(NT / 16) * nc8;
    for (size_t it = (size_t)blockIdx.x * 512 + otid(); it < tot; it += (size_t)gridDim.x * 512) {
        const int cb = (int)(it % nc8), rb = (int)(it / nc8), r0 = rb * 16, j0 = cb * 8;
        const int Ls = r0 < NTP ? 256 : 4096; const bool hasp = (r0 % Ls) != 0, hasn = ((r0 + 16) % Ls) != 0;
        float w0[2][8], w1[2][8], w2[2][8], bb[2][8];
#pragma unroll
        for (int q = 0; q < 2; ++q)
#pragma unroll
            for (int j = 0; j < 8; ++j) { const int c = j0 + j + q * C; w0[q][j] = w[c]; w1[q][j] = w[LD + c]; w2[q][j] = w[2 * LD + c]; bb[q][j] = bias[c]; }
        const bf16_t* sp = src + (size_t)r0 * LD + j0;
        u32x4 raw[2][6];
        const u32x4 z4 = (u32x4){0u, 0u, 0u, 0u};
#pragma unroll
        for (int q = 0; q < 2; ++q) { raw[q][0] = hasp ? *(const u32x4*)(sp - LD + q * C) : z4; raw[q][1] = *(const u32x4*)(sp + q * C); }
#pragma unroll
        for (int grp = 0; grp < 4; ++grp) {
#pragma unroll
            for (int k = 0; k < 4; ++k)
#pragma unroll
                for (int q = 0; q < 2; ++q) { const int rr = grp * 4 + k + 1; raw[q][2 + k] = (rr < 16 || hasn) ? *(const u32x4*)(sp + (size_t)rr * LD + q * C) : z4; }
#pragma unroll
            for (int k = 0; k < 4; ++k) {
                float o[8];
#pragma unroll
                for (int jj = 0; jj < 4; ++jj) {
                    float ca[2], cbv[2];
#pragma unroll
                    for (int h2 = 0; h2 < 2; ++h2) { const int j = 2 * jj + h2;
                        const float pa = h2 ? bfhi(raw[0][k][jj]) : bflo(raw[0][k][jj]), ca_ = h2 ? bfhi(raw[0][k + 1][jj]) : bflo(raw[0][k + 1][jj]), na = h2 ? bfhi(raw[0][k + 2][jj]) : bflo(raw[0][k + 2][jj]);
                        const float pb = h2 ? bfhi(raw[1][k][jj]) : bflo(raw[1][k][jj]), cb_ = h2 ? bfhi(raw[1][k + 1][jj]) : bflo(raw[1][k + 1][jj]), nb = h2 ? bfhi(raw[1][k + 2][jj]) : bflo(raw[1][k + 2][jj]);
                        ca[h2] = w0[0][j] * pa + w1[0][j] * ca_ + w2[0][j] * na + bb[0][j];
                        cbv[h2] = w0[1][j] * pb + w1[1][j] * cb_ + w2[1][j] * nb + bb[1][j];
                        o[j] = siluf(ca[h2]) * cbv[h2]; }
                }
                *(u32x4*)(dst + (size_t)(r0 + grp * 4 + k) * C + j0) = (u32x4){cvt_pk_bf16(o[0], o[1]), cvt_pk_bf16(o[2], o[3]), cvt_pk_bf16(o[4], o[5]), cvt_pk_bf16(o[6], o[7])};
            }
#pragma unroll
            for (int q = 0; q < 2; ++q) { raw[q][0] = raw[q][4]; raw[q][1] = raw[q][5]; }
        }
    }
}

__device__ void hyena_filters(const Params& p, LAS unsigned char* lds) {
    float* FtP = (float*)(p.ws + WS_X); float* FtS = FtP + (size_t)4096 * 256; float* PS = (float*)(p.ws + WS_X + 68 * MiB);
    LAS float* zz = (LAS float*)lds;
    LAS float* a1 = zz + 16 * 33;
    LAS float* a2 = a1 + 16 * 64;
    const int tid = otid();
    const float* w1 = p.in[I_HW1]; const float* b1 = p.in[I_HB1]; const float* w2 = p.in[I_HW2]; const float* b2 = p.in[I_HB2]; const float* w3 = p.in[I_HW3]; const float* fq = p.in[I_HFREQ];
    for (int it = blockIdx.x; it < 272; it += gridDim.x) {
        const int L = it < 16 ? 256 : 4096, t0 = it < 16 ? it * 16 : (it - 16) * 16;
        for (int i = tid; i < 16 * 33; i += 512) { const int r = i / 33, e = i % 33; const float t = (float)(t0 + r); float v;
            if (e == 0) v = t / (float)(L - 1);
            else { const int bi = (e - 1) & 15; const float band = 1e-4f + (float)bi * ((15.0f - 1e-4f) / 15.0f); const float rev = t * band / (float)L; v = e <= 16 ? cos_rev(rev) : -sin_rev(rev); }
            zz[i] = v; }
        __syncthreads();
        for (int i = tid; i < 1024; i += 512) { const int r = i >> 6, j = i & 63; float s = b1[j];
            for (int e = 0; e < 33; ++e) s += zz[r * 33 + e] * w1[e * 64 + j];
            a1[i] = sin_rr(fq[j] * s); }
        __syncthreads();
        for (int i = tid; i < 1024; i += 512) { const int r = i >> 6, j = i & 63; float s = b2[j];
            for (int k = 0; k < 64; ++k) s += a1[r * 64 + k] * w2[k * 64 + j];
            a2[i] = sin_rr(fq[64 + j] * s); }
        __syncthreads();
        const int c0 = tid * 8;
        float acc[16][8];
#pragma unroll
        for (int r = 0; r < 16; ++r)
#pragma unroll
            for (int j = 0; j < 8; ++j) acc[r][j] = 0.f;
        for (int k = 0; k < 64; ++k) { const f32x4 wa = *(const f32x4*)(w3 + (size_t)k * 4096 + c0), wb = *(const f32x4*)(w3 + (size_t)k * 4096 + c0 + 4);
#pragma unroll
            for (int r = 0; r < 16; ++r) { const float av = a2[r * 64 + k];
#pragma unroll
                for (int j = 0; j < 4; ++j) { acc[r][j] += av * wa[j]; acc[r][4 + j] += av * wb[j]; } } }
        float asum[8];
#pragma unroll
        for (int j = 0; j < 8; ++j) asum[j] = 0.f;
        const float mind = -3.0701134573253945f, maxd = -15.350567286626973f;
        float dl[8];
#pragma unroll
        for (int j = 0; j < 8; ++j) { const int c = (c0 + j) & 1023; dl[j] = fabsf(mind + (maxd - mind) * ((float)c / 1023.0f)); }
#pragma unroll
        for (int r = 0; r < 16; ++r) { const float tn = (float)(t0 + r) / (float)(L - 1);
#pragma unroll
            for (int j = 0; j < 8; ++j) { acc[r][j] *= (__expf(-tn * dl[j]) + 0.05f); asum[j] += fabsf(acc[r][j]); } }
        { float* Ft = it < 16 ? FtP : FtS;
#pragma unroll
          for (int j = 0; j < 8; ++j) { float* d = Ft + (size_t)(c0 + j) * L + t0;
#pragma unroll
              for (int r4 = 0; r4 < 4; ++r4) *(f32x4*)(d + r4 * 4) = (f32x4){acc[r4 * 4][j], acc[r4 * 4 + 1][j], acc[r4 * 4 + 2][j], acc[r4 * 4 + 3][j]}; } }
        *(f32x4*)(PS + (size_t)it * 4096 + c0) = (f32x4){asum[0], asum[1], asum[2], asum[3]}; *(f32x4*)(PS + (size_t)it * 4096 + c0 + 4) = (f32x4){asum[4], asum[5], asum[6], asum[7]};
        __syncthreads();
    }
}
__device__ void hyena_dwconv_t(const bf16_t* __restrict__ src, bf16_t* __restrict__ Zt, const float* __restrict__ w, const float* __restrict__ bias) {
    constexpr int C = 3072; const int nc8 = C / 8; const size_t tot = (size_t)(NT / 16) * nc8;
    for (size_t it = (size_t)blockIdx.x * 512 + otid(); it < tot; it += (size_t)gridDim.x * 512) {
        const int cb = (int)(it % nc8), rb = (int)(it / nc8), r0 = rb * 16, j0 = cb * 8;
        const int Ls = r0 < NTP ? 256 : 4096; const bool hasp = (r0 % Ls) != 0, hasn = ((r0 + 16) % Ls) != 0;
        float w0[8], w1[8], w2[8], bb[8];
#pragma unroll
        for (int j = 0; j < 8; ++j) { const int c = j0 + j; w0[j] = w[c]; w1[j] = w[C + c]; w2[j] = w[2 * C + c]; bb[j] = bias[c]; }
        float pv[8], cv[8], nv[8], lo[8]; unsigned pk[8][8];
        auto ld8 = [&](int r, float* o, bool ok) {
            if (ok) { const u32x4 x = *(const u32x4*)(src + (size_t)r * C + j0);
#pragma unroll
                for (int j = 0; j < 4; ++j) { o[2 * j] = bflo(x[j]); o[2 * j + 1] = bfhi(x[j]); } }
            else {
#pragma unroll
                for (int j = 0; j < 8; ++j) o[j] = 0.f; }
        };
        ld8(r0 - 1, pv, hasp); ld8(r0, cv, true);
#pragma unroll
        for (int i = 0; i < 16; ++i) {
            ld8(r0 + i + 1, nv, (i < 15) || hasn);
#pragma unroll
            for (int j = 0; j < 8; ++j) { const float o = w0[j] * pv[j] + w1[j] * cv[j] + w2[j] * nv[j] + bb[j];
                if (i & 1) pk[j][i >> 1] = cvt_pk_bf16(lo[j], o); else lo[j] = o;
                pv[j] = cv[j]; cv[j] = nv[j]; }
        }
#pragma unroll
        for (int j = 0; j < 8; ++j) { bf16_t* d = Zt + (size_t)(j0 + j) * NT + r0;
            *(u32x4*)d = (u32x4){pk[j][0], pk[j][1], pk[j][2], pk[j][3]}; *(u32x4*)(d + 8) = (u32x4){pk[j][4], pk[j][5], pk[j][6], pk[j][7]}; }
    }
}
__device__ __forceinline__ float blk_sum2(float v, LAS float* red, int slot) {
    v = wave_sum(v); if ((otid() & 63) == 0) red[slot * 8 + (otid() >> 6)] = v; return v; }
__device__ void hyena_mfma(const Params& p, LAS unsigned char* lds) {
    const float* FtP = (const float*)(p.ws + WS_X); const float* FtS = FtP + (size_t)4096 * 256; const float* PS = (const float*)(p.ws + WS_X + 68 * MiB);
    bf16_t* U = (bf16_t*)(p.ws + WS_U); const bf16_t* Zt = U + (size_t)NT * 3072; bf16_t* yT = U;
    for (int it = blockIdx.x; it < 2048; it += gridDim.x) {
        const int tid = otid(), lane = tid & 63, wid = tid >> 6, lr = lane & 31, g = lane >> 5;
        const int c = it & 1023;
        if (it < 1024) {
            constexpr int CST = 16400;
            LAS unsigned char* cp = lds; LAS bf16_t* uL = (LAS bf16_t*)(lds + 8 * CST); LAS float* red = (LAS float*)(lds + 8 * CST + 18432);
            const int mi = wid & 1, ah = (wid >> 1) & 1, batch = wid >> 2;
            for (int order = 0; order < 2; ++order) {
                const int colf = order * 1024 + c, colb = 2048 + order * 1024 + c;
                blk_sum2(tid < 256 ? PS[(size_t)(16 + tid) * 4096 + colf] : 0.f, red, 0); blk_sum2(tid < 256 ? PS[(size_t)(16 + tid) * 4096 + colb] : 0.f, red, 1);
                __syncthreads();
                float sf = 0.f, sb = 0.f;
#pragma unroll
                for (int q = 0; q < 8; ++q) { sf += red[q]; sb += red[8 + q]; }
                const float nf = 1.0f / (sf + 1e-6f), nb = 1.0f / (sb + 1e-6f), skip = p.in[I_HSKIP][order * 1024 + c];
                const float* hf = FtS + (size_t)colf * 4096; const float* hb = FtS + (size_t)colb * 4096;
                { float pv[24];
#pragma unroll
                  for (int j = 0; j < 24; ++j) { const int i = 16 * tid + j; float v;
                      if (i <= 0 || i >= 8192) v = 0.f; else if (i < 4096) v = hf[4096 - i] * nf; else if (i == 4096) v = hf[0] * nf + hb[0] * nb + skip; else v = hb[i - 4096] * nb;
                      pv[j] = v; }
#pragma unroll
                  for (int rho = 0; rho < 8; ++rho) { LAS unsigned char* d = cp + rho * CST + tid * 32;
                      *(LAS u32x4*)d = (u32x4){cvt_pk_bf16(pv[rho], pv[rho + 1]), cvt_pk_bf16(pv[rho + 2], pv[rho + 3]), cvt_pk_bf16(pv[rho + 4], pv[rho + 5]), cvt_pk_bf16(pv[rho + 6], pv[rho + 7])};
                      *(LAS u32x4*)(d + 16) = (u32x4){cvt_pk_bf16(pv[rho + 8], pv[rho + 9]), cvt_pk_bf16(pv[rho + 10], pv[rho + 11]), cvt_pk_bf16(pv[rho + 12], pv[rho + 13]), cvt_pk_bf16(pv[rho + 14], pv[rho + 15])}; } }
                if (order == 0) {
#pragma unroll
                    for (int i = 0; i < 2; ++i) { const int idx = tid + i * 512, bt = idx >> 9, ch = idx & 511;
                        *(LAS u32x4*)(uL + bt * 4608 + (ch >> 3) * 72 + (ch & 7) * 8) = *(const u32x4*)(Zt + (size_t)(2048 + c) * NT + NTP + bt * 4096 + ch * 8); }
                }
                __syncthreads();
                f32x16 acc;
#pragma unroll
                for (int r = 0; r < 16; ++r) acc[r] = 0.f;
                const int bp = 32 * mi + lr, rho = (-bp) & 7;
                const LAS unsigned char* cb = cp + rho * CST; const LAS bf16_t* ub = uL + batch * 4608;
                for (int e = 32 * ah - 63; e <= 32 * ah + 31; ++e) {
                    const int aa = 32 * ah + lr - e; const bool valid = (unsigned)aa < 64u; const int aac = aa & 63;
#pragma unroll
                    for (int ks = 0; ks < 4; ++ks) {
                        const int q = 4096 + 16 * ks + 8 * g - bp - 64 * e;
                        const bf16x8 af = *(const LAS bf16x8*)(cb + (q - rho) * 2);
                        u32x4 bw = *(const LAS u32x4*)(ub + aac * 72 + 16 * ks + 8 * g);
                        if (!valid) bw = (u32x4){0u, 0u, 0u, 0u};
                        acc = __builtin_amdgcn_mfma_f32_32x32x16_bf16(af, __builtin_bit_cast(bf16x8, bw), acc, 0, 0, 0);
                    }
                }
                __syncthreads();
                { const bf16_t* gp = Zt + (size_t)(order == 0 ? c : 1024 + c) * NT + NTP + batch * 4096; const int a = 32 * ah + lr;
#pragma unroll
                  for (int q4 = 0; q4 < 4; ++q4) { const int bq = 32 * mi + 8 * q4 + 4 * g; const u32x2 gv = *(const u32x2*)(gp + 64 * a + bq);
                      *(LAS u32x2*)(uL + batch * 4608 + a * 72 + bq) = (u32x2){cvt_pk_bf16(acc[4 * q4] * bflo(gv.x), acc[4 * q4 + 1] * bfhi(gv.x)), cvt_pk_bf16(acc[4 * q4 + 2] * bflo(gv.y), acc[4 * q4 + 3] * bfhi(gv.y))}; } }
                __syncthreads();
            }
#pragma unroll
            for (int i = 0; i < 2; ++i) { const int idx = tid + i * 512, bt = idx >> 9, ch = idx & 511;
                *(u32x4*)(yT + (size_t)c * NT + NTP + bt * 4096 + ch * 8) = *(const LAS u32x4*)(uL + bt * 4608 + (ch >> 3) * 72 + (ch & 7) * 8); }
            __syncthreads();
        } else {
            constexpr int CSP = 1040;
            LAS unsigned char* cp = lds; LAS bf16_t* uL = (LAS bf16_t*)(lds + 8 * CSP); LAS float* red = (LAS float*)(lds + 8 * CSP + 16896);
            const int mi = wid;
            for (int order = 0; order < 2; ++order) {
                const int colf = order * 1024 + c, colb = 2048 + order * 1024 + c;
                blk_sum2(tid < 16 ? PS[(size_t)tid * 4096 + colf] : 0.f, red, 0); blk_sum2(tid < 16 ? PS[(size_t)tid * 4096 + colb] : 0.f, red, 1);
                __syncthreads();
                float sf = 0.f, sb = 0.f;
#pragma unroll
                for (int q = 0; q < 8; ++q) { sf += red[q]; sb += red[8 + q]; }
                const float nf = 1.0f / (sf + 1e-6f), nb = 1.0f / (sb + 1e-6f), skip = p.in[I_HSKIP][order * 1024 + c];
                const float* hf = FtP + (size_t)colf * 256; const float* hb = FtP + (size_t)colb * 256;
                { const int rho = tid >> 6, ch = tid & 63; float pv[8];
#pragma unroll
                  for (int j = 0; j < 8; ++j) { const int i = 8 * ch + rho + j; float v;
                      if (i <= 0 || i >= 512) v = 0.f; else if (i < 256) v = hf[256 - i] * nf; else if (i == 256) v = hf[0] * nf + hb[0] * nb + skip; else v = hb[i - 256] * nb;
                      pv[j] = v; }
                  *(LAS u32x4*)(cp + rho * CSP + ch * 16) = (u32x4){cvt_pk_bf16(pv[0], pv[1]), cvt_pk_bf16(pv[2], pv[3]), cvt_pk_bf16(pv[4], pv[5]), cvt_pk_bf16(pv[6], pv[7])}; }
                if (order == 0) {
#pragma unroll
                    for (int i = 0; i < 2; ++i) { const int idx = tid + i * 512, bt = idx >> 5, ch = idx & 31;
                        *(LAS u32x4*)(uL + bt * 264 + ch * 8) = *(const u32x4*)(Zt + (size_t)(2048 + c) * NT + bt * 256 + ch * 8); }
                }
                __syncthreads();
                f32x16 acc;
#pragma unroll
                for (int r = 0; r < 16; ++r) acc[r] = 0.f;
                const int t = 32 * mi + lr, rho = (-t) & 7;
                const LAS unsigned char* cb = cp + rho * CSP;
#pragma unroll 4
                for (int ks = 0; ks < 16; ++ks) {
                    const int q = 256 + 16 * ks + 8 * g - t;
                    const bf16x8 af = *(const LAS bf16x8*)(cb + (q - rho) * 2);
                    const bf16x8 bf = *(const LAS bf16x8*)(uL + lr * 264 + 16 * ks + 8 * g);
                    acc = __builtin_amdgcn_mfma_f32_32x32x16_bf16(af, bf, acc, 0, 0, 0);
                }
                __syncthreads();
                { const bf16_t* gp = Zt + (size_t)(order == 0 ? c : 1024 + c) * NT + lr * 256;
#pragma unroll
                  for (int q4 = 0; q4 < 4; ++q4) { const int t4 = 32 * mi + 8 * q4 + 4 * g; const u32x2 gv = *(const u32x2*)(gp + t4);
                      *(LAS u32x2*)(uL + lr * 264 + t4) = (u32x2){cvt_pk_bf16(acc[4 * q4] * bflo(gv.x), acc[4 * q4 + 1] * bfhi(gv.x)), cvt_pk_bf16(acc[4 * q4 + 2] * bflo(gv.y), acc[4 * q4 + 3] * bfhi(gv.y))}; } }
                __syncthreads();
            }
#pragma unroll
            for (int i = 0; i < 2; ++i) { const int idx = tid + i * 512, bt = idx >> 5, ch = idx & 31;
                *(u32x4*)(yT + (size_t)c * NT + bt * 256 + ch * 8) = *(const LAS u32x4*)(uL + bt * 264 + ch * 8); }
            __syncthreads();
        }
    }
}
__device__ void hyena_untranspose(const Params& p, LAS unsigned char* lds) {
    const bf16_t* yT = (const bf16_t*)(p.ws + WS_U); bf16_t* H = (bf16_t*)(p.ws + WS_H);
    for (int it = blockIdx.x; it < 16 * 64; it += gridDim.x) { const int ct = it & 15, tt = it >> 4;
        vt_tile<4>(yT + (size_t)(ct * 64) * NT + tt * 256, NT, H + (size_t)(tt * 256) * DM + ct * 64, DM, (LAS bf16_t*)lds); }
}


#define XB_TMO      128
#define XB_XCNT(j)  (256  + 64 * (j))
#define XB_XSUB(j)  (1280 + 64 * (j))
#define XB_XGEN(j)  (2304 + 64 * (j))
#define XB_TOP      3328
#define XB_TOPGEN   3392
#define XCD_BAR_WORDS 3456
#define XB_SPIN_CAP (1u << 18)
__device__ __forceinline__ unsigned xb_ld(unsigned* p)              { return __hip_atomic_load(p, __ATOMIC_RELAXED, __HIP_MEMORY_SCOPE_AGENT); }
__device__ __forceinline__ unsigned xb_add(unsigned* p, unsigned v) { return __hip_atomic_fetch_add(p, v, __ATOMIC_RELAXED, __HIP_MEMORY_SCOPE_AGENT); }
__device__ __forceinline__ unsigned xb_xcc_id() { return (unsigned)__builtin_amdgcn_s_getreg((3 << 11) | 20) & 0xFu; }
#define XB_SPIN(cond, bar) do { unsigned _sp = 0; while (cond) { __builtin_amdgcn_s_sleep(1); \
    if ((++_sp & 255u) == 0u) { if (xb_ld(&(bar)[XB_TMO])) break; if (_sp > XB_SPIN_CAP) { atomicAdd(&(bar)[XB_TMO], 1u); break; } } } } while (0)
__device__ __forceinline__ void xcd_barrier_post(unsigned* bar) { if (threadIdx.x == 0) (void)xb_add(&bar[XB_XCNT(xb_xcc_id())], 1u); }
__device__ __forceinline__ void xcd_barrier_complete(unsigned* bar, unsigned x, unsigned& nloc, unsigned& nx) {
    const unsigned G = gridDim.x * gridDim.y * gridDim.z;
    unsigned sum, cnt, mine, sp = 0u;
    for (;;) {
        sum = 0u; cnt = 0u; mine = 0u;
#pragma unroll
        for (unsigned j = 0; j < 16; ++j) { const unsigned c = xb_ld(&bar[XB_XCNT(j)]); sum += c; cnt += (c > 0u) ? 1u : 0u; mine = (j == x) ? c : mine; }
        if (sum == G) break;
        __builtin_amdgcn_s_sleep(1);
        if ((++sp & 255u) == 0u) { if (xb_ld(&bar[XB_TMO])) break; if (sp > XB_SPIN_CAP) { atomicAdd(&bar[XB_TMO], 1u); break; } }
    }
    nloc = mine > 0u ? mine : 1u; nx = cnt > 0u ? cnt : 1u;
}
__device__ __forceinline__ void xcd_barrier(unsigned* bar, volatile LAS unsigned* st) {
    asm volatile("s_waitcnt vmcnt(0)" ::: "memory");
    __syncthreads();
    if (threadIdx.x == 0) {
        const unsigned x = xb_xcc_id();
        __builtin_amdgcn_s_waitcnt(0);
        unsigned nloc = st[0], nx = st[1];
        if (nloc == 0u) { xcd_barrier_complete(bar, x, nloc, nx); st[0] = nloc; st[1] = nx; }
        const unsigned old = xb_add(&bar[XB_XSUB(x)], 1u);
        const unsigned gen = old / nloc;
        if (old + 1u == (gen + 1u) * nloc) {
            __builtin_amdgcn_fence(__ATOMIC_RELEASE, "agent");
            asm volatile("s_waitcnt vmcnt(0)" ::: "memory");
            const unsigned og = xb_add(&bar[XB_TOP], 1u);
            const unsigned tg = og / nx;
            if (og + 1u == (tg + 1u) * nx) xb_add(&bar[XB_TOPGEN], 1u);
            else XB_SPIN(xb_ld(&bar[XB_TOPGEN]) == tg, bar);
            __builtin_amdgcn_fence(__ATOMIC_ACQUIRE, "agent");
            xb_add(&bar[XB_XGEN(x)], 1u);
            asm volatile("s_waitcnt vmcnt(0)" ::: "memory");
        } else {
            XB_SPIN(xb_ld(&bar[XB_XGEN(x)]) == gen, bar);
            __builtin_amdgcn_fence(__ATOMIC_ACQUIRE, "agent");
            asm volatile("s_waitcnt vmcnt(0)" ::: "memory");
        }
    }
    __syncthreads();
}

#ifndef REP_FLASH
#define REP_FLASH 1
#endif
#ifndef REP_L
#define REP_L -1
#endif
#ifndef REP_SYNC
#define REP_SYNC 1
#endif
#ifndef REP_GEMM
#define REP_GEMM 1
#endif
#ifndef DBG_L
#define DBG_L 2
#endif
constexpr int NPHASE = 42;

__device__ __forceinline__ void run_gemm_bf16(LAS unsigned char* lds, const bf16_t* A, const bf16_t* Bt, int N, int K, bf16_t* O) {
    pg8::Gemm g{A, Bt, NT, N, K}; pg8::StaticOrder S; S.init(NT, N, (int)gridDim.x, (int)blockIdx.x); pg8::EpiBf16 E{O, N};
    pg8::gemm_phase<pg8::EpiBf16, pg8::StaticOrder>(lds, g, S, E);
}
__device__ __forceinline__ void run_gemm_res(LAS unsigned char* lds, const bf16_t* A, const bf16_t* Bt, int K, bf16_t* X, const float* mod, int goff,
                                             bf16_t* An, const float* gnext, int scoff, int shoff, unsigned long long* slots, unsigned tag, int fin, float* Y, unsigned* bar) {
    pg8::Gemm g{A, Bt, NT, DM, K}; pg8::StaticOrder S; S.init(NT, DM, (int)gridDim.x, (int)blockIdx.x); pg8::EpiRes E{X, mod, goff, An, gnext, scoff, shoff, slots, tag, fin, Y, bar};
    pg8::gemm_phase<pg8::EpiRes, pg8::StaticOrder>(lds, g, S, E);
}

__device__ void conv_mixer_weights(const Params& p, int l, LAS unsigned char* lds) {
    bf16_t* W = (bf16_t*)(p.ws + WS_WMIX); int rot = 0;
    if (l == 0) { wconv(p.in[I_AQKV], 1024, 1536, W, lds, rot); wconv(p.in[I_AWO], 1024, 1024, W + (size_t)1536 * 1024, lds, rot); }
    else if (l == 1) { wconv(p.in[I_DQKV], 1024, 3072, W, lds, rot); wconv(p.in[I_DWO], 1024, 1024, W + (size_t)3072 * 1024, lds, rot); }
    else if (l == 2) { wconv(p.in[I_RWIN], 1024, 6144, W, lds, rot); wconv(p.in[I_RWO], 2048, 1024, W + (size_t)6144 * 1024, lds, rot); }
    else { wconv(p.in[I_HWIN], 1024, 3072, W, lds, rot); wconv(p.in[I_HWO], 1024, 1024, W + (size_t)3072 * 1024, lds, rot); }
}
__device__ void conv_ffn_weights(const Params& p, int l, LAS unsigned char* lds) {
    bf16_t* W = (bf16_t*)(p.ws + WS_WFFN); int rot = 0;
    wconv(p.in[I_FUP] + (size_t)l * 1024 * 5632, 1024, 5632, W, lds, rot); wconv(p.in[I_FDOWN] + (size_t)l * FF * 1024, FF, 1024, W + (size_t)5632 * 1024, lds, rot);
}

__device__ __forceinline__ bool phase_empty(int ph) { if (ph == 0) return false; if (ph == 41) return true;     const int l = (ph - 1) / 10, s = (ph - 1) % 10; return (s == 4 && l < 3)   || s == 6 || (s == 0 && l > 0); }

#ifndef ONLY
#define ONLY -1
#endif
#define EN(x) (ONLY == -1 || ONLY == (x))
__device__ __forceinline__ void run_phase(int ph, LAS unsigned char* lds) {
    KParamsPtr kp = (KParamsPtr)__builtin_amdgcn_kernarg_segment_ptr();
    asm volatile("" : "+s"(kp));
    Params p;
#pragma unroll
    for (int i = 0; i < 41; ++i) p.in[i] = kp->in[i];
    p.out = kp->out; p.ws = kp->ws;
    bf16_t* X = (bf16_t*)((unsigned char*)p.out + XR_OFF); const float* mod = (const float*)(p.ws + WS_MOD);
    bf16_t* H = (bf16_t*)(p.ws + WS_H); bf16_t* U = (bf16_t*)(p.ws + WS_U); bf16_t* XB = (bf16_t*)(p.ws + WS_X);
    bf16_t* WM = (bf16_t*)(p.ws + WS_WMIX); bf16_t* WF = (bf16_t*)(p.ws + WS_WFFN);
    if (ph == 0) { if (EN(0)) { prep_misc(p, lds); conv_mixer_weights(p, 0, lds); conv_ffn_weights(p, 0, lds); } return; }
    if (ph == 41) return;
    const int l = (ph - 1) / 10, s = (ph - 1) % 10;
    const int nin = l == 0 ? 1536 : (l == 2 ? 6144 : 3072);
    const int kout = l == 2 ? 2048 : 1024;
    unsigned long long* slots = (unsigned long long*)(p.ws + WS_SLOT);
    if (s == 0) { if (EN(2)) norm_mod(X, p.in[I_N1G] + l * DM, mod + l * 6144, 1 * 1024, 0, H); }
    else if (s == 1) { if (EN(4)) run_gemm_bf16(lds, H, WM, nin, 1024, U); }
    else if (s == 7) { if (EN(4)) run_gemm_bf16(lds, XB, WF, 5632, 1024, U); }
    else if (s == 5) { if (EN(5)) run_gemm_res(lds, l == 2 ? (const bf16_t*)(p.ws + WS_X + 36 * MiB) : H, WM + (size_t)nin * 1024, kout, X, mod, l * 6144 + 2 * 1024,
                                               XB, p.in[I_N2G] + l * DM, l * 6144 + 4 * 1024, l * 6144 + 3 * 1024, slots, (unsigned)(ph + 1), 0, p.out, (unsigned*)(p.ws + WS_BAR)); }
    else if (s == 9) { if (EN(5)) run_gemm_res(lds, XB, WF + (size_t)5632 * 1024, FF, X, mod, l * 6144 + 5 * 1024,
                                               l < 3 ? H : nullptr, l < 3 ? p.in[I_N1G] + (l + 1) * DM : p.in[I_FG], (l < 3 ? l + 1 : 0) * 6144 + 1 * 1024, (l < 3 ? l + 1 : 0) * 6144, slots, (unsigned)(ph + 1), l == 3 ? 1 : 0, p.out, (unsigned*)(p.ws + WS_BAR)); }
    else if (s == 8) { if (EN(6)) ffn_act_phase(U, XB, p.in[I_FCW] + (size_t)l * 3 * 5632, p.in[I_FCB] + (size_t)l * 5632); if (EN(0)) { if (l < 3) conv_mixer_weights(p, l + 1, lds); } }
    else if (s == 2) {
        if (l == 0) { if (EN(7)) { post_attn(p, U, XB, XB + (size_t)2 * 4352 * 256); vt_all(U, 1536, 1280, 256, XB + (size_t)2 * 4352 * 256 + (size_t)2 * 256 * 4352, XB + (size_t)2 * 4352 * 256, 4352, 256, lds); } }
        else if (l == 1) { if (EN(8)) { post_diff(p, U, XB, XB + (size_t)2 * 4352 * 1024, lds); vt_all(U, 3072, 2048, 1024, XB + (size_t)2 * 4352 * 1024 + (size_t)2 * 1024 * 4352, XB + (size_t)2 * 4352 * 1024, 4352, 256, lds); } }
        else if (l == 2) { if (EN(9)) ret_prep(p, lds); }
        else { if (EN(10)) hyena_dwconv_t(U, U + (size_t)NT * 3072, p.in[I_HSCW], p.in[I_HSCB]); if (EN(3)) hyena_filters(p, lds); }
        if (EN(0)) { if (l > 0) conv_ffn_weights(p, l, lds); }
    } else if (s == 3) {
        if (l < 3) { for (int rep = 0; rep < (l == REP_L ? 2 : REP_FLASH); ++rep) { if (l == 0) { if (EN(11)) attn_phase(p, lds); } else if (l == 1) { if (EN(12)) diff_phase(p, lds); } else if (l == 2) { if (EN(13)) ret_phase(p, lds); } } }
        else { if (EN(14)) hyena_mfma(p, lds); }
    } else if (s == 4) {
        if (l == 2) { if (EN(15)) ret_gate(p); }
        else if (l == 3) { if (EN(16)) hyena_untranspose(p, lds); }
    }
}

__global__ void __launch_bounds__(512, 2) mega_kernel(Params p, int ph_begin, int ph_end) {
    extern __shared__ __attribute__((aligned(16))) unsigned char shm[];
    LAS unsigned char* lds = (LAS unsigned char*)shm;
    cg::grid_group grid = cg::this_grid();
    volatile LAS unsigned* st = (volatile LAS unsigned*)(lds + LDS_BYTES - 16);
    if (threadIdx.x == 0) { st[0] = 0u; st[1] = 0u; }
    __syncthreads();
    xcd_barrier_post((unsigned*)(p.ws + WS_BAR));
    int nsync = 0;
    for (int ph = ph_begin; ph < ph_end; ++ph) {
        if (phase_empty(ph)) continue;
        if (nsync == 1) {
            __builtin_amdgcn_fence(__ATOMIC_RELEASE, "agent"); asm volatile("s_waitcnt vmcnt(0) lgkmcnt(0)" ::: "memory");
            grid.sync();
            __builtin_amdgcn_fence(__ATOMIC_ACQUIRE, "agent"); asm volatile("s_waitcnt vmcnt(0) lgkmcnt(0)" ::: "memory");
        } else if (nsync > 1) {
            KParamsPtr kp = (KParamsPtr)__builtin_amdgcn_kernarg_segment_ptr();
            xcd_barrier((unsigned*)(kp->ws + WS_BAR), st);
        }
        ++nsync;
        run_phase(ph, lds);
        __syncthreads();
    }
}

extern "C" void kernel_launch(void* const* d_in, const int* in_sizes, int n_in, void* d_out, int out_size, void* d_ws, size_t ws_size, hipStream_t stream) {
    static int grid_blocks = 0;
    if (!grid_blocks) {
        int dev = 0, cus = 0, per_cu = 0;
        hipGetDevice(&dev);
        hipDeviceGetAttribute(&cus, hipDeviceAttributeMultiprocessorCount, dev);
        if (hipFuncSetAttribute((const void*)mega_kernel, hipFuncAttributeMaxDynamicSharedMemorySize, LDS_BYTES) != hipSuccess) { fprintf(stderr, "hipFuncSetAttribute failed\n"); return; }
        if (hipOccupancyMaxActiveBlocksPerMultiprocessor(&per_cu, (const void*)mega_kernel, 512, LDS_BYTES) != hipSuccess || per_cu < 1) { fprintf(stderr, "occupancy query failed\n"); return; }
        if (cus != 256) { fprintf(stderr, "this kernel's residual epilogue needs exactly 256 workgroups (one 256x256 unit each); device has %d CUs\n", cus); return; }
        grid_blocks = cus;
    }
    if (ws_size < WS_NEED || n_in < 41) { fprintf(stderr, "workspace too small: %zu < %zu\n", ws_size, (size_t)WS_NEED); return; }
    Params p{};
    for (int i = 0; i < 41; ++i) p.in[i] = (const float*)d_in[i];
    p.out = (float*)d_out; p.ws = (unsigned char*)d_ws;
#if MULTI_LAUNCH
    for (int ph = 0; ph < NPHASE; ++ph) {
        int b = ph, e = ph + 1; void* args[] = {&p, &b, &e};
        hipLaunchCooperativeKernel((const void*)mega_kernel, dim3(grid_blocks), dim3(512), args, LDS_BYTES, stream);
    }
#else
    (void)hipMemsetAsync((unsigned char*)d_ws + WS_BAR, 0, XCD_BAR_WORDS * sizeof(unsigned), stream);
    (void)hipMemsetAsync((unsigned char*)d_ws + WS_SLOT, 0, WS_SLOT_BYTES + WS_PSLOT_BYTES + 256, stream);
    int b = 0, e = NPHASE; void* args[] = {&p, &b, &e};
    hipError_t err = hipLaunchCooperativeKernel((const void*)mega_kernel, dim3(grid_blocks), dim3(512), args, LDS_BYTES, stream);
    if (err != hipSuccess) fprintf(stderr, "cooperative launch failed: %s (grid %d)\n", hipGetErrorString(err), grid_blocks);
#endif
}
```

```cpp
#include <hip/hip_runtime.h>
#include <hip/hip_cooperative_groups.h>
#include <cstdio>
namespace cg = cooperative_groups;

#ifndef MULTI_LAUNCH
#define MULTI_LAUNCH 0
#endif

#define LAS __attribute__((address_space(3)))
typedef unsigned short bf16_t;
typedef short bf16x8 __attribute__((ext_vector_type(8)));
typedef float f32x4 __attribute__((ext_vector_type(4)));
typedef float f32x16 __attribute__((ext_vector_type(16)));
typedef unsigned u32x4 __attribute__((ext_vector_type(4)));
typedef unsigned u32x2 __attribute__((ext_vector_type(2)));

constexpr int NT = 16384;
constexpr int NTP = 8192;
constexpr int DM = 1024;
constexpr int FF = 2816;
constexpr int LDS_BYTES = 155648;
constexpr size_t MiB = 1048576;
constexpr size_t WS_MOD = 0;
constexpr size_t WS_IDENT = 512 * 1024;
constexpr size_t WS_SLOT = 2 * 1048576;
constexpr size_t WS_SLOT_BYTES = 64 * 4 * 256 * 8;
constexpr size_t WS_PSLOT = WS_SLOT + WS_SLOT_BYTES;
constexpr size_t WS_PSLOT_BYTES = 512 * 2 * 128 * 8;
constexpr size_t WS_DQMAX = WS_PSLOT + WS_PSLOT_BYTES + 16;
constexpr size_t WS_CKMAX = WS_PSLOT + WS_PSLOT_BYTES;
constexpr size_t WS_BAR = 1024 * 1024;
constexpr size_t WS_WMIX = 4 * MiB;
constexpr size_t WS_WFFN = 22 * MiB;
constexpr size_t WS_H = 40 * MiB;
constexpr size_t WS_U = 72 * MiB;
constexpr size_t WS_X = 264 * MiB;
constexpr size_t WS_IDENTW = 364 * MiB;
constexpr size_t WS_NEED = 368 * MiB;
constexpr size_t XR_OFF = 32 * 1048576;
constexpr size_t OUT_NAK = 16777216, OUT_NAV = 18874368, OUT_NDK = 20971520, OUT_NDV = 29360128, OUT_NSR = 37748736;

struct Params { const float* in[41]; float* out; unsigned char* ws; };
typedef const __attribute__((address_space(4))) Params* KParamsPtr;
constexpr int LDS_RETPARAM = 148 * 1024;

enum { I_XP = 0, I_XS, I_CAK, I_CAV, I_CDK, I_CDV, I_SRET, I_C, I_CCTX, I_WMOD, I_BMOD, I_N1G, I_N2G, I_FG, I_AQKV, I_AQG, I_AKG, I_AWO,
       I_DQKV, I_DLAM, I_DSUB, I_DWO, I_RWIN, I_RLD, I_RGN, I_RWO, I_HWIN, I_HSCW, I_HSCB, I_HW1, I_HB1, I_HW2, I_HB2, I_HW3, I_HFREQ, I_HSKIP, I_HWO,
       I_FUP, I_FCW, I_FCB, I_FDOWN };

__device__ __forceinline__ int otid() { int t = (int)threadIdx.x; asm volatile("" : "+v"(t)); return t; }
typedef float f32x2v __attribute__((ext_vector_type(2)));
typedef __bf16 bf16x2v __attribute__((ext_vector_type(2)));
__device__ __forceinline__ unsigned cvt_pk_bf16(float lo, float hi) { const f32x2v v = {lo, hi}; const bf16x2v b = __builtin_convertvector(v, bf16x2v); return __builtin_bit_cast(unsigned, b); }
__device__ __forceinline__ bf16_t f2bf(float f) { return (bf16_t)(cvt_pk_bf16(f, 0.f) & 0xffffu); }
__device__ __forceinline__ float bf2f(bf16_t b) { return __uint_as_float(((unsigned)b) << 16); }
__device__ __forceinline__ float bflo(unsigned w) { return __uint_as_float(w << 16); }
__device__ __forceinline__ float bfhi(unsigned w) { return __uint_as_float(w & 0xffff0000u); }
__device__ __forceinline__ float shfl_xor_f(float v, int m) { return __int_as_float(__builtin_amdgcn_ds_bpermute((((int)(otid() & 63)) ^ m) << 2, __float_as_int(v))); }
__device__ __forceinline__ float wave_sum(float v) {
#pragma unroll
    for (int o = 32; o >= 1; o >>= 1) v += shfl_xor_f(v, o);
    return v;
}
__device__ __forceinline__ float fast_exp2(float x) { return __builtin_amdgcn_exp2f(x); }
__device__ __forceinline__ float siluf(float x) { return x * __builtin_amdgcn_rcpf(1.0f + __expf(-x)); }
__device__ __forceinline__ float sin_rr(float x) { float r = x * 0.15915494309189535f; r -= rintf(r); return __builtin_amdgcn_sinf(r); }
__device__ __forceinline__ float cos_rr(float x) { float r = x * 0.15915494309189535f; r -= rintf(r); return __builtin_amdgcn_cosf(r); }
__device__ __forceinline__ float sin_rev(float r) { r -= rintf(r); return __builtin_amdgcn_sinf(r); }
__device__ __forceinline__ float cos_rev(float r) { r -= rintf(r); return __builtin_amdgcn_cosf(r); }

__device__ __forceinline__ void xcd_barrier(unsigned* bar, volatile LAS unsigned* st);
namespace pg8 {
constexpr int BM = 256, BK = 64, HALF = 128, HTB = HALF * BK * 2, STAGE_BYTES = 8 * HTB, NXCD = 8, WGM = 8;
__device__ __forceinline__ int lds_byte(int r, int c) { const int st = (r >> 4) * 2 + (c >> 5), rr = r & 15, cc = c & 31, ob = rr * 64 + cc * 2; return st * 1024 + (ob ^ (((ob >> 9) & 1) << 5)); }
__device__ __forceinline__ void stage_rc(int b, int& R, int& C) { const int st = b / 1024, sb = b % 1024, swz = sb ^ (((sb >> 9) & 1) << 5); R = (st >> 1) * 16 + swz / 64; C = (st & 1) * 32 + (swz % 64) / 2; }
__device__ __forceinline__ int perm32(int rho) { const int n = rho >> 4, i = rho & 15; return 8 * (i >> 2) + 4 * n + (i & 3); }
struct Unit { int pm, pn; };
struct Gemm { const bf16_t* A; const bf16_t* Bt; int M, N, K; };
struct StaticOrder {
    int nM, nN, nwg, G, c;
    __device__ void init(int M, int N, int G_, int c_) { nM = M / BM; nN = N / BM; nwg = nM * nN; G = G_; c = c_; }
    __device__ bool next(int i, Unit& u) const {
        const long L = (long)i * G + c; if (L >= nwg) return false;
        int wgid = (int)L; { const int q = nwg / NXCD, r = nwg % NXCD, xcd = wgid % NXCD, off = wgid / NXCD; wgid = (xcd < r ? xcd * (q + 1) : r * (q + 1) + (xcd - r) * q) + off; }
        const int nig = WGM * nN, gid = wgid / nig, fm = gid * WGM, gsz = (nM - fm) < WGM ? (nM - fm) : WGM;
        u.pm = fm + ((wgid % nig) % gsz); u.pn = (wgid % nig) / gsz; return true;
    }
    __device__ __forceinline__ void a_ready(const Unit&) const {}
    __device__ __forceinline__ void done(const Unit&) const {}
};
struct EpiBf16 {
    static constexpr bool PERM = true, AFTER_DRAIN = false;
    bf16_t* O; int ldc;
    __device__ __forceinline__ void operator()(const f32x4 (&acc)[2][2][4][2], const Unit& u, int wr, int wc, int fr, int fq) const {
        const int row0 = u.pm * BM + wr * 64 + fr; const int col0 = u.pn * BM + wc * 32 + 8 * fq;
#pragma unroll
        for (int ai = 0; ai < 2; ++ai)
#pragma unroll
            for (int m = 0; m < 4; ++m) { bf16_t* rowp = O + (size_t)(row0 + ai * HALF + m * 16) * ldc + col0;
#pragma unroll
                for (int bj = 0; bj < 2; ++bj) { f32x4 v0 = acc[ai][bj][m][0], v1 = acc[ai][bj][m][1];
                    u32x4 w; w.x = cvt_pk_bf16(v0[0], v0[1]); w.y = cvt_pk_bf16(v0[2], v0[3]); w.z = cvt_pk_bf16(v1[0], v1[1]); w.w = cvt_pk_bf16(v1[2], v1[3]);
                    *(u32x4*)(rowp + bj * HALF) = w; } }
    }
};
struct EpiRes {
    static constexpr bool PERM = false, AFTER_DRAIN = true;
    bf16_t* X; const float* mod; int goff;
    bf16_t* An; const float* gnext; int scoff, shoff; unsigned long long* slots; unsigned tag; int fin; float* Y; unsigned* bar;
    __device__ __forceinline__ void fused(f32x4 (&acc)[2][2][4][2], const Unit& u, int wr, int wc, int fr, int fq, LAS unsigned char* lds) const {
        const int row0 = u.pm * BM + wr * 64 + fr, col0 = u.pn * BM + wc * 32 + 4 * fq;
        const int cond = u.pm < 32 ? 0 : (u.pm < 48 ? 1 : 2);
        const float* gp = mod + cond * 24576 + goff + col0;
        f32x4 gv[2][2];
#pragma unroll
        for (int bj = 0; bj < 2; ++bj)
#pragma unroll
            for (int n = 0; n < 2; ++n) gv[bj][n] = *(const f32x4*)(gp + bj * HALF + n * 16);
        float ss[2][4];
#pragma unroll
        for (int ai = 0; ai < 2; ++ai)
#pragma unroll
            for (int m = 0; m < 4; ++m) { bf16_t* rowp = X + (size_t)(row0 + ai * HALF + m * 16) * DM + col0; float t = 0.f;
#pragma unroll
                for (int bj = 0; bj < 2; ++bj)
#pragma unroll
                    for (int n = 0; n < 2; ++n) { u32x2* p = (u32x2*)(rowp + bj * HALF + n * 16); const u32x2 w = *p; f32x4 v = (f32x4){bflo(w.x), bfhi(w.x), bflo(w.y), bfhi(w.y)}; v += gv[bj][n] * acc[ai][bj][m][n];
                        if (!fin) *p = (u32x2){cvt_pk_bf16(v[0], v[1]), cvt_pk_bf16(v[2], v[3])}; acc[ai][bj][m][n] = v; t += v[0] * v[0] + v[1] * v[1] + v[2] * v[2] + v[3] * v[3]; }
                ss[ai][m] = t; }
        if (An == nullptr && !fin) return;
        LAS float* xl = (LAS float*)lds;
#pragma unroll
        for (int ai = 0; ai < 2; ++ai)
#pragma unroll
            for (int m = 0; m < 4; ++m) { float t = ss[ai][m]; t += shfl_xor_f(t, 16); t += shfl_xor_f(t, 32); if (fq == 0) xl[(ai * HALF + wr * 64 + m * 16 + fr) * 4 + wc] = t; }
        __syncthreads();
        const int tid = otid();
        if (tid < 256) {
            const f32x4 q = *(const LAS f32x4*)(xl + tid * 4); const float mine = q[0] + q[1] + q[2] + q[3];
            unsigned long long* sp = slots + ((size_t)u.pm * 4) * 256 + tid;
            (void)__hip_atomic_exchange(sp + (size_t)u.pn * 256, ((unsigned long long)tag << 32) | (unsigned long long)__float_as_uint(mine), __ATOMIC_RELAXED, __HIP_MEMORY_SCOPE_AGENT);
            float tot = mine;
#pragma unroll
            for (int k = 1; k < 4; ++k) { unsigned long long* o = sp + (size_t)((u.pn + k) & 3) * 256; unsigned long long v; unsigned spin = 0;
                for (;;) { v = __hip_atomic_load(o, __ATOMIC_RELAXED, __HIP_MEMORY_SCOPE_AGENT); if ((unsigned)(v >> 32) == tag) break; __builtin_amdgcn_s_sleep(1); if (++spin > (1u << 22)) break; }
                tot += __uint_as_float((unsigned)v); }
            xl[1024 + tid] = rsqrtf(tot * (1.0f / 1024.0f) + 1e-6f);
        }
        __syncthreads();
        if (fin) {
            xcd_barrier(bar, (volatile LAS unsigned*)(lds + LDS_BYTES - 16));
#pragma unroll
            for (int ai = 0; ai < 2; ++ai)
#pragma unroll
                for (int m = 0; m < 4; ++m) { const int rl = ai * HALF + wr * 64 + m * 16 + fr; const float rs = xl[1024 + rl]; float* rowp = Y + (size_t)(u.pm * BM + rl) * DM + col0;
#pragma unroll
                    for (int bj = 0; bj < 2; ++bj)
#pragma unroll
                        for (int n = 0; n < 2; ++n) { const f32x4 g4 = *(const f32x4*)(gnext + col0 + bj * HALF + n * 16); *(f32x4*)(rowp + bj * HALF + n * 16) = acc[ai][bj][m][n] * rs * g4; } }
            return;
        }
        f32x4 Gn[2][2], Sh[2][2];
#pragma unroll
        for (int bj = 0; bj < 2; ++bj)
#pragma unroll
            for (int n = 0; n < 2; ++n) { const int c = col0 + bj * HALF + n * 16; const f32x4 g4 = *(const f32x4*)(gnext + c), s4 = *(const f32x4*)(mod + cond * 24576 + scoff + c);
                Gn[bj][n] = g4 * (s4 + 1.0f); Sh[bj][n] = *(const f32x4*)(mod + cond * 24576 + shoff + c); }
#pragma unroll
        for (int ai = 0; ai < 2; ++ai)
#pragma unroll
            for (int m = 0; m < 4; ++m) { const int rl = ai * HALF + wr * 64 + m * 16 + fr; const int row = u.pm * BM + rl; const float rs = xl[1024 + rl];
                bf16_t* op = An + (size_t)row * DM + col0;
#pragma unroll
                for (int bj = 0; bj < 2; ++bj)
#pragma unroll
                    for (int n = 0; n < 2; ++n) { const f32x4 h = acc[ai][bj][m][n] * rs * Gn[bj][n] + Sh[bj][n];
                        *(u32x2*)(op + bj * HALF + n * 16) = (u32x2){cvt_pk_bf16(h[0], h[1]), cvt_pk_bf16(h[2], h[3])}; } }
    }
};

template <class Epi, class Sched>
__device__ __forceinline__ void gemm_phase(LAS unsigned char* lds, const Gemm g, const Sched& S, const Epi& E) {
    const int tid = otid(), wid = __builtin_amdgcn_readfirstlane(tid >> 6), lane = tid & 63, wr = wid >> 2, wc = wid & 3, fr = lane & 15, fq = lane >> 4;
    const int K = g.K, nt = K / BK;
    unsigned voffA[2], voffB[2];
#pragma unroll
    for (int i = 0; i < 2; ++i) { int R, C; stage_rc(tid * 16 + i * 8192, R, C); const int Rb = Epi::PERM ? ((R & ~31) + perm32(R & 31)) : R;
        voffA[i] = (unsigned)(R * K + C) * 2u; voffB[i] = (unsigned)(Rb * K + C) * 2u; }
    const size_t kstep = (size_t)(BK * 2);
    const size_t hstep = (size_t)HALF * K * 2;
    const size_t tstep = 2 * hstep;
    const unsigned ldsw = (unsigned)wid * 1024u;
    const int aoff = lds_byte(wr * 64 + fr, fq * 8), boff = lds_byte(wc * 32 + fr, fq * 8);
#define PG8_SA(b, h) (((b) * 2 + (h)) * HTB)
#define PG8_SB(b, h) ((4 + (b) * 2 + (h)) * HTB)
#define PG8_STAGE(bufoff, gbase, voff) do { _Pragma("unroll") for (int _i = 0; _i < 2; ++_i) \
        __builtin_amdgcn_global_load_lds((const unsigned*)((const char*)(gbase) + (voff)[_i]), (LAS unsigned*)(lds + (bufoff) + ldsw + _i * 8192), 16, 0, 0); } while (0)
#define PG8_LDA(dst, b, h) do { _Pragma("unroll") for (int m = 0; m < 4; ++m) _Pragma("unroll") for (int k = 0; k < 2; ++k) dst[m][k] = *(const LAS bf16x8*)(lds + PG8_SA(b, h) + aoff + m * 2048 + k * 1024); } while (0)
#define PG8_LDB(dst, b, h) do { _Pragma("unroll") for (int n = 0; n < 2; ++n) _Pragma("unroll") for (int k = 0; k < 2; ++k) dst[n][k] = *(const LAS bf16x8*)(lds + PG8_SB(b, h) + boff + n * 2048 + k * 1024); } while (0)
#define PG8_MMA(ai, bj, At, Bt) do { __builtin_amdgcn_s_setprio(1); _Pragma("unroll") for (int m = 0; m < 4; ++m) _Pragma("unroll") for (int n = 0; n < 2; ++n) _Pragma("unroll") for (int k = 0; k < 2; ++k) \
        acc[ai][bj][m][n] = __builtin_amdgcn_mfma_f32_16x16x32_bf16(Bt[n][k], At[m][k], acc[ai][bj][m][n], 0, 0, 0); __builtin_amdgcn_s_setprio(0); } while (0)
#define PG8_WAIT_V(n) asm volatile("s_waitcnt vmcnt(" #n ")" ::: "memory")
#define PG8_WAIT_L(n) asm volatile("s_waitcnt lgkmcnt(" #n ")" ::: "memory")
#define PG8_BAR __builtin_amdgcn_s_barrier()
#define PG8_SCHED __builtin_amdgcn_sched_barrier(0)
    Unit cur, nxt; int ui = 0;
    if (!S.next(0, cur)) return;
    f32x4 acc[2][2][4][2];
#pragma unroll
    for (int a = 0; a < 2; ++a)
#pragma unroll
        for (int b = 0; b < 2; ++b)
#pragma unroll
            for (int m = 0; m < 4; ++m)
#pragma unroll
                for (int n = 0; n < 2; ++n) acc[a][b][m][n] = (f32x4){0.f, 0.f, 0.f, 0.f};
    bf16x8 At[4][2], B0[2][2], B1[2][2];
    const char* cA = (const char*)g.A + (size_t)cur.pm * tstep; const char* cB = (const char*)g.Bt + (size_t)cur.pn * tstep;
    S.a_ready(cur);
    PG8_STAGE(PG8_SB(0, 0), cB, voffB); PG8_STAGE(PG8_SA(0, 0), cA, voffA); PG8_STAGE(PG8_SB(0, 1), cB + hstep, voffB); PG8_STAGE(PG8_SA(0, 1), cA + hstep, voffA);
    if (wr == 1) PG8_BAR;
    PG8_WAIT_V(4); PG8_BAR;
    PG8_STAGE(PG8_SB(1, 0), cB + kstep, voffB); PG8_STAGE(PG8_SA(1, 0), cA + kstep, voffA); PG8_STAGE(PG8_SB(1, 1), cB + hstep + kstep, voffB);
    PG8_WAIT_V(6); PG8_BAR;
    for (;;) {
        const bool has_next = S.next(ui + 1, nxt);
        const char* nA = has_next ? (const char*)g.A + (size_t)nxt.pm * tstep : cA; const char* nB = has_next ? (const char*)g.Bt + (size_t)nxt.pn * tstep : cB;
        for (int t = 0; t < nt; t += 2) {
            const bool last = (t == nt - 2);
            const char* a1 = cA + (size_t)(t + 1) * kstep;
            const char* a2 = last ? nA : cA + (size_t)(t + 2) * kstep; const char* b2 = last ? nB : cB + (size_t)(t + 2) * kstep;
            const char* a3 = a2 + kstep; const char* b3 = b2 + kstep;
            if (last && has_next) S.a_ready(nxt);
            PG8_LDB(B0, 0, 0); PG8_SCHED; PG8_LDA(At, 0, 0); PG8_STAGE(PG8_SA(1, 1), a1 + hstep, voffA);
            PG8_WAIT_L(8); PG8_BAR; PG8_WAIT_L(0); PG8_MMA(0, 0, At, B0); PG8_BAR; PG8_SCHED;
            PG8_LDB(B1, 0, 1); PG8_STAGE(PG8_SB(0, 0), b2, voffB);
            PG8_BAR; PG8_WAIT_L(0); PG8_MMA(0, 1, At, B1); PG8_BAR;
            PG8_LDA(At, 0, 1); PG8_STAGE(PG8_SA(0, 0), a2, voffA);
            PG8_BAR; PG8_WAIT_L(0); PG8_MMA(1, 0, At, B0); PG8_BAR; PG8_SCHED;
            PG8_STAGE(PG8_SB(0, 1), b2 + hstep, voffB);
            PG8_WAIT_V(6); PG8_BAR; PG8_MMA(1, 1, At, B1); PG8_BAR;
            PG8_LDB(B0, 1, 0); PG8_SCHED; PG8_LDA(At, 1, 0); PG8_STAGE(PG8_SA(0, 1), a2 + hstep, voffA);
            PG8_WAIT_L(8); PG8_BAR; PG8_WAIT_L(0); PG8_MMA(0, 0, At, B0); PG8_BAR; PG8_SCHED;
            PG8_LDB(B1, 1, 1); PG8_STAGE(PG8_SB(1, 0), b3, voffB);
            PG8_BAR; PG8_WAIT_L(0); PG8_MMA(0, 1, At, B1); PG8_BAR;
            PG8_LDA(At, 1, 1); PG8_STAGE(PG8_SA(1, 0), a3, voffA);
            PG8_BAR; PG8_WAIT_L(0); PG8_MMA(1, 0, At, B0); PG8_BAR; PG8_SCHED;
            PG8_STAGE(PG8_SB(1, 1), b3 + hstep, voffB);
            PG8_WAIT_V(6); PG8_BAR; PG8_MMA(1, 1, At, B1); PG8_BAR;
        }
        if constexpr (!Epi::AFTER_DRAIN) { E(acc, cur, wr, wc, fr, fq); S.done(cur); }
        if (!has_next) break;
#pragma unroll
        for (int a = 0; a < 2; ++a)
#pragma unroll
            for (int b = 0; b < 2; ++b)
#pragma unroll
                for (int m = 0; m < 4; ++m)
#pragma unroll
                    for (int n = 0; n < 2; ++n) acc[a][b][m][n] = (f32x4){0.f, 0.f, 0.f, 0.f};
        cur = nxt; cA = nA; cB = nB; ++ui;
    }
    PG8_WAIT_V(0);
    if (wr == 0) PG8_BAR;
    PG8_BAR;
    if constexpr (Epi::AFTER_DRAIN) { E.fused(acc, cur, wr, wc, fr, fq, lds); S.done(cur); }
#undef PG8_SA
#undef PG8_SB
#undef PG8_STAGE
#undef PG8_LDA
#undef PG8_LDB
#undef PG8_MMA
#undef PG8_WAIT_V
#undef PG8_WAIT_L
#undef PG8_BAR
#undef PG8_SCHED
}
}

template <bool P16 = false>
__device__ __forceinline__ void wconv_tile(const float* __restrict__ src, int N, bf16_t* __restrict__ dst, int ldd, int kt, int ntile, LAS float* tl) {
    const int tid = otid();
#pragma unroll
    for (int i = 0; i < 2; ++i) { const int k = (tid >> 4) + 32 * i, n4 = (tid & 15) * 4;
        const f32x4 v = *(const f32x4*)(src + (size_t)(kt * 64 + k) * N + ntile * 64 + n4);
        tl[k * 65 + n4] = v[0]; tl[k * 65 + n4 + 1] = v[1]; tl[k * 65 + n4 + 2] = v[2]; tl[k * 65 + n4 + 3] = v[3]; }
    __syncthreads();
    { const int n = tid >> 3, k8 = (tid & 7) * 8; u32x4 w;
      w.x = cvt_pk_bf16(tl[(k8 + 0) * 65 + n], tl[(k8 + 1) * 65 + n]); w.y = cvt_pk_bf16(tl[(k8 + 2) * 65 + n], tl[(k8 + 3) * 65 + n]);
      w.z = cvt_pk_bf16(tl[(k8 + 4) * 65 + n], tl[(k8 + 5) * 65 + n]); w.w = cvt_pk_bf16(tl[(k8 + 6) * 65 + n], tl[(k8 + 7) * 65 + n]);
      if (P16) { const int odd = (tid & 1); bf16_t* d = dst + (size_t)(ntile * 64 + n) * ldd + kt * 64;
          *(u32x2*)(d + (odd ? k8 - 4 : k8)) = (u32x2){w.x, w.y}; *(u32x2*)(d + (odd ? k8 + 4 : k8 + 8)) = (u32x2){w.z, w.w}; }
      else *(u32x4*)(dst + (size_t)(ntile * 64 + n) * ldd + kt * 64 + k8) = w; }
    __syncthreads();
}
__device__ void wconv(const float* src, int K, int N, bf16_t* dst, LAS unsigned char* lds, int& rot) {
    const int nk = K / 64, nn = N / 64, tot = nk * nn;
    int start = (int)blockIdx.x - rot; while (start < 0) start += gridDim.x;
    for (int it = start; it < tot; it += gridDim.x) wconv_tile(src, N, dst, K, it / nn, it % nn, (LAS float*)lds);
    rot = (rot + tot) % (int)gridDim.x;
}
template <int NQ, bool P16 = false>
__device__ __forceinline__ void vt_tile(const bf16_t* __restrict__ src, int ld, bf16_t* __restrict__ dst, size_t ldd, LAS bf16_t* tl) {
    const int tid = otid();
    { const int r = tid >> 3, c8 = (tid & 7) * 8; u32x4 v[NQ];
#pragma unroll
      for (int q = 0; q < NQ; ++q) v[q] = *(const u32x4*)(src + (size_t)r * ld + q * 64 + c8);
#pragma unroll
      for (int q = 0; q < NQ; ++q) *(LAS u32x4*)(tl + q * 4608 + r * 72 + c8) = v[q]; }
    __syncthreads();
    { const int c = tid >> 3, t8 = (tid & 7) * 8;
#pragma unroll
      for (int q = 0; q < NQ; ++q) { unsigned w[4];
#pragma unroll
          for (int j = 0; j < 4; ++j) w[j] = (unsigned)tl[q * 4608 + (t8 + 2 * j) * 72 + c] | ((unsigned)tl[q * 4608 + (t8 + 2 * j + 1) * 72 + c] << 16);
          if (P16) { const int odd = (tid & 1); bf16_t* d = dst + (size_t)(q * 64 + c) * ldd;
              *(u32x2*)(d + (odd ? t8 - 4 : t8)) = (u32x2){w[0], w[1]}; *(u32x2*)(d + (odd ? t8 + 4 : t8 + 8)) = (u32x2){w[2], w[3]}; }
          else *(u32x4*)(dst + (size_t)(q * 64 + c) * ldd + t8) = (u32x4){w[0], w[1], w[2], w[3]}; } }
    __syncthreads();
}
template <bool P16 = false>
__device__ void vt_all(const bf16_t* U, int ld, int vc0, int C, bf16_t* VtP, bf16_t* VtS, int LK, int koff, LAS unsigned char* lds) {
    const int nct = C / 256, tot = (NT / 64) * nct;
    for (int it = blockIdx.x; it < tot; it += gridDim.x) {
        const int tt = it / nct, ct = it % nct, t0 = tt * 64;
        const bf16_t* src = U + (size_t)t0 * ld + vc0 + ct * 256;
        if (t0 < NTP) { const int b = t0 >> 8, tp = t0 & 255; vt_tile<4, P16>(src, ld, VtP + ((size_t)b * C + ct * 256) * 256 + tp, 256, (LAS bf16_t*)lds); }
        else { const int ts = t0 - NTP, b = ts >> 12, tp = ts & 4095; vt_tile<4, P16>(src, ld, VtS + ((size_t)b * C + ct * 256) * LK + koff + tp, (size_t)LK, (LAS bf16_t*)lds); }
    }
}
__device__ void norm_mod(const bf16_t* __restrict__ X, const float* __restrict__ g, const float* __restrict__ mod, int scoff, int shoff, bf16_t* __restrict__ H) {
    const int lane = otid() & 63, gw = blockIdx.x * 8 + (otid() >> 6), nw = gridDim.x * 8;
    for (int r = gw; r < NT; r += nw) {
        const int cond = r < NTP ? 0 : (r < NTP + 4096 ? 1 : 2);
        const bf16_t* xr = X + (size_t)r * DM; const float* mp = mod + cond * 24576;
        f32x4 v[4]; float ss = 0.f;
#pragma unroll
        for (int i = 0; i < 4; ++i) { const u32x2 w = *(const u32x2*)(xr + i * 256 + lane * 4); v[i] = (f32x4){bflo(w.x), bfhi(w.x), bflo(w.y), bfhi(w.y)}; ss += v[i][0] * v[i][0] + v[i][1] * v[i][1] + v[i][2] * v[i][2] + v[i][3] * v[i][3]; }
        ss = wave_sum(ss); const float rs = rsqrtf(ss * (1.0f / DM) + 1e-6f);
#pragma unroll
        for (int i = 0; i < 4; ++i) { const int c = i * 256 + lane * 4; const f32x4 gg = *(const f32x4*)(g + c), sc = *(const f32x4*)(mp + scoff + c), sh = *(const f32x4*)(mp + shoff + c);
            float o[4];
#pragma unroll
            for (int j = 0; j < 4; ++j) o[j] = v[i][j] * rs * gg[j] * (1.0f + sc[j]) + sh[j];
            *(u32x2*)(H + (size_t)r * DM + c) = (u32x2){cvt_pk_bf16(o[0], o[1]), cvt_pk_bf16(o[2], o[3])}; }
    }
}
__device__ void final_norm(float* __restrict__ X, const float* __restrict__ g) {
    const int lane = otid() & 63, gw = blockIdx.x * 8 + (otid() >> 6), nw = gridDim.x * 8;
    for (int r = gw; r < NT; r += nw) {
        float* xr = X + (size_t)r * DM; f32x4 v[4]; float ss = 0.f;
#pragma unroll
        for (int i = 0; i < 4; ++i) { v[i] = *(const f32x4*)(xr + i * 256 + lane * 4); ss += v[i][0] * v[i][0] + v[i][1] * v[i][1] + v[i][2] * v[i][2] + v[i][3] * v[i][3]; }
        ss = wave_sum(ss); const float rs = rsqrtf(ss * (1.0f / DM) + 1e-6f);
#pragma unroll
        for (int i = 0; i < 4; ++i) { const int c = i * 256 + lane * 4; const f32x4 gg = *(const f32x4*)(g + c); f32x4 o;
#pragma unroll
            for (int j = 0; j < 4; ++j) o[j] = v[i][j] * rs * gg[j];
            *(f32x4*)(xr + c) = o; }
    }
}
__device__ void prep_misc(const Params& p, LAS unsigned char* lds) {
    const int tid = otid(); const size_t gt = (size_t)blockIdx.x * 512 + tid, ng = (size_t)gridDim.x * 512;
    { const f32x4* a = (const f32x4*)p.in[I_XP]; const f32x4* b = (const f32x4*)p.in[I_XS]; u32x2* o = (u32x2*)((unsigned char*)p.out + XR_OFF); const size_t n4 = (size_t)NTP * DM / 4;
      for (size_t i = gt; i < n4; i += ng) { const f32x4 va = a[i], vb = b[i]; o[i] = (u32x2){cvt_pk_bf16(va[0], va[1]), cvt_pk_bf16(va[2], va[3])}; o[n4 + i] = (u32x2){cvt_pk_bf16(vb[0], vb[1]), cvt_pk_bf16(vb[2], vb[3])}; } }
    { bf16_t* id = (bf16_t*)(p.ws + WS_IDENT); for (size_t i = gt; i < 65536; i += ng) id[i] = ((i >> 8) == (i & 255)) ? (bf16_t)0x3F80 : (bf16_t)0; }
    { bf16_t* idw = (bf16_t*)(p.ws + WS_IDENTW); for (size_t i = gt; i < 65536; i += ng) idw[(i >> 8) * 6144 + (i & 255)] = ((i >> 8) == (i & 255)) ? (bf16_t)0x3F80 : (bf16_t)0; }
    LAS float* sc = (LAS float*)lds;
    LAS float* red = sc + 3072;
    for (int i = tid; i < 3072; i += 512) { const int c = i >> 10, k = i & 1023; const float v = c == 0 ? p.in[I_CCTX][k] : p.in[I_C][(c - 1) * 1024 + k]; sc[i] = siluf(v); }
    __syncthreads();
    float* mod = (float*)(p.ws + WS_MOD);
    for (int it = blockIdx.x; it < 4 * 96; it += gridDim.x) {
        const int l = it / 96, n0 = (it % 96) * 64, col = tid & 63, kq = tid >> 6;
        const float* w = p.in[I_WMOD] + (size_t)l * 1024 * 6144 + n0 + col;
        float a0 = 0.f, a1 = 0.f, a2 = 0.f;
#pragma unroll 8
        for (int k = kq * 128; k < kq * 128 + 128; ++k) { const float wv = w[(size_t)k * 6144]; a0 += sc[k] * wv; a1 += sc[1024 + k] * wv; a2 += sc[2048 + k] * wv; }
        red[(kq * 3 + 0) * 64 + col] = a0; red[(kq * 3 + 1) * 64 + col] = a1; red[(kq * 3 + 2) * 64 + col] = a2;
        __syncthreads();
        if (tid < 192) { const int c = tid >> 6; float s = p.in[I_BMOD][l * 6144 + n0 + col];
#pragma unroll
            for (int q = 0; q < 8; ++q) s += red[(q * 3 + c) * 64 + col];
            mod[c * 24576 + l * 6144 + n0 + col] = s; }
        __syncthreads();
    }
}

struct RopeCS { float cs[8], sn[8]; };
__device__ __forceinline__ void rope_cs8(int lane, int tp, RopeCS& r) {
    const int k = lane & 7; const float pos = (float)((k < 4) ? (tp >> 6) : (tp & 63));
#pragma unroll
    for (int j = 0; j < 8; ++j) { const float ang = pos * fast_exp2(-(float)(8 * (k & 1) + j) * (13.287712379549449f / 16.0f)); r.cs[j] = cos_rr(ang); r.sn[j] = sin_rr(ang); }
}
__device__ __forceinline__ void rope8(float* x, int lane, const RopeCS& r) {
    const bool second = (lane & 2) != 0;
#pragma unroll
    for (int j = 0; j < 8; ++j) { const float pr = shfl_xor_f(x[j], 2); x[j] = second ? (pr * r.sn[j] + x[j] * r.cs[j]) : (x[j] * r.cs[j] - pr * r.sn[j]); }
}
__device__ __forceinline__ void unpack8(const u32x4 w, float* x) {
#pragma unroll
    for (int j = 0; j < 4; ++j) { x[2 * j] = bflo(w[j]); x[2 * j + 1] = bfhi(w[j]); }
}
__device__ __forceinline__ u32x4 pack8(const float* x) { return (u32x4){cvt_pk_bf16(x[0], x[1]), cvt_pk_bf16(x[2], x[3]), cvt_pk_bf16(x[4], x[5]), cvt_pk_bf16(x[6], x[7])}; }
__device__ __forceinline__ void rms8(float* x, const float* gn) {
    float ss = 0.f;
#pragma unroll
    for (int j = 0; j < 8; ++j) ss += x[j] * x[j];
    ss += shfl_xor_f(ss, 1); ss += shfl_xor_f(ss, 2); ss += shfl_xor_f(ss, 4);
    const float rs = rsqrtf(ss * (1.0f / 64.0f) + 1e-6f);
#pragma unroll
    for (int j = 0; j < 8; ++j) x[j] = x[j] * rs * gn[j];
}
__device__ void post_attn(const Params& p, bf16_t* U, bf16_t* KS, bf16_t* VtS, LAS unsigned char* lds) {
    float ckrun = 0.f;
    const int lane = otid() & 63, gw = blockIdx.x * 8 + (otid() >> 6), nw = gridDim.x * 8;
    float qg[8], kg[8];
#pragma unroll
    for (int j = 0; j < 8; ++j) { qg[j] = p.in[I_AQG][(lane & 7) * 8 + j]; kg[j] = p.in[I_AKG][(lane & 7) * 8 + j]; }
    float* nak = p.out + OUT_NAK; float* nav = p.out + OUT_NAV;
    for (int t = gw; t < NT + 512; t += nw) {
        if (t < NT) {
            const bool smp = t >= NTP; const int ts = t - NTP; const int b = smp ? (ts >> 12) : (t >> 8), tp = smp ? (ts & 4095) : (t & 255);
            bf16_t* ur = U + (size_t)t * 1536 + lane * 8;
            const u32x4 w0 = *(const u32x4*)ur, w1 = *(const u32x4*)(ur + 512), w2 = *(const u32x4*)(ur + 1024);
            RopeCS rc; if (smp) rope_cs8(lane, tp, rc);
            float x[8];
            unpack8(w0, x); rms8(x, qg); if (smp) rope8(x, lane, rc); *(u32x4*)ur = pack8(x);
            unpack8(w1, x); rms8(x, qg); if (smp) rope8(x, lane, rc); *(u32x4*)(ur + 512) = pack8(x);
            unpack8(w2, x);
            float y[8];
#pragma unroll
            for (int j = 0; j < 8; ++j) y[j] = x[j];
            rms8(y, kg); if (smp) rope8(y, lane, rc);
            if (lane < 32) {
                if (!smp) { *(u32x4*)(ur + 1024) = pack8(y); float* o = nak + (size_t)t * 256 + lane * 8; *(f32x4*)o = (f32x4){y[0], y[1], y[2], y[3]}; *(f32x4*)(o + 4) = (f32x4){y[4], y[5], y[6], y[7]}; }
                else *(u32x4*)(KS + ((size_t)b * 4352 + 256 + tp) * 256 + lane * 8) = pack8(y);
            } else if (!smp) { float* o = nav + (size_t)t * 256 + (lane - 32) * 8; *(f32x4*)o = (f32x4){x[0], x[1], x[2], x[3]}; *(f32x4*)(o + 4) = (f32x4){x[4], x[5], x[6], x[7]}; }
        } else {
            const int ci = t - NT, b = ci >> 8, m = ci & 255;
            for (int kh = 0; kh < 4; ++kh) {
                const bf16_t kb16 = f2bf(p.in[I_CAK][((size_t)(b * 256 + m) * 4 + kh) * 64 + lane]);
                KS[((size_t)b * 4352 + m) * 256 + kh * 64 + lane] = kb16;
                const float kn = wave_sum(bf2f(kb16) * bf2f(kb16));
                ckrun = fmaxf(ckrun, kn);
                VtS[((size_t)(b * 4 + kh) * 64 + lane) * 4352 + m] = f2bf(p.in[I_CAV][((size_t)(b * 256 + m) * 4 + kh) * 64 + lane]);
            }
        }
    }
    { LAS float* red = (LAS float*)lds; const int wid = otid() >> 6;
      if ((otid() & 63) == 0) red[wid] = ckrun;
      __syncthreads();
      if (otid() == 0) { float m = 0.f; for (int i = 0; i < 8; ++i) m = fmaxf(m, red[i]); if (m > 0.f) atomicMax((unsigned*)(p.ws + WS_CKMAX), __float_as_uint(m)); }
      __syncthreads(); }
}
__device__ __forceinline__ float subhead_maxsq(const float* x) {
    float ss = 0.f;
#pragma unroll
    for (int j = 0; j < 8; ++j) ss += x[j] * x[j];
    ss += shfl_xor_f(ss, 1); ss += shfl_xor_f(ss, 2); ss += shfl_xor_f(ss, 4);
    ss = fmaxf(ss, shfl_xor_f(ss, 8)); ss = fmaxf(ss, shfl_xor_f(ss, 16)); ss = fmaxf(ss, shfl_xor_f(ss, 32));
    return ss;
}
__device__ void post_diff(const Params& p, bf16_t* U, bf16_t* KS, bf16_t* VtS, LAS unsigned char* lds) {
    const int lane = otid() & 63, gw = blockIdx.x * 8 + (otid() >> 6), nw = gridDim.x * 8;
    float* ndk = p.out + OUT_NDK; float* ndv = p.out + OUT_NDV;
    float qrun = 0.f, krun = 0.f;
    for (int t = gw; t < NT + 512; t += nw) {
        if (t < NT) {
            const bool smp = t >= NTP; const int ts = t - NTP; const int b = smp ? (ts >> 12) : (t >> 8), tp = smp ? (ts & 4095) : (t & 255);
            bf16_t* ur = U + (size_t)t * 3072 + lane * 8;
            float qm = 0.f, km = 0.f;
            if (!smp) {
                u32x4 w[4], wq[2];
#pragma unroll
                for (int c = 0; c < 4; ++c) w[c] = *(const u32x4*)(ur + 1024 + c * 512);
                wq[0] = *(const u32x4*)ur; wq[1] = *(const u32x4*)(ur + 512);
#pragma unroll
                for (int c = 0; c < 4; ++c) { float x[8]; unpack8(w[c], x); float* o = (c < 2 ? ndk : ndv) + (size_t)t * 1024 + (c & 1) * 512 + lane * 8;
                    if (c < 2) km = fmaxf(km, subhead_maxsq(x));
                    *(f32x4*)o = (f32x4){x[0], x[1], x[2], x[3]}; *(f32x4*)(o + 4) = (f32x4){x[4], x[5], x[6], x[7]}; }
#pragma unroll
                for (int c = 0; c < 2; ++c) { float x[8]; unpack8(wq[c], x); qm = fmaxf(qm, subhead_maxsq(x)); }
            } else {
                u32x4 w[4];
#pragma unroll
                for (int c = 0; c < 4; ++c) w[c] = *(const u32x4*)(ur + c * 512);
                RopeCS rc; rope_cs8(lane, tp, rc);
#pragma unroll
                for (int c = 0; c < 4; ++c) { float x[8]; unpack8(w[c], x); const float m2 = subhead_maxsq(x); if (c < 2) qm = fmaxf(qm, m2); else km = fmaxf(km, m2); rope8(x, lane, rc);
                    if (c < 2) *(u32x4*)(ur + c * 512) = pack8(x); else *(u32x4*)(KS + ((size_t)b * 4352 + 256 + tp) * 1024 + (c - 2) * 512 + lane * 8) = pack8(x); }
            }
            qrun = fmaxf(qrun, qm); krun = fmaxf(krun, km);
        } else {
            const int ci = t - NT, b = ci >> 8, m = ci & 255;
            for (int j = 0; j < 16; ++j) { const int c = j * 64 + lane;
                const bf16_t kb16 = f2bf(p.in[I_CDK][(size_t)(b * 256 + m) * 1024 + c]); const float kn = wave_sum(bf2f(kb16) * bf2f(kb16));
                krun = fmaxf(krun, kn);
                KS[((size_t)b * 4352 + m) * 1024 + c] = kb16;
                VtS[((size_t)b * 1024 + c) * 4352 + m] = f2bf(p.in[I_CDV][(size_t)(b * 256 + m) * 1024 + c]); }
        }
    }
    { LAS float* red = (LAS float*)lds; const int wid = otid() >> 6;
      if (lane == 0) { red[wid] = qrun; red[8 + wid] = krun; }
      __syncthreads();
      if (otid() == 0) { float a = 0.f, b2 = 0.f;
          for (int i = 0; i < 8; ++i) { a = fmaxf(a, red[i]); b2 = fmaxf(b2, red[8 + i]); }
          atomicMax((unsigned*)(p.ws + WS_DQMAX), __float_as_uint(a)); atomicMax((unsigned*)(p.ws + WS_DQMAX) + 1, __float_as_uint(b2)); }
      __syncthreads(); }
}

struct FlashArgs {
    const bf16_t* q; int ldq;
    const bf16_t* k; int ldk;
    const bf16_t* vt; int ldvt;
    const bf16_t* ident;
    int nreal, ntiles, kcol;
    bf16_t* out; int ldo;
    float* outf;
    float qscale; float fixm;
    float lgf, lgb; int n0, L, dir, half;
    float lam, onem; const float* subg;
};

template <int DK, int DV, int MODE, bool FXC = false>
__device__ __forceinline__ void flash_item(LAS unsigned char* lds, const FlashArgs& a) {
    constexpr int KW = (MODE == 1) ? 2 * DK : DK, KLD = KW + 8, VLD = 72, KB = 64 * KLD * 2, VB = DV * VLD * 2, STG = KB + VB;
    constexpr int NKC = KW / 64, NVC = DV / 64, NS = DK / 16, ND = DV / 32;
    static_assert(2 * STG <= LDS_BYTES, "lds");
    const int tid = otid(), lane = tid & 63, lr = lane & 31, g = lane >> 5;
    bf16x8 qf[NS];
#pragma unroll
    for (int s = 0; s < NS; ++s) {
        u32x4 w = *(const u32x4*)(a.q + (size_t)lr * a.ldq + s * 16 + g * 8);
        if (MODE <= 1) {
#pragma unroll
            for (int j = 0; j < 4; ++j) w[j] = cvt_pk_bf16(bflo(w[j]) * a.qscale, bfhi(w[j]) * a.qscale);
        }
        qf[s] = __builtin_bit_cast(bf16x8, w);
    }
    f32x16 O[ND];
#pragma unroll
    for (int d = 0; d < ND; ++d)
#pragma unroll
        for (int r = 0; r < 16; ++r) O[d][r] = 0.f;
    float m_run = -1e30f, l_run = 0.f;
    if constexpr (MODE >= 2) {
        static_assert(DK == 256 && DV == 128, "ret path shapes");
        constexpr int KB2 = 64 * 512, VB2 = 256 * 128, STG2 = KB2 + VB2;
        static_assert(2 * STG2 + 16384 <= LDS_BYTES - 16, "ret lds");
        const int wid_u = __builtin_amdgcn_readfirstlane(tid >> 6);
        const int nt = a.ntiles;
        unsigned koff[4], voff[4];
#pragma unroll
        for (int i = 0; i < 4; ++i) { const int blk = wid_u * 4 + i;
            { const int row = 2 * blk + (lane >> 5), pos = lane & 31, c = pos ^ (row & 31); koff[i] = (unsigned)(row * a.ldk + c * 8) * 2u; }
            { const int row = 8 * blk + (lane >> 3), pos = lane & 7, c = pos ^ ((row >> 1) & 7); voff[i] = (unsigned)(row * a.ldvt + c * 8) * 2u; } }
        auto dma = [&](int t, int buf) {
            const char* kbase = (t * 64 >= a.nreal) ? (const char*)a.ident + (size_t)((t * 64 - a.nreal) & 255) * a.ldk * 2 : (const char*)a.k + (size_t)t * 64 * a.ldk * 2;
            const char* vbase = (const char*)a.vt + (size_t)t * 128;
            LAS unsigned char* base = lds + buf * STG2;
#pragma unroll
            for (int i = 0; i < 4; ++i) __builtin_amdgcn_global_load_lds((const unsigned*)(kbase + koff[i]), (LAS unsigned*)(base + (wid_u * 4 + i) * 1024), 16, 0, 0);
#pragma unroll
            for (int i = 0; i < 4; ++i) __builtin_amdgcn_global_load_lds((const unsigned*)(vbase + voff[i]), (LAS unsigned*)(base + KB2 + (wid_u * 4 + i) * 1024), 16, 0, 0);
        };
        auto unif = [](float v) { return __int_as_float(__builtin_amdgcn_readfirstlane(__float_as_int(v))); };
        const float f1 = unif(fast_exp2(-a.lgf)), f2 = unif(f1 * f1), f3 = unif(f2 * f1), f8 = unif(fast_exp2(-8.0f * a.lgf));
        const float b1 = unif(fast_exp2(a.lgb)), b2 = unif(b1 * b1), b3 = unif(b2 * b1), b8 = unif(fast_exp2(8.0f * a.lgb));
        LAS unsigned char* pbuf = lds + 2 * STG2;
        auto compute2 = [&](int t) {
            const LAS unsigned char* kb = lds + (t & 1) * STG2; const LAS unsigned char* vb = kb + KB2;
            const int n = a.n0 + lr, m0 = t * 64, half = a.half;
            const unsigned ka0 = (unsigned)(size_t)(kb + (half * 32 + lr) * 512) + (unsigned)((g ^ lr) << 4);
            auto kfrag = [&](int s_) { return *(const LAS bf16x8*)(size_t)(ka0 ^ (unsigned)(s_ << 5)); };
            f32x16 S;
#pragma unroll
            for (int r = 0; r < 16; ++r) S[r] = 0.f;
            bf16x8 ka[2], kc[2];
            ka[0] = kfrag(0); ka[1] = kfrag(1);
#pragma unroll
            for (int grp = 0; grp < 8; ++grp) {
                if (grp < 7) { if (grp & 1) { ka[0] = kfrag(2 * grp + 2); ka[1] = kfrag(2 * grp + 3); } else { kc[0] = kfrag(2 * grp + 2); kc[1] = kfrag(2 * grp + 3); } }
                __builtin_amdgcn_sched_barrier(0);
                if (grp & 1) { S = __builtin_amdgcn_mfma_f32_32x32x16_bf16(kc[0], qf[2 * grp], S, 0, 0, 0); S = __builtin_amdgcn_mfma_f32_32x32x16_bf16(kc[1], qf[2 * grp + 1], S, 0, 0, 0); }
                else { S = __builtin_amdgcn_mfma_f32_32x32x16_bf16(ka[0], qf[2 * grp], S, 0, 0, 0); S = __builtin_amdgcn_mfma_f32_32x32x16_bf16(ka[1], qf[2 * grp + 1], S, 0, 0, 0); }
                __builtin_amdgcn_sched_barrier(0);
            }
            const int mb = m0 + half * 32;
            if (MODE == 2) {
                if (m0 < a.nreal) {
                    if (mb + 31 < a.n0) {
                        float c4 = 0.0625f * fast_exp2((float)(n - mb - 4 * g) * a.lgf);
#pragma unroll
                        for (int q4 = 0; q4 < 4; ++q4) { S[4 * q4] *= c4; S[4 * q4 + 1] *= c4 * f1; S[4 * q4 + 2] *= c4 * f2; S[4 * q4 + 3] *= c4 * f3; c4 *= f8; }
                    } else if (mb > a.n0 + 31) {
                        float c4 = 0.0625f * fast_exp2((float)(mb + 4 * g - n) * a.lgb);
#pragma unroll
                        for (int q4 = 0; q4 < 4; ++q4) { S[4 * q4] *= c4; S[4 * q4 + 1] *= c4 * b1; S[4 * q4 + 2] *= c4 * b2; S[4 * q4 + 3] *= c4 * b3; c4 *= b8; }
                    } else {
#pragma unroll
                        for (int r = 0; r < 16; ++r) { const int m = mb + 8 * (r >> 2) + 4 * g + (r & 3); const int df = n - m;
                            const float e = df > 0 ? (float)df * a.lgf : (float)(-df) * a.lgb; float f = fast_exp2(e) * 0.0625f; if (df == 0) f = 0.125f; S[r] *= f; }
                    }
                } else {
                    const float f = ((m0 - a.nreal) < 256) ? fast_exp2((float)(n + 1) * a.lgf) : fast_exp2((float)(a.L - n) * a.lgb);
#pragma unroll
                    for (int r = 0; r < 16; ++r) S[r] *= f;
                }
            } else {
#pragma unroll
                for (int r = 0; r < 16; ++r) { const int m = mb + 8 * (r >> 2) + 4 * g + (r & 3);
                    const float e = a.dir == 0 ? (float)(a.L - 1 - m) * a.lgf : (float)m * a.lgb; S[r] *= fast_exp2(e) * 0.0625f; }
            }
            u32x4 pw0, pw1;
            pw0.x = cvt_pk_bf16(S[0], S[1]); pw0.y = cvt_pk_bf16(S[2], S[3]); pw0.z = cvt_pk_bf16(S[4], S[5]); pw0.w = cvt_pk_bf16(S[6], S[7]);
            pw1.x = cvt_pk_bf16(S[8], S[9]); pw1.y = cvt_pk_bf16(S[10], S[11]); pw1.z = cvt_pk_bf16(S[12], S[13]); pw1.w = cvt_pk_bf16(S[14], S[15]);
            { LAS unsigned char* pb = pbuf + wid_u * 2048 + lane * 16; *(LAS u32x4*)pb = pw0; *(LAS u32x4*)(pb + 1024) = pw1; }
            u32x4 vf[ND];
            auto vload = [&](int kk) {
#pragma unroll
                for (int d = 0; d < ND; ++d) { const unsigned va0 = ((unsigned)(size_t)(vb + (half * 128 + lr) * 128) + (unsigned)((g ^ ((lr >> 1) & 7)) << 4)) ^ (unsigned)(kk << 5);
                    vf[d] = *(const LAS u32x4*)(size_t)(va0 + d * 4096); }
            };
            auto pv = [&](const u32x4 pw) { const bf16x8 pf = __builtin_bit_cast(bf16x8, pw);
#pragma unroll
                for (int d = 0; d < ND; ++d) O[d] = __builtin_amdgcn_mfma_f32_32x32x16_bf16(__builtin_bit_cast(bf16x8, vf[d]), pf, O[d], 0, 0, 0); };
            vload(2 * half); pv(pw0);
            vload(2 * half + 1); pv(pw1);
            asm volatile("s_waitcnt lgkmcnt(0)" ::: "memory"); __builtin_amdgcn_s_barrier(); asm volatile("" ::: "memory");
            const LAS unsigned char* pp = pbuf + (wid_u ^ 4) * 2048 + lane * 16;
            { const u32x4 q0 = *(const LAS u32x4*)pp; vload(2 * (1 - half)); pv(q0); }
            { const u32x4 q1 = *(const LAS u32x4*)(pp + 1024); vload(2 * (1 - half) + 1); pv(q1); }
        };
        dma(0, 0);
        asm volatile("s_waitcnt vmcnt(0)" ::: "memory"); __syncthreads();
        for (int t = 0; t < nt; ++t) {
            if (t + 1 < nt) dma(t + 1, (t + 1) & 1);
            compute2(t);
            asm volatile("s_waitcnt vmcnt(0)" ::: "memory"); __syncthreads();
        }
    } else {
    constexpr bool PF2 = (MODE == 0);
    u32x4 kreg[NKC], vreg[NVC], kreg2[PF2 ? NKC : 1], vreg2[PF2 ? NVC : 1];
    auto gload = [&](int t, u32x4* kr, u32x4* vr) {
        const bf16_t* kp; int ldk;
        if (MODE >= 2 && t * 64 >= a.nreal) { kp = a.ident + (size_t)((t * 64 - a.nreal) & 255) * 256; ldk = 256; } else { kp = a.k + (size_t)t * 64 * a.ldk; ldk = a.ldk; }
#pragma unroll
        for (int i = 0; i < NKC; ++i) { const int c = tid + i * 512, row = c / (KW / 8), cc = c % (KW / 8); kr[i] = *(const u32x4*)(kp + (size_t)row * ldk + cc * 8); }
#pragma unroll
        for (int i = 0; i < NVC; ++i) { const int c = tid + i * 512, d = c >> 3, cc = c & 7; vr[i] = *(const u32x4*)(a.vt + (size_t)d * a.ldvt + t * 64 + cc * 8); }
    };
    auto sstore = [&](int buf, const u32x4* kr, const u32x4* vr) {
        LAS unsigned char* base = lds + buf * STG;
#pragma unroll
        for (int i = 0; i < NKC; ++i) { const int c = tid + i * 512, row = c / (KW / 8), cc = c % (KW / 8); *(LAS u32x4*)(base + (row * KLD + cc * 8) * 2) = kr[i]; }
#pragma unroll
        for (int i = 0; i < NVC; ++i) { const int c = tid + i * 512, d = c >> 3, cc = c & 7; *(LAS u32x4*)(base + KB + (d * VLD + cc * 8) * 2) = vr[i]; }
    };
    gload(0, kreg, vreg); sstore(0, kreg, vreg); __syncthreads();
    const int nt = a.ntiles;
    auto compute = [&](int t) {
        LAS unsigned char* kb = lds + (t & 1) * STG; LAS unsigned char* vb = kb + KB;
        f32x16 S[2];
        if constexpr (MODE <= 1) {
            bf16x8 kf[2][NS];
#pragma unroll
            for (int ks = 0; ks < 2; ++ks)
#pragma unroll
                for (int s = 0; s < NS; ++s) kf[ks][s] = *(const LAS bf16x8*)(kb + ((ks * 32 + lr) * KLD + a.kcol + s * 16 + g * 8) * 2);
            u32x4 vf[2][ND];
            auto vload = [&](int kk, u32x4* dst) {
#pragma unroll
                for (int d = 0; d < ND; ++d) { const LAS unsigned char* vp = vb + ((d * 32 + lr) * VLD + kk * 16 + 4 * g) * 2;
                    const u32x2 v0 = *(const LAS u32x2*)vp, v1 = *(const LAS u32x2*)(vp + 16); dst[d] = (u32x4){v0.x, v0.y, v1.x, v1.y}; }
            };
            vload(0, vf[0]);
            __builtin_amdgcn_sched_barrier(0);
            constexpr bool fx = FXC;
#pragma unroll
            for (int r = 0; r < 16; ++r) { S[0][r] = fx ? -a.fixm : 0.f; S[1][r] = fx ? -a.fixm : 0.f; }
#pragma unroll
            for (int s = 0; s < NS; ++s) { S[0] = __builtin_amdgcn_mfma_f32_32x32x16_bf16(kf[0][s], qf[s], S[0], 0, 0, 0); S[1] = __builtin_amdgcn_mfma_f32_32x32x16_bf16(kf[1][s], qf[s], S[1], 0, 0, 0); }
            if (fx) {
                float ls = 0.f;
#pragma unroll
                for (int ks = 0; ks < 2; ++ks)
#pragma unroll
                    for (int r = 0; r < 16; ++r) { const float pv = fast_exp2(S[ks][r]); S[ks][r] = pv; ls += pv; }
                l_run += ls;
            } else {
                float mx = S[0][0];
#pragma unroll
                for (int ks = 0; ks < 2; ++ks)
#pragma unroll
                    for (int r = 0; r < 16; ++r) mx = fmaxf(mx, S[ks][r]);
                mx = fmaxf(mx, shfl_xor_f(mx, 32));
                const float mn = fmaxf(m_run, mx), alpha = fast_exp2(m_run - mn); m_run = mn;
                float ls = 0.f;
#pragma unroll
                for (int ks = 0; ks < 2; ++ks)
#pragma unroll
                    for (int r = 0; r < 16; ++r) { const float pv = fast_exp2(S[ks][r] - mn); S[ks][r] = pv; ls += pv; }
                l_run = l_run * alpha + ls;
#pragma unroll
                for (int d = 0; d < ND; ++d)
#pragma unroll
                    for (int r = 0; r < 16; ++r) O[d][r] *= alpha;
            }
#pragma unroll
            for (int kk = 0; kk < 4; ++kk) {
                if (kk < 3) vload(kk + 1, vf[(kk + 1) & 1]);
                __builtin_amdgcn_sched_barrier(0);
                const int ks = kk >> 1, rb = (kk & 1) * 8;
                u32x4 pw; pw.x = cvt_pk_bf16(S[ks][rb + 0], S[ks][rb + 1]); pw.y = cvt_pk_bf16(S[ks][rb + 2], S[ks][rb + 3]); pw.z = cvt_pk_bf16(S[ks][rb + 4], S[ks][rb + 5]); pw.w = cvt_pk_bf16(S[ks][rb + 6], S[ks][rb + 7]);
                const bf16x8 pf = __builtin_bit_cast(bf16x8, pw);
#pragma unroll
                for (int d = 0; d < ND; ++d) O[d] = __builtin_amdgcn_mfma_f32_32x32x16_bf16(__builtin_bit_cast(bf16x8, vf[kk & 1][d]), pf, O[d], 0, 0, 0);
            }
            return;
        }
#pragma unroll
        for (int ks = 0; ks < 2; ++ks) {
            if (MODE >= 2 && ks == 1) __builtin_amdgcn_sched_barrier(0);
#pragma unroll
            for (int r = 0; r < 16; ++r) S[ks][r] = 0.f;
#pragma unroll
            for (int s = 0; s < NS; ++s) {
                const bf16x8 af = *(const LAS bf16x8*)(kb + ((ks * 32 + lr) * KLD + a.kcol + s * 16 + g * 8) * 2);
                S[ks] = __builtin_amdgcn_mfma_f32_32x32x16_bf16(af, qf[s], S[ks], 0, 0, 0);
            }
            if (MODE == 2) {
                const int n = a.n0 + lr;
                if (t * 64 < a.nreal) {
#pragma unroll
                    for (int r = 0; r < 16; ++r) { const int m = t * 64 + ks * 32 + 8 * (r >> 2) + 4 * g + (r & 3); const int df = n - m;
                        const float e = df > 0 ? (float)df * a.lgf : (float)(-df) * a.lgb; float f = fast_exp2(e) * 0.0625f; if (df == 0) f = 0.125f; S[ks][r] *= f; }
                } else {
                    const float f = ((t * 64 - a.nreal) < 256) ? fast_exp2((float)(n + 1) * a.lgf) : fast_exp2((float)(a.L - n) * a.lgb);
#pragma unroll
                    for (int r = 0; r < 16; ++r) S[ks][r] *= f;
                }
            } else if (MODE == 3) {
#pragma unroll
                for (int r = 0; r < 16; ++r) { const int m = t * 64 + ks * 32 + 8 * (r >> 2) + 4 * g + (r & 3);
                    const float e = a.dir == 0 ? (float)(a.L - 1 - m) * a.lgf : (float)m * a.lgb; S[ks][r] *= fast_exp2(e) * 0.0625f; }
            }
            if (MODE >= 2) {
#pragma unroll
                for (int k2 = 0; k2 < 2; ++k2) {
                    const int kk = ks * 2 + k2, rb = k2 * 8;
                    u32x4 pw; pw.x = cvt_pk_bf16(S[ks][rb + 0], S[ks][rb + 1]); pw.y = cvt_pk_bf16(S[ks][rb + 2], S[ks][rb + 3]); pw.z = cvt_pk_bf16(S[ks][rb + 4], S[ks][rb + 5]); pw.w = cvt_pk_bf16(S[ks][rb + 6], S[ks][rb + 7]);
                    const bf16x8 pf = __builtin_bit_cast(bf16x8, pw);
#pragma unroll
                    for (int d = 0; d < ND; ++d) {
                        const LAS unsigned char* vp = vb + ((d * 32 + lr) * VLD + kk * 16 + 4 * g) * 2;
                        const u32x2 v0 = *(const LAS u32x2*)vp, v1 = *(const LAS u32x2*)(vp + 16);
                        const bf16x8 vf = __builtin_bit_cast(bf16x8, (u32x4){v0.x, v0.y, v1.x, v1.y});
                        O[d] = __builtin_amdgcn_mfma_f32_32x32x16_bf16(vf, pf, O[d], 0, 0, 0);
                    }
                }
            }
        }
        if (MODE <= 1) {
            float mx = S[0][0];
#pragma unroll
            for (int ks = 0; ks < 2; ++ks)
#pragma unroll
                for (int r = 0; r < 16; ++r) mx = fmaxf(mx, S[ks][r]);
            mx = fmaxf(mx, shfl_xor_f(mx, 32));
            const float mn = fmaxf(m_run, mx), alpha = fast_exp2(m_run - mn); m_run = mn;
            float ls = 0.f;
#pragma unroll
            for (int ks = 0; ks < 2; ++ks)
#pragma unroll
                for (int r = 0; r < 16; ++r) { const float pv = fast_exp2(S[ks][r] - mn); S[ks][r] = pv; ls += pv; }
            l_run = l_run * alpha + ls;
#pragma unroll
            for (int d = 0; d < ND; ++d)
#pragma unroll
                for (int r = 0; r < 16; ++r) O[d][r] *= alpha;
#pragma unroll
            for (int kk = 0; kk < 4; ++kk) {
                const int ks = kk >> 1, rb = (kk & 1) * 8;
                u32x4 pw; pw.x = cvt_pk_bf16(S[ks][rb + 0], S[ks][rb + 1]); pw.y = cvt_pk_bf16(S[ks][rb + 2], S[ks][rb + 3]); pw.z = cvt_pk_bf16(S[ks][rb + 4], S[ks][rb + 5]); pw.w = cvt_pk_bf16(S[ks][rb + 6], S[ks][rb + 7]);
                const bf16x8 pf = __builtin_bit_cast(bf16x8, pw);
#pragma unroll
                for (int d = 0; d < ND; ++d) {
                    const LAS unsigned char* vp = vb + ((d * 32 + lr) * VLD + kk * 16 + 4 * g) * 2;
                    const u32x2 v0 = *(const LAS u32x2*)vp, v1 = *(const LAS u32x2*)(vp + 16);
                    const bf16x8 vf = __builtin_bit_cast(bf16x8, (u32x4){v0.x, v0.y, v1.x, v1.y});
                    O[d] = __builtin_amdgcn_mfma_f32_32x32x16_bf16(vf, pf, O[d], 0, 0, 0);
                }
            }
        }
    };
    if (PF2) {
        if (nt > 1) gload(1, kreg, vreg);
        for (int t = 0; t < nt; t += 2) {
            if (t + 2 < nt) gload(t + 2, kreg2, vreg2);
            compute(t);
            if (t + 1 < nt) sstore(1, kreg, vreg);
            __syncthreads();
            if (t + 1 >= nt) break;
            if (t + 3 < nt) gload(t + 3, kreg, vreg);
            compute(t + 1);
            if (t + 2 < nt) sstore(0, kreg2, vreg2);
            __syncthreads();
        }
    } else {
        for (int t = 0; t < nt; ++t) {
            if (t + 1 < nt) gload(t + 1, kreg, vreg);
            compute(t);
            if (t + 1 < nt) sstore((t + 1) & 1, kreg, vreg);
            __syncthreads();
        }
    }
    }
    if (MODE == 0) {
        const float inv = 1.0f / (l_run + shfl_xor_f(l_run, 32));
        bf16_t* op = a.out + (size_t)lr * a.ldo;
#pragma unroll
        for (int d = 0; d < ND; ++d)
#pragma unroll
            for (int q4 = 0; q4 < 4; ++q4)
                *(u32x2*)(op + d * 32 + 8 * q4 + 4 * g) = (u32x2){cvt_pk_bf16(O[d][4 * q4] * inv, O[d][4 * q4 + 1] * inv), cvt_pk_bf16(O[d][4 * q4 + 2] * inv, O[d][4 * q4 + 3] * inv)};
    } else if (MODE == 1) {
        const int wid = tid >> 6;
        const float inv = 1.0f / (l_run + shfl_xor_f(l_run, 32));
        LAS float* ex = (LAS float*)lds;
        if (wid >= 4) {
#pragma unroll
            for (int d = 0; d < ND; ++d)
#pragma unroll
                for (int r = 0; r < 16; ++r) ex[(((wid - 4) * ND + d) * 16 + r) * 64 + lane] = O[d][r] * inv;
        }
        __syncthreads();
        if (wid < 4) {
            float ss = 0.f;
#pragma unroll
            for (int d = 0; d < ND; ++d)
#pragma unroll
                for (int r = 0; r < 16; ++r) { const float o = O[d][r] * inv - a.lam * ex[((wid * ND + d) * 16 + r) * 64 + lane]; O[d][r] = o; ss += o * o; }
            ss += shfl_xor_f(ss, 32);
            const float rs = rsqrtf(ss * (1.0f / DV) + 1e-5f) * a.onem;
            bf16_t* op = a.out + (size_t)lr * a.ldo;
#pragma unroll
            for (int d = 0; d < ND; ++d)
#pragma unroll
                for (int q4 = 0; q4 < 4; ++q4) { const int dd = d * 32 + 8 * q4 + 4 * g; const f32x4 sg = *(const f32x4*)(a.subg + dd);
                    *(u32x2*)(op + dd) = (u32x2){cvt_pk_bf16(O[d][4 * q4] * rs * sg[0], O[d][4 * q4 + 1] * rs * sg[1]), cvt_pk_bf16(O[d][4 * q4 + 2] * rs * sg[2], O[d][4 * q4 + 3] * rs * sg[3])}; }
        }
        __syncthreads();
    } else if (MODE == 2) {
        const int wid_e = __builtin_amdgcn_readfirstlane(tid >> 6);
        const LAS int* pp = (const LAS int*)(lds + LDS_RETPARAM) + wid_e * 8;
        const int e_row = pp[0], e_col = pp[1], e_pair = pp[2], e_dvh = pp[3];
        KParamsPtr kpe = (KParamsPtr)__builtin_amdgcn_kernarg_segment_ptr();
        unsigned char* wsb = kpe->ws;
        unsigned long long* pslot = (unsigned long long*)(wsb + WS_PSLOT) + (size_t)e_pair * 256;
        float ss = 0.f;
#pragma unroll
        for (int d = 0; d < ND; ++d)
#pragma unroll
            for (int r = 0; r < 16; ++r) ss += O[d][r] * O[d][r];
        ss += shfl_xor_f(ss, 32);
        LAS float* xl = (LAS float*)lds;
        if (g == 0) xl[wid_e * 32 + lr] = ss;
        __syncthreads();
        if (wid_e < 4 && g == 0) {
            const float mine = xl[wid_e * 32 + lr] + xl[(wid_e + 4) * 32 + lr];
            const int row = wid_e * 32 + lr;
            (void)__hip_atomic_exchange(pslot + (size_t)e_dvh * 128 + row, (0x5EEDull << 32) | (unsigned long long)__float_as_uint(mine), __ATOMIC_RELAXED, __HIP_MEMORY_SCOPE_AGENT);
            unsigned long long* o = pslot + (size_t)(e_dvh ^ 1) * 128 + row; unsigned long long v; unsigned spin = 0;
            for (;;) { v = __hip_atomic_load(o, __ATOMIC_RELAXED, __HIP_MEMORY_SCOPE_AGENT); if ((unsigned)(v >> 32) == 0x5EEDu) break; __builtin_amdgcn_s_sleep(1); if (++spin > (1u << 22)) break; }
            xl[256 + row] = rsqrtf((mine + __uint_as_float((unsigned)v)) * (1.0f / 512.0f) + 1e-6f);
        }
        __syncthreads();
        const float rs = xl[256 + (wid_e & 3) * 32 + lr];
        bf16_t* op = (bf16_t*)(wsb + WS_X + 36 * MiB) + (size_t)(e_row + lr) * 2048 + e_col; const bf16_t* gp = (const bf16_t*)(wsb + WS_U) + (size_t)(e_row + lr) * 6144 + 4096 + e_col; const float* gnp = kpe->in[I_RGN] + e_col;
#pragma unroll
        for (int d = 0; d < ND; ++d)
#pragma unroll
            for (int q4 = 0; q4 < 4; ++q4) { const int dd = d * 32 + 8 * q4 + 4 * g; const u32x2 gw = *(const u32x2*)(gp + dd); const f32x4 g4 = *(const f32x4*)(gnp + dd);
                const float o0 = siluf(bflo(gw.x)) * (O[d][4 * q4] * rs * g4[0]), o1 = siluf(bfhi(gw.x)) * (O[d][4 * q4 + 1] * rs * g4[1]);
                const float o2 = siluf(bflo(gw.y)) * (O[d][4 * q4 + 2] * rs * g4[2]), o3 = siluf(bfhi(gw.y)) * (O[d][4 * q4 + 3] * rs * g4[3]);
                *(u32x2*)(op + dd) = (u32x2){cvt_pk_bf16(o0, o1), cvt_pk_bf16(o2, o3)}; }
        __syncthreads();
    } else {
        float* op = a.outf + (size_t)lr * 512;
#pragma unroll
        for (int d = 0; d < ND; ++d)
#pragma unroll
            for (int q4 = 0; q4 < 4; ++q4) *(f32x4*)(op + d * 32 + 8 * q4 + 4 * g) = (f32x4){O[d][4 * q4], O[d][4 * q4 + 1], O[d][4 * q4 + 2], O[d][4 * q4 + 3]};
    }
}

__device__ __forceinline__ int xcd_item(int it) { return (gridDim.x == 256 && it < 512) ? ((it & 256) | ((it & 7) << 5) | ((it & 255) >> 3)) : it; }
template <bool FXC>
__device__ __forceinline__ void attn_phase_t(const Params& p, LAS unsigned char* lds, const float fixm) {
    bf16_t* U = (bf16_t*)(p.ws + WS_U); bf16_t* H = (bf16_t*)(p.ws + WS_H);
    bf16_t* KS = (bf16_t*)(p.ws + WS_X); bf16_t* VtS = KS + (size_t)2 * 4352 * 256; bf16_t* VtP = VtS + (size_t)2 * 256 * 4352;
    const int wid = otid() >> 6, sub = wid >> 2, w4 = wid & 3;
    for (int it = blockIdx.x; it < 1024; it += gridDim.x) {
        FlashArgs a; a.ident = nullptr; a.kcol = 0; a.qscale = 0.125f * 1.4426950408889634f; a.ldo = DM; a.outf = nullptr; a.ldq = 1536; a.fixm = fixm;
        if (it < 512) { const int ix = xcd_item(it); const int b = ix >> 8, pr = (ix >> 5) & 7, qb = ix & 31; const int head = pr * 2 + sub, kh = pr >> 1;
            const size_t tok = (size_t)NTP + b * 4096 + qb * 128 + w4 * 32;
            a.q = U + tok * 1536 + head * 64; a.k = KS + (size_t)b * 4352 * 256 + kh * 64; a.ldk = 256; a.vt = VtS + (size_t)(b * 4 + kh) * 64 * 4352; a.ldvt = 4352;
            a.nreal = 4352; a.ntiles = 68; a.out = H + tok * DM + head * 64;
        } else { const int i2 = it - 512, b = i2 >> 4, pr = (i2 >> 1) & 7, qb = i2 & 1; const int head = pr * 2 + sub, kh = pr >> 1;
            const size_t tok = (size_t)b * 256 + qb * 128 + w4 * 32;
            a.q = U + tok * 1536 + head * 64; a.k = U + (size_t)b * 256 * 1536 + 1024 + kh * 64; a.ldk = 1536; a.vt = VtP + (size_t)(b * 4 + kh) * 64 * 256; a.ldvt = 256;
            a.nreal = 256; a.ntiles = 4; a.out = H + tok * DM + head * 64;
        }
        flash_item<64, 64, 0, FXC>(lds, a);
    }
}
__device__ void attn_phase(const Params& p, LAS unsigned char* lds) {
    float gq = 0.f, gk = 0.f;
    for (int i = 0; i < 64; ++i) { gq = fmaxf(gq, fabsf(p.in[I_AQG][i])); gk = fmaxf(gk, fabsf(p.in[I_AKG][i])); }
    const float ckn = sqrtf(__uint_as_float(*(const unsigned*)(p.ws + WS_CKMAX)));
    const float sbound = 8.0f * gq * fmaxf(8.0f * gk, ckn) * (0.125f * 1.4426950408889634f) * 1.03f + 0.25f;
    const float fixm = sbound <= 60.0f ? sbound : -1.0f;
    if (fixm >= 0.f) attn_phase_t<true>(p, lds, fixm); else attn_phase_t<false>(p, lds, fixm);
}
template <bool FXC>
__device__ __forceinline__ void diff_phase_t(const Params& p, LAS unsigned char* lds, const float dfix) {
    bf16_t* U = (bf16_t*)(p.ws + WS_U); bf16_t* H = (bf16_t*)(p.ws + WS_H);
    bf16_t* KS = (bf16_t*)(p.ws + WS_X); bf16_t* VtS = KS + (size_t)2 * 4352 * 1024; bf16_t* VtP = VtS + (size_t)2 * 1024 * 4352;
    const int wid = otid() >> 6, sub = wid >> 2, w4 = wid & 3;
    const float* lam = p.in[I_DLAM]; float s1 = 0.f, s2 = 0.f;
    for (int i = 0; i < 64; ++i) { s1 += lam[i] * lam[64 + i]; s2 += lam[128 + i] * lam[192 + i]; }
    const float lam_init = 0.8f - 0.6f * expf(-0.3f * 1.0f); const float lam_full = expf(s1) - expf(s2) + lam_init;
    for (int it = blockIdx.x; it < 1024; it += gridDim.x) {
        FlashArgs a; a.ident = nullptr; a.kcol = sub * 64; a.qscale = 0.125f * 1.4426950408889634f; a.ldo = DM; a.outf = nullptr; a.ldq = 3072; a.fixm = dfix;
        a.lam = lam_full; a.onem = 1.0f - lam_init; a.subg = p.in[I_DSUB];
        if (it < 512) { const int ix = xcd_item(it); const int b = ix >> 8, h = (ix >> 5) & 7, qb = ix & 31; const size_t tok = (size_t)NTP + b * 4096 + qb * 128 + w4 * 32;
            a.q = U + tok * 3072 + h * 128 + sub * 64; a.k = KS + (size_t)b * 4352 * 1024 + h * 128; a.ldk = 1024; a.vt = VtS + ((size_t)b * 1024 + h * 128) * 4352; a.ldvt = 4352;
            a.nreal = 4352; a.ntiles = 68; a.out = H + tok * DM + h * 128;
        } else { const int i2 = it - 512, b = i2 >> 4, h = (i2 >> 1) & 7, qb = i2 & 1; const size_t tok = (size_t)b * 256 + qb * 128 + w4 * 32;
            a.q = U + tok * 3072 + h * 128 + sub * 64; a.k = U + (size_t)b * 256 * 3072 + 1024 + h * 128; a.ldk = 3072; a.vt = VtP + ((size_t)b * 1024 + h * 128) * 256; a.ldvt = 256;
            a.nreal = 256; a.ntiles = 4; a.out = H + tok * DM + h * 128;
        }
        flash_item<64, 128, 1, FXC>(lds, a);
    }
}
__device__ void diff_phase(const Params& p, LAS unsigned char* lds) {
    const float dqn = sqrtf(__uint_as_float(*(const unsigned*)(p.ws + WS_DQMAX))), dkn = sqrtf(__uint_as_float(*((const unsigned*)(p.ws + WS_DQMAX) + 1)));
    const float dbound = dqn * dkn * (0.125f * 1.4426950408889634f) * 1.03f + 0.25f; const float dfix = dbound <= 60.0f ? dbound : -1.0f;
    if (dfix >= 0.f) diff_phase_t<true>(p, lds, dfix); else diff_phase_t<false>(p, lds, dfix);
}
__device__ void ret_phase(const Params& p, LAS unsigned char* lds) {
    bf16_t* U = (bf16_t*)(p.ws + WS_U); bf16_t* VtP = (bf16_t*)(p.ws + WS_H); bf16_t* VtS = (bf16_t*)(p.ws + WS_X); bf16_t* OB = (bf16_t*)(p.ws + WS_X + 36 * MiB);
    const bf16_t* ident = (const bf16_t*)(p.ws + WS_IDENT); const bf16_t* identw = (const bf16_t*)(p.ws + WS_IDENTW);
    const float L2E = 1.4426950408889634f;
    for (int it = blockIdx.x; it < 2048; it += gridDim.x) {
        const int wid = __builtin_amdgcn_readfirstlane(otid() >> 6), rg = wid & 3, half = wid >> 2;
        FlashArgs a; a.ident = identw; a.kcol = 0; a.qscale = 1.f; a.ldo = 2048; a.outf = nullptr; a.dir = 0; a.half = half;
        if (it < 512) { const int ix = xcd_item(it); const int b = ix >> 8, h = (ix >> 6) & 3, dvh = (ix >> 5) & 1, qb = ix & 31; const size_t tok0 = (size_t)NTP + b * 4096;
            a.lgf = -fabsf(p.in[I_RLD][h]) * L2E; a.lgb = -fabsf(p.in[I_RLD][4 + h]) * L2E;
            a.n0 = qb * 128 + rg * 32; a.L = 4096;
            a.q = U + (tok0 + a.n0) * 6144 + h * 256; a.ldq = 6144; a.k = U + tok0 * 6144 + 1024 + h * 256; a.ldk = 6144;
            a.vt = VtS + ((size_t)b * 2048 + h * 512 + dvh * 256) * 4608; a.ldvt = 4608; a.nreal = 4096; a.ntiles = 72;
            a.out = nullptr;
            if ((otid() & 63) == 0) { LAS int* pp = (LAS int*)(lds + LDS_RETPARAM) + wid * 8; pp[0] = (int)(tok0 + a.n0); pp[1] = h * 512 + dvh * 256 + half * 128; pp[2] = (b * 4 + h) * 32 + qb; pp[3] = dvh; }
            flash_item<256, 128, 2>(lds, a);
        } else if (it < 1024) { const int i2 = it - 512, b = i2 >> 4, h = (i2 >> 2) & 3, dvh = (i2 >> 1) & 1, qb = i2 & 1; const size_t tok0 = (size_t)b * 256;
            a.lgf = -fabsf(p.in[I_RLD][h]) * L2E; a.lgb = -fabsf(p.in[I_RLD][4 + h]) * L2E;
            a.n0 = qb * 128 + rg * 32; a.L = 256;
            a.q = U + (tok0 + a.n0) * 6144 + h * 256; a.ldq = 6144; a.k = U + tok0 * 6144 + 1024 + h * 256; a.ldk = 6144;
            a.vt = VtP + ((size_t)b * 2048 + h * 512 + dvh * 256) * 256; a.ldvt = 256; a.nreal = 256; a.ntiles = 4;
            a.out = nullptr;
            if ((otid() & 63) == 0) { LAS int* pp = (LAS int*)(lds + LDS_RETPARAM) + wid * 8; pp[0] = (int)(tok0 + a.n0); pp[1] = h * 512 + dvh * 256 + half * 128; pp[2] = 256 + (b * 4 + h) * 2 + qb; pp[3] = dvh; }
            flash_item<256, 128, 2>(lds, a);
        } else { const int i2 = it - 1024, b = i2 >> 5, dir = (i2 >> 4) & 1, h = (i2 >> 2) & 3, dvh = (i2 >> 1) & 1, ib = i2 & 1; const size_t tok0 = (size_t)b * 256;
            a.lgf = -fabsf(p.in[I_RLD][h]) * L2E; a.lgb = -fabsf(p.in[I_RLD][4 + h]) * L2E;
            a.n0 = ib * 128 + rg * 32; a.L = 256; a.dir = dir;
            a.q = ident + (size_t)(ib * 128 + rg * 32) * 256; a.ldq = 256; a.k = U + tok0 * 6144 + 1024 + h * 256; a.ldk = 6144;
            a.vt = VtP + ((size_t)b * 2048 + h * 512 + dvh * 256) * 256; a.ldvt = 256; a.nreal = 256; a.ntiles = 4;
            a.out = nullptr; a.outf = p.out + OUT_NSR + ((size_t)((b * 2 + dir) * 4 + h) * 256 + ib * 128 + rg * 32) * 512 + dvh * 256 + half * 128;
            flash_item<256, 128, 3>(lds, a);
        }
    }
}
__device__ void ret_prep(const Params& p, LAS unsigned char* lds) {
    bf16_t* U = (bf16_t*)(p.ws + WS_U); bf16_t* VtP = (bf16_t*)(p.ws + WS_H); bf16_t* VtS = (bf16_t*)(p.ws + WS_X);
    vt_all<true>(U, 6144, 2048, 2048, VtP, VtS, 4608, 0, lds);
    for (int it = blockIdx.x; it < 16 * 32; it += gridDim.x) { const int mt = it >> 5, tl = it & 31, kt = tl >> 3, ntile = tl & 7; const int b = mt >> 3, dir = (mt >> 2) & 1, h = mt & 3;
        wconv_tile<true>(p.in[I_SRET] + (size_t)mt * 256 * 512, 512, VtS + ((size_t)b * 2048 + h * 512) * 4608 + 4096 + dir * 256, 4608, kt, ntile, (LAS float*)lds); }
}
__device__ void ret_gate(const Params& p) {
    const bf16_t* U = (const bf16_t*)(p.ws + WS_U); bf16_t* OB = (bf16_t*)(p.ws + WS_X + 36 * MiB); const float* gn = p.in[I_RGN];
    const int lane = otid() & 63, gw = blockIdx.x * 8 + (otid() >> 6), nw = gridDim.x * 8;
    for (int it = gw; it < NT * 4; it += nw) { const int t = it >> 2, h = it & 3;
        bf16_t* op = OB + (size_t)t * 2048 + h * 512 + lane * 8; const u32x4 ow = *(const u32x4*)op; const u32x4 gwv = *(const u32x4*)(U + (size_t)t * 6144 + 4096 + h * 512 + lane * 8);
        float o[8], gg[8];
#pragma unroll
        for (int j = 0; j < 4; ++j) { o[2 * j] = bflo(ow[j]); o[2 * j + 1] = bfhi(ow[j]); gg[2 * j] = bflo(gwv[j]); gg[2 * j + 1] = bfhi(gwv[j]); }
        float ss = 0.f;
#pragma unroll
        for (int j = 0; j < 8; ++j) ss += o[j] * o[j];
        ss = wave_sum(ss); const float rs = rsqrtf(ss * (1.0f / 512.0f) + 1e-6f);
        const f32x4 g0 = *(const f32x4*)(gn + h * 512 + lane * 8), g1 = *(const f32x4*)(gn + h * 512 + lane * 8 + 4);
        float r[8];
#pragma unroll
        for (int j = 0; j < 8; ++j) r[j] = siluf(gg[j]) * (o[j] * rs * (j < 4 ? g0[j] : g1[j - 4]));
        *(u32x4*)op = (u32x4){cvt_pk_bf16(r[0], r[1]), cvt_pk_bf16(r[2], r[3]), cvt_pk_bf16(r[4], r[5]), cvt_pk_bf16(r[6], r[7])};
    }
}

__device__ void ffn_act_phase(const bf16_t* __restrict__ src, bf16_t* __restrict__ dst, const float* __restrict__ w, const float* __restrict__ bias) {
    constexpr int C = FF, LD = 2 * FF; const int nc8 = C / 8; const size_t tot = (size_t)(NT / 16) * nc8;
    for (size_t it = (size_t)blockIdx.x * 512 + otid(); it < tot; it += (size_t)gridDim.x * 512) {
        const int cb = (int)(it % nc8), rb = (int)(it / nc8), r0 = rb * 16, j0 = cb * 8;
        const int Ls = r0 < NTP ? 256 : 4096; const bool hasp = (r0 % Ls) != 0, hasn = ((r0 + 16) % Ls) != 0;
        float w0[2][8], w1[2][8], w2[2][8], bb[2][8];
#pragma unroll
        for (int q = 0; q < 2; ++q)
#pragma unroll
            for (int j = 0; j < 8; ++j) { const int c = j0 + j + q * C; w0[q][j] = w[c]; w1[q][j] = w[LD + c]; w2[q][j] = w[2 * LD + c]; bb[q][j] = bias[c]; }
        const bf16_t* sp = src + (size_t)r0 * LD + j0;
        u32x4 raw[2][6];
        const u32x4 z4 = (u32x4){0u, 0u, 0u, 0u};
#pragma unroll
        for (int q = 0; q < 2; ++q) { raw[q][0] = hasp ? *(const u32x4*)(sp - LD + q * C) : z4; raw[q][1] = *(const u32x4*)(sp + q * C); }
#pragma unroll
        for (int grp = 0; grp < 4; ++grp) {
#pragma unroll
            for (int k = 0; k < 4; ++k)
#pragma unroll
                for (int q = 0; q < 2; ++q) { const int rr = grp * 4 + k + 1; raw[q][2 + k] = (rr < 16 || hasn) ? *(const u32x4*)(sp + (size_t)rr * LD + q * C) : z4; }
#pragma unroll
            for (int k = 0; k < 4; ++k) {
                float o[8];
#pragma unroll
                for (int jj = 0; jj < 4; ++jj) {
                    float ca[2], cbv[2];
#pragma unroll
                    for (int h2 = 0; h2 < 2; ++h2) { const int j = 2 * jj + h2;
                        const float pa = h2 ? bfhi(raw[0][k][jj]) : bflo(raw[0][k][jj]), ca_ = h2 ? bfhi(raw[0][k + 1][jj]) : bflo(raw[0][k + 1][jj]), na = h2 ? bfhi(raw[0][k + 2][jj]) : bflo(raw[0][k + 2][jj]);
                        const float pb = h2 ? bfhi(raw[1][k][jj]) : bflo(raw[1][k][jj]), cb_ = h2 ? bfhi(raw[1][k + 1][jj]) : bflo(raw[1][k + 1][jj]), nb = h2 ? bfhi(raw[1][k + 2][jj]) : bflo(raw[1][k + 2][jj]);
                        ca[h2] = w0[0][j] * pa + w1[0][j] * ca_ + w2[0][j] * na + bb[0][j];
                        cbv[h2] = w0[1][j] * pb + w1[1][j] * cb_ + w2[1][j] * nb + bb[1][j];
                        o[j] = siluf(ca[h2]) * cbv[h2]; }
                }
                *(u32x4*)(dst + (size_t)(r0 + grp * 4 + k) * C + j0) = (u32x4){cvt_pk_bf16(o[0], o[1]), cvt_pk_bf16(o[2], o[3]), cvt_pk_bf16(o[4], o[5]), cvt_pk_bf16(o[6], o[7])};
            }
#pragma unroll
            for (int q = 0; q < 2; ++q) { raw[q][0] = raw[q][4]; raw[q][1] = raw[q][5]; }
        }
    }
}

__device__ void hyena_filters(const Params& p, LAS unsigned char* lds) {
    float* FtP = (float*)(p.ws + WS_X); float* FtS = FtP + (size_t)4096 * 256; float* PS = (float*)(p.ws + WS_X + 68 * MiB);
    LAS float* zz = (LAS float*)lds;
    LAS float* a1 = zz + 16 * 33;
    LAS float* a2 = a1 + 16 * 64;
    const int tid = otid();
    const float* w1 = p.in[I_HW1]; const float* b1 = p.in[I_HB1]; const float* w2 = p.in[I_HW2]; const float* b2 = p.in[I_HB2]; const float* w3 = p.in[I_HW3]; const float* fq = p.in[I_HFREQ];
    for (int it = blockIdx.x; it < 272; it += gridDim.x) {
        const int L = it < 16 ? 256 : 4096, t0 = it < 16 ? it * 16 : (it - 16) * 16;
        for (int i = tid; i < 16 * 33; i += 512) { const int r = i / 33, e = i % 33; const float t = (float)(t0 + r); float v;
            if (e == 0) v = t / (float)(L - 1);
            else { const int bi = (e - 1) & 15; const float band = 1e-4f + (float)bi * ((15.0f - 1e-4f) / 15.0f); const float rev = t * band / (float)L; v = e <= 16 ? cos_rev(rev) : -sin_rev(rev); }
            zz[i] = v; }
        __syncthreads();
        for (int i = tid; i < 1024; i += 512) { const int r = i >> 6, j = i & 63; float s = b1[j];
            for (int e = 0; e < 33; ++e) s += zz[r * 33 + e] * w1[e * 64 + j];
            a1[i] = sin_rr(fq[j] * s); }
        __syncthreads();
        for (int i = tid; i < 1024; i += 512) { const int r = i >> 6, j = i & 63; float s = b2[j];
            for (int k = 0; k < 64; ++k) s += a1[r * 64 + k] * w2[k * 64 + j];
            a2[i] = sin_rr(fq[64 + j] * s); }
        __syncthreads();
        const int c0 = tid * 8;
        float acc[16][8];
#pragma unroll
        for (int r = 0; r < 16; ++r)
#pragma unroll
            for (int j = 0; j < 8; ++j) acc[r][j] = 0.f;
        for (int k = 0; k < 64; ++k) { const f32x4 wa = *(const f32x4*)(w3 + (size_t)k * 4096 + c0), wb = *(const f32x4*)(w3 + (size_t)k * 4096 + c0 + 4);
#pragma unroll
            for (int r = 0; r < 16; ++r) { const float av = a2[r * 64 + k];
#pragma unroll
                for (int j = 0; j < 4; ++j) { acc[r][j] += av * wa[j]; acc[r][4 + j] += av * wb[j]; } } }
        float asum[8];
#pragma unroll
        for (int j = 0; j < 8; ++j) asum[j] = 0.f;
        const float mind = -3.0701134573253945f, maxd = -15.350567286626973f;
        float dl[8];
#pragma unroll
        for (int j = 0; j < 8; ++j) { const int c = (c0 + j) & 1023; dl[j] = fabsf(mind + (maxd - mind) * ((float)c / 1023.0f)); }
#pragma unroll
        for (int r = 0; r < 16; ++r) { const float tn = (float)(t0 + r) / (float)(L - 1);
#pragma unroll
            for (int j = 0; j < 8; ++j) { acc[r][j] *= (__expf(-tn * dl[j]) + 0.05f); asum[j] += fabsf(acc[r][j]); } }
        { float* Ft = it < 16 ? FtP : FtS;
#pragma unroll
          for (int j = 0; j < 8; ++j) { float* d = Ft + (size_t)(c0 + j) * L + t0;
#pragma unroll
              for (int r4 = 0; r4 < 4; ++r4) *(f32x4*)(d + r4 * 4) = (f32x4){acc[r4 * 4][j], acc[r4 * 4 + 1][j], acc[r4 * 4 + 2][j], acc[r4 * 4 + 3][j]}; } }
        *(f32x4*)(PS + (size_t)it * 4096 + c0) = (f32x4){asum[0], asum[1], asum[2], asum[3]}; *(f32x4*)(PS + (size_t)it * 4096 + c0 + 4) = (f32x4){asum[4], asum[5], asum[6], asum[7]};
        __syncthreads();
    }
}
__device__ void hyena_dwconv_t(const bf16_t* __restrict__ src, bf16_t* __restrict__ Zt, const float* __restrict__ w, const float* __restrict__ bias) {
    constexpr int C = 3072; const int nc8 = C / 8; const size_t tot = (size_t)(NT / 16) * nc8;
    for (size_t it = (size_t)blockIdx.x * 512 + otid(); it < tot; it += (size_t)gridDim.x * 512) {
        const int cb = (int)(it % nc8), rb = (int)(it / nc8), r0 = rb * 16, j0 = cb * 8;
        const int Ls = r0 < NTP ? 256 : 4096; const bool hasp = (r0 % Ls) != 0, hasn = ((r0 + 16) % Ls) != 0;
        float w0[8], w1[8], w2[8], bb[8];
#pragma unroll
        for (int j = 0; j < 8; ++j) { const int c = j0 + j; w0[j] = w[c]; w1[j] = w[C + c]; w2[j] = w[2 * C + c]; bb[j] = bias[c]; }
        float pv[8], cv[8], nv[8], lo[8]; unsigned pk[8][8];
        auto ld8 = [&](int r, float* o, bool ok) {
            if (ok) { const u32x4 x = *(const u32x4*)(src + (size_t)r * C + j0);
#pragma unroll
                for (int j = 0; j < 4; ++j) { o[2 * j] = bflo(x[j]); o[2 * j + 1] = bfhi(x[j]); } }
            else {
#pragma unroll
                for (int j = 0; j < 8; ++j) o[j] = 0.f; }
        };
        ld8(r0 - 1, pv, hasp); ld8(r0, cv, true);
#pragma unroll
        for (int i = 0; i < 16; ++i) {
            ld8(r0 + i + 1, nv, (i < 15) || hasn);
#pragma unroll
            for (int j = 0; j < 8; ++j) { const float o = w0[j] * pv[j] + w1[j] * cv[j] + w2[j] * nv[j] + bb[j];
                if (i & 1) pk[j][i >> 1] = cvt_pk_bf16(lo[j], o); else lo[j] = o;
                pv[j] = cv[j]; cv[j] = nv[j]; }
        }
#pragma unroll
        for (int j = 0; j < 8; ++j) { bf16_t* d = Zt + (size_t)(j0 + j) * NT + r0;
            *(u32x4*)d = (u32x4){pk[j][0], pk[j][1], pk[j][2], pk[j][3]}; *(u32x4*)(d + 8) = (u32x4){pk[j][4], pk[j][5], pk[j][6], pk[j][7]}; }
    }
}
__device__ __forceinline__ float blk_sum2(float v, LAS float* red, int slot) {
    v = wave_sum(v); if ((otid() & 63) == 0) red[slot * 8 + (otid() >> 6)] = v; return v; }
__device__ void hyena_mfma(const Params& p, LAS unsigned char* lds) {
    const float* FtP = (const float*)(p.ws + WS_X); const float* FtS = FtP + (size_t)4096 * 256; const float* PS = (const float*)(p.ws + WS_X + 68 * MiB);
    bf16_t* U = (bf16_t*)(p.ws + WS_U); const bf16_t* Zt = U + (size_t)NT * 3072; bf16_t* yT = U;
    for (int it = blockIdx.x; it < 2048; it += gridDim.x) {
        const int tid = otid(), lane = tid & 63, wid = tid >> 6, lr = lane & 31, g = lane >> 5;
        const int c = it & 1023;
        if (it < 1024) {
            constexpr int CST = 16400;
            LAS unsigned char* cp = lds; LAS bf16_t* uL = (LAS bf16_t*)(lds + 8 * CST); LAS float* red = (LAS float*)(lds + 8 * CST + 18432);
            const int mi = wid & 1, ah = (wid >> 1) & 1, batch = wid >> 2;
            for (int order = 0; order < 2; ++order) {
                const int colf = order * 1024 + c, colb = 2048 + order * 1024 + c;
                blk_sum2(tid < 256 ? PS[(size_t)(16 + tid) * 4096 + colf] : 0.f, red, 0); blk_sum2(tid < 256 ? PS[(size_t)(16 + tid) * 4096 + colb] : 0.f, red, 1);
                __syncthreads();
                float sf = 0.f, sb = 0.f;
#pragma unroll
                for (int q = 0; q < 8; ++q) { sf += red[q]; sb += red[8 + q]; }
                const float nf = 1.0f / (sf + 1e-6f), nb = 1.0f / (sb + 1e-6f), skip = p.in[I_HSKIP][order * 1024 + c];
                const float* hf = FtS + (size_t)colf * 4096; const float* hb = FtS + (size_t)colb * 4096;
                { float pv[24];
#pragma unroll
                  for (int j = 0; j < 24; ++j) { const int i = 16 * tid + j; float v;
                      if (i <= 0 || i >= 8192) v = 0.f; else if (i < 4096) v = hf[4096 - i] * nf; else if (i == 4096) v = hf[0] * nf + hb[0] * nb + skip; else v = hb[i - 4096] * nb;
                      pv[j] = v; }
#pragma unroll
                  for (int rho = 0; rho < 8; ++rho) { LAS unsigned char* d = cp + rho * CST + tid * 32;
                      *(LAS u32x4*)d = (u32x4){cvt_pk_bf16(pv[rho], pv[rho + 1]), cvt_pk_bf16(pv[rho + 2], pv[rho + 3]), cvt_pk_bf16(pv[rho + 4], pv[rho + 5]), cvt_pk_bf16(pv[rho + 6], pv[rho + 7])};
                      *(LAS u32x4*)(d + 16) = (u32x4){cvt_pk_bf16(pv[rho + 8], pv[rho + 9]), cvt_pk_bf16(pv[rho + 10], pv[rho + 11]), cvt_pk_bf16(pv[rho + 12], pv[rho + 13]), cvt_pk_bf16(pv[rho + 14], pv[rho + 15])}; } }
                if (order == 0) {
#pragma unroll
                    for (int i = 0; i < 2; ++i) { const int idx = tid + i * 512, bt = idx >> 9, ch = idx & 511;
                        *(LAS u32x4*)(uL + bt * 4608 + (ch >> 3) * 72 + (ch & 7) * 8) = *(const u32x4*)(Zt + (size_t)(2048 + c) * NT + NTP + bt * 4096 + ch * 8); }
                }
                __syncthreads();
                f32x16 acc;
#pragma unroll
                for (int r = 0; r < 16; ++r) acc[r] = 0.f;
                const int bp = 32 * mi + lr, rho = (-bp) & 7;
                const LAS unsigned char* cb = cp + rho * CST; const LAS bf16_t* ub = uL + batch * 4608;
                for (int e = 32 * ah - 63; e <= 32 * ah + 31; ++e) {
                    const int aa = 32 * ah + lr - e; const bool valid = (unsigned)aa < 64u; const int aac = aa & 63;
#pragma unroll
                    for (int ks = 0; ks < 4; ++ks) {
                        const int q = 4096 + 16 * ks + 8 * g - bp - 64 * e;
                        const bf16x8 af = *(const LAS bf16x8*)(cb + (q - rho) * 2);
                        u32x4 bw = *(const LAS u32x4*)(ub + aac * 72 + 16 * ks + 8 * g);
                        if (!valid) bw = (u32x4){0u, 0u, 0u, 0u};
                        acc = __builtin_amdgcn_mfma_f32_32x32x16_bf16(af, __builtin_bit_cast(bf16x8, bw), acc, 0, 0, 0);
                    }
                }
                __syncthreads();
                { const bf16_t* gp = Zt + (size_t)(order == 0 ? c : 1024 + c) * NT + NTP + batch * 4096; const int a = 32 * ah + lr;
#pragma unroll
                  for (int q4 = 0; q4 < 4; ++q4) { const int bq = 32 * mi + 8 * q4 + 4 * g; const u32x2 gv = *(const u32x2*)(gp + 64 * a + bq);
                      *(LAS u32x2*)(uL + batch * 4608 + a * 72 + bq) = (u32x2){cvt_pk_bf16(acc[4 * q4] * bflo(gv.x), acc[4 * q4 + 1] * bfhi(gv.x)), cvt_pk_bf16(acc[4 * q4 + 2] * bflo(gv.y), acc[4 * q4 + 3] * bfhi(gv.y))}; } }
                __syncthreads();
            }
#pragma unroll
            for (int i = 0; i < 2; ++i) { const int idx = tid + i * 512, bt = idx >> 9, ch = idx & 511;
                *(u32x4*)(yT + (size_t)c * NT + NTP + bt * 4096 + ch * 8) = *(const LAS u32x4*)(uL + bt * 4608 + (ch >> 3) * 72 + (ch & 7) * 8); }
            __syncthreads();
        } else {
            constexpr int CSP = 1040;
            LAS unsigned char* cp = lds; LAS bf16_t* uL = (LAS bf16_t*)(lds + 8 * CSP); LAS float* red = (LAS float*)(lds + 8 * CSP + 16896);
            const int mi = wid;
            for (int order = 0; order < 2; ++order) {
                const int colf = order * 1024 + c, colb = 2048 + order * 1024 + c;
                blk_sum2(tid < 16 ? PS[(size_t)tid * 4096 + colf] : 0.f, red, 0); blk_sum2(tid < 16 ? PS[(size_t)tid * 4096 + colb] : 0.f, red, 1);
                __syncthreads();
                float sf = 0.f, sb = 0.f;
#pragma unroll
                for (int q = 0; q < 8; ++q) { sf += red[q]; sb += red[8 + q]; }
                const float nf = 1.0f / (sf + 1e-6f), nb = 1.0f / (sb + 1e-6f), skip = p.in[I_HSKIP][order * 1024 + c];
                const float* hf = FtP + (size_t)colf * 256; const float* hb = FtP + (size_t)colb * 256;
                { const int rho = tid >> 6, ch = tid & 63; float pv[8];
#pragma unroll
                  for (int j = 0; j < 8; ++j) { const int i = 8 * ch + rho + j; float v;
                      if (i <= 0 || i >= 512) v = 0.f; else if (i < 256) v = hf[256 - i] * nf; else if (i == 256) v = hf[0] * nf + hb[0] * nb + skip; else v = hb[i - 256] * nb;
                      pv[j] = v; }
                  *(LAS u32x4*)(cp + rho * CSP + ch * 16) = (u32x4){cvt_pk_bf16(pv[0], pv[1]), cvt_pk_bf16(pv[2], pv[3]), cvt_pk_bf16(pv[4], pv[5]), cvt_pk_bf16(pv[6], pv[7])}; }
                if (order == 0) {
#pragma unroll
                    for (int i = 0; i < 2; ++i) { const int idx = tid + i * 512, bt = idx >> 5, ch = idx & 31;
                        *(LAS u32x4*)(uL + bt * 264 + ch * 8) = *(const u32x4*)(Zt + (size_t)(2048 + c) * NT + bt * 256 + ch * 8); }
                }
                __syncthreads();
                f32x16 acc;
#pragma unroll
                for (int r = 0; r < 16; ++r) acc[r] = 0.f;
                const int t = 32 * mi + lr, rho = (-t) & 7;
                const LAS unsigned char* cb = cp + rho * CSP;
#pragma unroll 4
                for (int ks = 0; ks < 16; ++ks) {
                    const int q = 256 + 16 * ks + 8 * g - t;
                    const bf16x8 af = *(const LAS bf16x8*)(cb + (q - rho) * 2);
                    const bf16x8 bf = *(const LAS bf16x8*)(uL + lr * 264 + 16 * ks + 8 * g);
                    acc = __builtin_amdgcn_mfma_f32_32x32x16_bf16(af, bf, acc, 0, 0, 0);
                }
                __syncthreads();
                { const bf16_t* gp = Zt + (size_t)(order == 0 ? c : 1024 + c) * NT + lr * 256;
#pragma unroll
                  for (int q4 = 0; q4 < 4; ++q4) { const int t4 = 32 * mi + 8 * q4 + 4 * g; const u32x2 gv = *(const u32x2*)(gp + t4);
                      *(LAS u32x2*)(uL + lr * 264 + t4) = (u32x2){cvt_pk_bf16(acc[4 * q4] * bflo(gv.x), acc[4 * q4 + 1] * bfhi(gv.x)), cvt_pk_bf16(acc[4 * q4 + 2] * bflo(gv.y), acc[4 * q4 + 3] * bfhi(gv.y))}; } }
                __syncthreads();
            }
#pragma unroll
            for (int i = 0; i < 2; ++i) { const int idx = tid + i * 512, bt = idx >> 5, ch = idx & 31;
                *(u32x4*)(yT + (size_t)c * NT + bt * 256 + ch * 8) = *(const LAS u32x4*)(uL + bt * 264 + ch * 8); }
            __syncthreads();
        }
    }
}
__device__ void hyena_untranspose(const Params& p, LAS unsigned char* lds) {
    const bf16_t* yT = (const bf16_t*)(p.ws + WS_U); bf16_t* H = (bf16_t*)(p.ws + WS_H);
    for (int it = blockIdx.x; it < 16 * 64; it += gridDim.x) { const int ct = it & 15, tt = it >> 4;
        vt_tile<4>(yT + (size_t)(ct * 64) * NT + tt * 256, NT, H + (size_t)(tt * 256) * DM + ct * 64, DM, (LAS bf16_t*)lds); }
}


#define XB_TMO      128
#define XB_XCNT(j)  (256  + 64 * (j))
#define XB_XSUB(j)  (1280 + 64 * (j))
#define XB_XGEN(j)  (2304 + 64 * (j))
#define XB_TOP      3328
#define XB_TOPGEN   3392
#define XCD_BAR_WORDS 3456
#define XB_SPIN_CAP (1u << 18)
__device__ __forceinline__ unsigned xb_ld(unsigned* p)              { return __hip_atomic_load(p, __ATOMIC_RELAXED, __HIP_MEMORY_SCOPE_AGENT); }
__device__ __forceinline__ unsigned xb_add(unsigned* p, unsigned v) { return __hip_atomic_fetch_add(p, v, __ATOMIC_RELAXED, __HIP_MEMORY_SCOPE_AGENT); }
__device__ __forceinline__ unsigned xb_xcc_id() { return (unsigned)__builtin_amdgcn_s_getreg((3 << 11) | 20) & 0xFu; }
#define XB_SPIN(cond, bar) do { unsigned _sp = 0; while (cond) { __builtin_amdgcn_s_sleep(1); \
    if ((++_sp & 255u) == 0u) { if (xb_ld(&(bar)[XB_TMO])) break; if (_sp > XB_SPIN_CAP) { atomicAdd(&(bar)[XB_TMO], 1u); break; } } } } while (0)
__device__ __forceinline__ void xcd_barrier_post(unsigned* bar) { if (threadIdx.x == 0) (void)xb_add(&bar[XB_XCNT(xb_xcc_id())], 1u); }
__device__ __forceinline__ void xcd_barrier_complete(unsigned* bar, unsigned x, unsigned& nloc, unsigned& nx) {
    const unsigned G = gridDim.x * gridDim.y * gridDim.z;
    unsigned sum, cnt, mine, sp = 0u;
    for (;;) {
        sum = 0u; cnt = 0u; mine = 0u;
#pragma unroll
        for (unsigned j = 0; j < 16; ++j) { const unsigned c = xb_ld(&bar[XB_XCNT(j)]); sum += c; cnt += (c > 0u) ? 1u : 0u; mine = (j == x) ? c : mine; }
        if (sum == G) break;
        __builtin_amdgcn_s_sleep(1);
        if ((++sp & 255u) == 0u) { if (xb_ld(&bar[XB_TMO])) break; if (sp > XB_SPIN_CAP) { atomicAdd(&bar[XB_TMO], 1u); break; } }
    }
    nloc = mine > 0u ? mine : 1u; nx = cnt > 0u ? cnt : 1u;
}
__device__ __forceinline__ void xcd_barrier(unsigned* bar, volatile LAS unsigned* st) {
    asm volatile("s_waitcnt vmcnt(0)" ::: "memory");
    __syncthreads();
    if (threadIdx.x == 0) {
        const unsigned x = xb_xcc_id();
        __builtin_amdgcn_s_waitcnt(0);
        unsigned nloc = st[0], nx = st[1];
        if (nloc == 0u) { xcd_barrier_complete(bar, x, nloc, nx); st[0] = nloc; st[1] = nx; }
        const unsigned old = xb_add(&bar[XB_XSUB(x)], 1u);
        const unsigned gen = old / nloc;
        if (old + 1u == (gen + 1u) * nloc) {
            __builtin_amdgcn_fence(__ATOMIC_RELEASE, "agent");
            asm volatile("s_waitcnt vmcnt(0)" ::: "memory");
            const unsigned og = xb_add(&bar[XB_TOP], 1u);
            const unsigned tg = og / nx;
            if (og + 1u == (tg + 1u) * nx) xb_add(&bar[XB_TOPGEN], 1u);
            else XB_SPIN(xb_ld(&bar[XB_TOPGEN]) == tg, bar);
            __builtin_amdgcn_fence(__ATOMIC_ACQUIRE, "agent");
            xb_add(&bar[XB_XGEN(x)], 1u);
            asm volatile("s_waitcnt vmcnt(0)" ::: "memory");
        } else {
            XB_SPIN(xb_ld(&bar[XB_XGEN(x)]) == gen, bar);
            __builtin_amdgcn_fence(__ATOMIC_ACQUIRE, "agent");
            asm volatile("s_waitcnt vmcnt(0)" ::: "memory");
        }
    }
    __syncthreads();
}

#ifndef REP_FLASH
#define REP_FLASH 1
#endif
#ifndef REP_L
#define REP_L -1
#endif
#ifndef REP_SYNC
#define REP_SYNC 1
#endif
#ifndef REP_GEMM
#define REP_GEMM 1
#endif
#ifndef DBG_L
#define DBG_L 2
#endif
constexpr int NPHASE = 42;

__device__ __forceinline__ void run_gemm_bf16(LAS unsigned char* lds, const bf16_t* A, const bf16_t* Bt, int N, int K, bf16_t* O) {
    pg8::Gemm g{A, Bt, NT, N, K}; pg8::StaticOrder S; S.init(NT, N, (int)gridDim.x, (int)blockIdx.x); pg8::EpiBf16 E{O, N};
    pg8::gemm_phase<pg8::EpiBf16, pg8::StaticOrder>(lds, g, S, E);
}
__device__ __forceinline__ void run_gemm_res(LAS unsigned char* lds, const bf16_t* A, const bf16_t* Bt, int K, bf16_t* X, const float* mod, int goff,
                                             bf16_t* An, const float* gnext, int scoff, int shoff, unsigned long long* slots, unsigned tag, int fin, float* Y, unsigned* bar) {
    pg8::Gemm g{A, Bt, NT, DM, K}; pg8::StaticOrder S; S.init(NT, DM, (int)gridDim.x, (int)blockIdx.x); pg8::EpiRes E{X, mod, goff, An, gnext, scoff, shoff, slots, tag, fin, Y, bar};
    pg8::gemm_phase<pg8::EpiRes, pg8::StaticOrder>(lds, g, S, E);
}

__device__ void conv_mixer_weights(const Params& p, int l, LAS unsigned char* lds) {
    bf16_t* W = (bf16_t*)(p.ws + WS_WMIX); int rot = 0;
    if (l == 0) { wconv(p.in[I_AQKV], 1024, 1536, W, lds, rot); wconv(p.in[I_AWO], 1024, 1024, W + (size_t)1536 * 1024, lds, rot); }
    else if (l == 1) { wconv(p.in[I_DQKV], 1024, 3072, W, lds, rot); wconv(p.in[I_DWO], 1024, 1024, W + (size_t)3072 * 1024, lds, rot); }
    else if (l == 2) { wconv(p.in[I_RWIN], 1024, 6144, W, lds, rot); wconv(p.in[I_RWO], 2048, 1024, W + (size_t)6144 * 1024, lds, rot); }
    else { wconv(p.in[I_HWIN], 1024, 3072, W, lds, rot); wconv(p.in[I_HWO], 1024, 1024, W + (size_t)3072 * 1024, lds, rot); }
}
__device__ void conv_ffn_weights(const Params& p, int l, LAS unsigned char* lds) {
    bf16_t* W = (bf16_t*)(p.ws + WS_WFFN); int rot = 0;
    wconv(p.in[I_FUP] + (size_t)l * 1024 * 5632, 1024, 5632, W, lds, rot); wconv(p.in[I_FDOWN] + (size_t)l * FF * 1024, FF, 1024, W + (size_t)5632 * 1024, lds, rot);
}

__device__ __forceinline__ bool phase_empty(int ph) { if (ph == 0) return false; if (ph == 41) return true;     const int l = (ph - 1) / 10, s = (ph - 1) % 10; return (s == 4 && l < 3)   || s == 6 || (s == 0 && l > 0); }

#ifndef ONLY
#define ONLY -1
#endif
#define EN(x) (ONLY == -1 || ONLY == (x))
__device__ __forceinline__ void run_phase(int ph, LAS unsigned char* lds) {
    KParamsPtr kp = (KParamsPtr)__builtin_amdgcn_kernarg_segment_ptr();
    asm volatile("" : "+s"(kp));
    Params p;
#pragma unroll
    for (int i = 0; i < 41; ++i) p.in[i] = kp->in[i];
    p.out = kp->out; p.ws = kp->ws;
    bf16_t* X = (bf16_t*)((unsigned char*)p.out + XR_OFF); const float* mod = (const float*)(p.ws + WS_MOD);
    bf16_t* H = (bf16_t*)(p.ws + WS_H); bf16_t* U = (bf16_t*)(p.ws + WS_U); bf16_t* XB = (bf16_t*)(p.ws + WS_X);
    bf16_t* WM = (bf16_t*)(p.ws + WS_WMIX); bf16_t* WF = (bf16_t*)(p.ws + WS_WFFN);
    if (ph == 0) { if (EN(0)) { prep_misc(p, lds); conv_mixer_weights(p, 0, lds); conv_ffn_weights(p, 0, lds); } return; }
    if (ph == 41) return;
    const int l = (ph - 1) / 10, s = (ph - 1) % 10;
    const int nin = l == 0 ? 1536 : (l == 2 ? 6144 : 3072);
    const int kout = l == 2 ? 2048 : 1024;
    unsigned long long* slots = (unsigned long long*)(p.ws + WS_SLOT);
    if (s == 0) { if (EN(2)) norm_mod(X, p.in[I_N1G] + l * DM, mod + l * 6144, 1 * 1024, 0, H); }
    else if (s == 1) { if (EN(4)) run_gemm_bf16(lds, H, WM, nin, 1024, U); }
    else if (s == 7) { if (EN(4)) run_gemm_bf16(lds, XB, WF, 5632, 1024, U); }
    else if (s == 5) { if (EN(5)) run_gemm_res(lds, l == 2 ? (const bf16_t*)(p.ws + WS_X + 36 * MiB) : H, WM + (size_t)nin * 1024, kout, X, mod, l * 6144 + 2 * 1024,
                                               XB, p.in[I_N2G] + l * DM, l * 6144 + 4 * 1024, l * 6144 + 3 * 1024, slots, (unsigned)(ph + 1), 0, p.out, (unsigned*)(p.ws + WS_BAR)); }
    else if (s == 9) { if (EN(5)) run_gemm_res(lds, XB, WF + (size_t)5632 * 1024, FF, X, mod, l * 6144 + 5 * 1024,
                                               l < 3 ? H : nullptr, l < 3 ? p.in[I_N1G] + (l + 1) * DM : p.in[I_FG], (l < 3 ? l + 1 : 0) * 6144 + 1 * 1024, (l < 3 ? l + 1 : 0) * 6144, slots, (unsigned)(ph + 1), l == 3 ? 1 : 0, p.out, (unsigned*)(p.ws + WS_BAR)); }
    else if (s == 8) { if (EN(6)) ffn_act_phase(U, XB, p.in[I_FCW] + (size_t)l * 3 * 5632, p.in[I_FCB] + (size_t)l * 5632); if (EN(0)) { if (l < 3) conv_mixer_weights(p, l + 1, lds); } }
    else if (s == 2) {
        if (l == 0) { if (EN(7)) { post_attn(p, U, XB, XB + (size_t)2 * 4352 * 256, lds); vt_all(U, 1536, 1280, 256, XB + (size_t)2 * 4352 * 256 + (size_t)2 * 256 * 4352, XB + (size_t)2 * 4352 * 256, 4352, 256, lds); } }
        else if (l == 1) { if (EN(8)) { post_diff(p, U, XB, XB + (size_t)2 * 4352 * 1024, lds); vt_all(U, 3072, 2048, 1024, XB + (size_t)2 * 4352 * 1024 + (size_t)2 * 1024 * 4352, XB + (size_t)2 * 4352 * 1024, 4352, 256, lds); } }
        else if (l == 2) { if (EN(9)) ret_prep(p, lds); }
        else { if (EN(10)) hyena_dwconv_t(U, U + (size_t)NT * 3072, p.in[I_HSCW], p.in[I_HSCB]); if (EN(3)) hyena_filters(p, lds); }
        if (EN(0)) { if (l > 0) conv_ffn_weights(p, l, lds); }
    } else if (s == 3) {
        if (l < 3) { for (int rep = 0; rep < (l == REP_L ? 2 : REP_FLASH); ++rep) { if (l == 0) { if (EN(11)) attn_phase(p, lds); } else if (l == 1) { if (EN(12)) diff_phase(p, lds); } else if (l == 2) { if (EN(13)) ret_phase(p, lds); } } }
        else { if (EN(14)) hyena_mfma(p, lds); }
    } else if (s == 4) {
        if (l == 2) { if (EN(15)) ret_gate(p); }
        else if (l == 3) { if (EN(16)) hyena_untranspose(p, lds); }
    }
}

__global__ void __launch_bounds__(512, 2) mega_kernel(Params p, int ph_begin, int ph_end) {
    extern __shared__ __attribute__((aligned(16))) unsigned char shm[];
    LAS unsigned char* lds = (LAS unsigned char*)shm;
    cg::grid_group grid = cg::this_grid();
    volatile LAS unsigned* st = (volatile LAS unsigned*)(lds + LDS_BYTES - 16);
    if (threadIdx.x == 0) { st[0] = 0u; st[1] = 0u; }
    __syncthreads();
    xcd_barrier_post((unsigned*)(p.ws + WS_BAR));
    int nsync = 0;
    for (int ph = ph_begin; ph < ph_end; ++ph) {
        if (phase_empty(ph)) continue;
        if (nsync == 1) {
            __builtin_amdgcn_fence(__ATOMIC_RELEASE, "agent"); asm volatile("s_waitcnt vmcnt(0) lgkmcnt(0)" ::: "memory");
            grid.sync();
            __builtin_amdgcn_fence(__ATOMIC_ACQUIRE, "agent"); asm volatile("s_waitcnt vmcnt(0) lgkmcnt(0)" ::: "memory");
        } else if (nsync > 1) {
            KParamsPtr kp = (KParamsPtr)__builtin_amdgcn_kernarg_segment_ptr();
            xcd_barrier((unsigned*)(kp->ws + WS_BAR), st);
        }
        ++nsync;
        run_phase(ph, lds);
        __syncthreads();
    }
}

extern "C" void kernel_launch(void* const* d_in, const int* in_sizes, int n_in, void* d_out, int out_size, void* d_ws, size_t ws_size, hipStream_t stream) {
    static int grid_blocks = 0;
    if (!grid_blocks) {
        int dev = 0, cus = 0, per_cu = 0;
        hipGetDevice(&dev);
        hipDeviceGetAttribute(&cus, hipDeviceAttributeMultiprocessorCount, dev);
        if (hipFuncSetAttribute((const void*)mega_kernel, hipFuncAttributeMaxDynamicSharedMemorySize, LDS_BYTES) != hipSuccess) { fprintf(stderr, "hipFuncSetAttribute failed\n"); return; }
        if (hipOccupancyMaxActiveBlocksPerMultiprocessor(&per_cu, (const void*)mega_kernel, 512, LDS_BYTES) != hipSuccess || per_cu < 1) { fprintf(stderr, "occupancy query failed\n"); return; }
        if (cus != 256) { fprintf(stderr, "this kernel's residual epilogue needs exactly 256 workgroups (one 256x256 unit each); device has %d CUs\n", cus); return; }
        grid_blocks = cus;
    }
    if (ws_size < WS_NEED || n_in < 41) { fprintf(stderr, "workspace too small: %zu < %zu\n", ws_size, (size_t)WS_NEED); return; }
    Params p{};
    for (int i = 0; i < 41; ++i) p.in[i] = (const float*)d_in[i];
    p.out = (float*)d_out; p.ws = (unsigned char*)d_ws;
#if MULTI_LAUNCH
    for (int ph = 0; ph < NPHASE; ++ph) {
        int b = ph, e = ph + 1; void* args[] = {&p, &b, &e};
        hipLaunchCooperativeKernel((const void*)mega_kernel, dim3(grid_blocks), dim3(512), args, LDS_BYTES, stream);
    }
#else
    (void)hipMemsetAsync((unsigned char*)d_ws + WS_BAR, 0, XCD_BAR_WORDS * sizeof(unsigned), stream);
    (void)hipMemsetAsync((unsigned char*)d_ws + WS_SLOT, 0, WS_SLOT_BYTES + WS_PSLOT_BYTES + 256, stream);
    int b = 0, e = NPHASE; void* args[] = {&p, &b, &e};
    hipError_t err = hipLaunchCooperativeKernel((const void*)mega_kernel, dim3(grid_blocks), dim3(512), args, LDS_BYTES, stream);
    if (err != hipSuccess) fprintf(stderr, "cooperative launch failed: %s (grid %d)\n", hipGetErrorString(err), grid_blocks);
#endif
}
```
